# Optimizing an MI355X kernel written in HIP

```python
import jax, jax.numpy as jnp
from jax import lax
import numpy as np

D_MODEL = 1024
BATCH = 8
SEQ = 8192
DEPTH = 2

HEAD_DIM = 64
N_HEADS_DIL = 8
N_HEADS_NA = 8
D_DIL = N_HEADS_DIL * HEAD_DIM
D_NA = N_HEADS_NA * HEAD_DIM
D_MIX = D_DIL + D_NA
ATTN_SCALE = HEAD_DIM ** -0.5
ROPE_THETA = 10000.0
DIL_PATTERNS = ((128, 1), (512, 4), (2048, 16))
DIL_BLOCK = 64
GRID_W = 64
NA_ROWS_MAX = 8
NA_COLS = 16
NA_QCOLS = 16
NA_KCOLS = NA_QCOLS + NA_COLS
N_EXPERTS = 16
EXPERT_FF = 2816
EC_CAPACITY = 2
EPS = 1e-6
NEG_INF = -1e30

kernel_name = "hybrid_dilated_neighbourhood_ec_moe_encoder"


def _rmsnorm(x, g):
    xf = x.astype(jnp.float32)
    y = xf * lax.rsqrt(jnp.mean(xf * xf, axis=-1, keepdims=True) + EPS)
    return (y * g.astype(jnp.float32)).astype(x.dtype)


def _rope_tables(T):
    pos = jnp.arange(T, dtype=jnp.float32)
    inv = ROPE_THETA ** (-jnp.arange(0, HEAD_DIM, 2, dtype=jnp.float32) / HEAD_DIM)
    ang = pos[:, None] * inv[None, :]
    return jnp.cos(ang), jnp.sin(ang)


def _apply_rope(x, cos, sin):
    xf = x.astype(jnp.float32)
    x1, x2 = jnp.split(xf, 2, axis=-1)
    return jnp.concatenate([x1 * cos - x2 * sin, x2 * cos + x1 * sin], axis=-1).astype(x.dtype)


def _heads(a, n):
    B, T, _ = a.shape
    return a.reshape(B, T, n, HEAD_DIM).transpose(0, 2, 1, 3)


def _unheads(a):
    B, H, T, hd = a.shape
    return a.transpose(0, 2, 1, 3).reshape(B, T, H * hd)


def _dilated_branch(q, k, v, window, dilation):
    B, H, T, hd = q.shape
    half = window // (2 * dilation)
    L = T // dilation
    blk = DIL_BLOCK
    nb = -(-L // blk)
    nbr = -(-half // blk)
    span = (2 * nbr + 1) * blk
    Lp = nb * blk

    def strided(a):
        return a.reshape(B, H, L, dilation, hd).transpose(0, 1, 3, 2, 4)

    qs = jnp.pad(strided(q), ((0, 0), (0, 0), (0, 0), (0, Lp - L), (0, 0)))
    qs = qs.reshape(B, H, dilation, nb, blk, hd)
    pad_k = ((0, 0), (0, 0), (0, 0), (nbr * blk, Lp - L + nbr * blk), (0, 0))

    def windows(a):
        ab = jnp.pad(strided(a), pad_k).reshape(B, H, dilation, nb + 2 * nbr, blk, hd)
        return jnp.concatenate([ab[:, :, :, sh:sh + nb] for sh in range(2 * nbr + 1)], axis=4)

    ks, vs = windows(k), windows(v)
    q_idx = jnp.arange(nb)[:, None] * blk + jnp.arange(blk)[None, :]
    k_idx = jnp.arange(nb)[:, None] * blk + jnp.arange(span)[None, :] - nbr * blk
    rel = k_idx[:, None, :] - q_idx[:, :, None]
    valid = (jnp.abs(rel) <= half) & (k_idx[:, None, :] >= 0) & (k_idx[:, None, :] < L)

    s = jnp.einsum('bhrnqd,bhrnkd->bhrnqk', qs, ks, preferred_element_type=jnp.float32) * ATTN_SCALE
    s = jnp.where(valid, s, NEG_INF)
    m = jnp.max(s, axis=-1, keepdims=True)
    p = jnp.exp(s - m)
    den = jnp.sum(p, axis=-1, keepdims=True)
    o = jnp.einsum('bhrnqk,bhrnkd->bhrnqd', p.astype(v.dtype), vs,
                   preferred_element_type=jnp.float32) / den
    lse = (m + jnp.log(den))[..., 0]

    def unstrided(a):
        a = a.reshape(B, H, dilation, Lp, *a.shape[5:])[:, :, :, :L]
        return jnp.moveaxis(a, 2, 3).reshape(B, H, T, *a.shape[4:])

    return unstrided(o), unstrided(lse)


def _dilated_attention(q, k, v):
    outs, lses = zip(*[_dilated_branch(q, k, v, w, d) for (w, d) in DIL_PATTERNS])
    wts = jax.nn.softmax(jnp.stack(lses), axis=0)
    return jnp.sum(wts[..., None] * jnp.stack(outs), axis=0)


def _neighbourhood_attention(q, k, v, rpb):
    B, H, T, hd = q.shape
    rows = T // GRID_W
    kh = min(NA_ROWS_MAX, rows)
    kw = NA_COLS
    ncb = GRID_W // NA_QCOLS
    kg = k.reshape(B, H, rows, GRID_W, hd)
    vg = v.reshape(B, H, rows, GRID_W, hd)
    q_rows = jnp.moveaxis(q.reshape(B, H, rows, GRID_W, hd), 2, 0)

    r_idx = jnp.arange(rows)
    r_start = jnp.clip(r_idx - kh // 2, 0, rows - kh)
    c_idx = jnp.arange(GRID_W).reshape(ncb, NA_QCOLS)
    c_start = jnp.clip(c_idx - kw // 2, 0, GRID_W - kw)
    kc_start = jnp.clip(jnp.arange(ncb) * NA_QCOLS - kw // 2, 0, GRID_W - NA_KCOLS)
    kc = kc_start[:, None] + jnp.arange(NA_KCOLS)[None, :]
    col_valid = (kc[:, None, :] >= c_start[..., None]) & (kc[:, None, :] < c_start[..., None] + kw)
    valid = jnp.broadcast_to(col_valid[:, :, None, :], (ncb, NA_QCOLS, kh, NA_KCOLS))
    valid = valid.reshape(ncb, NA_QCOLS, kh * NA_KCOLS)
    dcol = jnp.clip(kc[:, None, :] - c_idx[..., None] + (kw - 1), 0, 2 * kw - 2)
    rpb_f = rpb.astype(jnp.float32)

    def one_row(args):
        q_r, r, rs = args
        k_r = lax.dynamic_slice_in_dim(kg, rs, kh, axis=2)
        v_r = lax.dynamic_slice_in_dim(vg, rs, kh, axis=2)

        def blocks(a):
            a = a[:, :, :, kc]
            return a.transpose(0, 1, 3, 2, 4, 5).reshape(B, H, ncb, kh * NA_KCOLS, hd)

        kb, vb = blocks(k_r), blocks(v_r)
        drow = rs + jnp.arange(kh) - r + (NA_ROWS_MAX - 1)
        bias = rpb_f[:, drow[None, None, :, None], dcol[:, :, None, :]]
        bias = bias.reshape(H, ncb, NA_QCOLS, kh * NA_KCOLS)
        qb = q_r.reshape(B, H, ncb, NA_QCOLS, hd)
        s = jnp.einsum('bhjqd,bhjkd->bhjqk', qb, kb, preferred_element_type=jnp.float32) * ATTN_SCALE
        s = jnp.where(valid, s + bias, NEG_INF)
        p = jax.nn.softmax(s, axis=-1)
        o = jnp.einsum('bhjqk,bhjkd->bhjqd', p.astype(v.dtype), vb, preferred_element_type=jnp.float32)
        return o.reshape(B, H, GRID_W, hd)

    o = lax.map(one_row, (q_rows, r_idx, r_start))
    return jnp.moveaxis(o, 0, 2).reshape(B, H, T, hd)


def _expert_choice_ffn(h, w_router, w_gate, w_up, w_down):
    B, T, D = h.shape
    cap = EC_CAPACITY * T // N_EXPERTS
    logits = jnp.einsum('btd,de->bte', h, w_router, preferred_element_type=jnp.float32)
    aff = jax.nn.softmax(logits, axis=-1)
    gate, idx = lax.top_k(aff.transpose(0, 2, 1), cap)
    bidx = jnp.arange(B)[:, None, None]
    xg = h[bidx, idx]

    def expert(args):
        xe, wg, wu, wd = args
        return (jax.nn.silu(xe @ wg) * (xe @ wu)) @ wd

    ye = lax.map(expert, (xg.transpose(1, 0, 2, 3), w_gate, w_up, w_down))
    ye = ye.transpose(1, 0, 2, 3) * gate[..., None].astype(h.dtype)
    return jnp.zeros_like(h).at[bidx, idx].add(ye)


def setup_inputs(seed: int = 0) -> dict:
    key = jax.random.key(seed)
    ks = jax.random.split(key, 13)
    f32 = jnp.float32
    nrm = lambda k, shape: jax.random.normal(k, shape, dtype=f32)
    return {
        "x": nrm(ks[0], (BATCH, SEQ, D_MODEL)),
        "attn_norm": 1.0 + 0.05 * nrm(ks[1], (DEPTH, D_MODEL)),
        "w_in": nrm(ks[2], (DEPTH, D_MODEL, 3 * D_MIX)) * D_MODEL ** -0.5,
        "dil_out_norm": 1.0 + 0.05 * nrm(ks[3], (DEPTH, D_DIL)),
        "na_out_norm": 1.0 + 0.05 * nrm(ks[4], (DEPTH, D_NA)),
        "na_rpb": 0.1 * nrm(ks[5], (DEPTH, N_HEADS_NA, 2 * NA_ROWS_MAX - 1, 2 * NA_COLS - 1)),
        "w_out": nrm(ks[6], (DEPTH, D_MIX, D_MODEL)) * D_MIX ** -0.5,
        "ffn_norm": 1.0 + 0.05 * nrm(ks[7], (DEPTH, D_MODEL)),
        "w_router": nrm(ks[8], (DEPTH, D_MODEL, N_EXPERTS)) * D_MODEL ** -0.5,
        "w_gate": nrm(ks[9], (DEPTH, N_EXPERTS, D_MODEL, EXPERT_FF)) * D_MODEL ** -0.5,
        "w_up": nrm(ks[10], (DEPTH, N_EXPERTS, D_MODEL, EXPERT_FF)) * D_MODEL ** -0.5,
        "w_down": nrm(ks[11], (DEPTH, N_EXPERTS, EXPERT_FF, D_MODEL)) * EXPERT_FF ** -0.5,
        "final_norm": 1.0 + 0.05 * nrm(ks[12], (D_MODEL,)),
    }


def reference(x, attn_norm, w_in, dil_out_norm, na_out_norm, na_rpb, w_out,
              ffn_norm, w_router, w_gate, w_up, w_down, final_norm):
    B, T, _ = x.shape
    cos, sin = _rope_tables(T)
    split_pts = (D_DIL, 2 * D_DIL, 3 * D_DIL, 3 * D_DIL + D_NA, 3 * D_DIL + 2 * D_NA)
    for l in range(DEPTH):
        h = _rmsnorm(x, attn_norm[l])
        proj = jnp.einsum('btd,df->btf', h, w_in[l])
        qa, ka, va, qb, kb, vb = jnp.split(proj, split_pts, axis=-1)
        qa = _apply_rope(_heads(qa, N_HEADS_DIL), cos, sin)
        ka = _apply_rope(_heads(ka, N_HEADS_DIL), cos, sin)
        oa = _dilated_attention(qa, ka, _heads(va, N_HEADS_DIL))
        ob = _neighbourhood_attention(_heads(qb, N_HEADS_NA), _heads(kb, N_HEADS_NA),
                                      _heads(vb, N_HEADS_NA), na_rpb[l])
        mixed = jnp.concatenate([_rmsnorm(_unheads(oa).astype(x.dtype), dil_out_norm[l]),
                                 _rmsnorm(_unheads(ob).astype(x.dtype), na_out_norm[l])], axis=-1)
        x = x + jnp.einsum('btf,fd->btd', mixed, w_out[l])
        x = x + _expert_choice_ffn(_rmsnorm(x, ffn_norm[l]), w_router[l], w_gate[l], w_up[l], w_down[l])
    return _rmsnorm(x, final_norm)
```

```cpp
#include <hip/hip_runtime.h>
#include <cstdio>
#include <cstdint>

#ifndef PM
#define PM 0xffff
#endif
#ifndef MK_N_LAUNCHES
#define MK_N_LAUNCHES 1
#endif

#define GAS __attribute__((address_space(1)))
#define LAS __attribute__((address_space(3)))
typedef unsigned short bf16_t;
typedef short bf16x8 __attribute__((ext_vector_type(8)));
typedef short s16x4 __attribute__((ext_vector_type(4)));
typedef float f32x4 __attribute__((ext_vector_type(4)));
typedef float f32x2 __attribute__((ext_vector_type(2)));
typedef unsigned u32x4 __attribute__((ext_vector_type(4)));
typedef unsigned u32x2 __attribute__((ext_vector_type(2)));
typedef GAS unsigned gu32;

constexpr int D = 1024, BATCH = 8, T = 8192, M = BATCH * T, NQKV = 3072, NE = 16, FF = 2816, CAP = 1024, MS = NE * BATCH * CAP;
constexpr int NWAVES = 8, NTHREADS = 512;
constexpr float EPS = 1e-6f;
constexpr float LOG2E = 1.4426950408889634f;
constexpr float QSCALE = 0.125f * LOG2E;
constexpr int NPH = 17;

constexpr size_t MiB = 1u << 20;
constexpr size_t WS_CTL = 0, CTL_BYTES = 1 * MiB;
constexpr size_t WS_ROPE = 2 * MiB;
constexpr size_t WS_AFF = 4 * MiB;
constexpr size_t WS_INV = 8 * MiB;
constexpr size_t WS_SEL = 12 * MiB;
constexpr size_t WS_GATEV = 12 * MiB + 512 * 1024;
constexpr size_t WS_WIN = 16 * MiB;
constexpr size_t WS_WOUT = 22 * MiB;
constexpr size_t WS_WGU = 24 * MiB;
constexpr size_t WS_WD = 200 * MiB;
constexpr size_t WS_H = 288 * MiB;
constexpr size_t WS_ACT = 416 * MiB;
constexpr size_t WS_QKV = 416 * MiB;
constexpr size_t WS_MIX = 800 * MiB;
constexpr size_t WS_YE = 1120 * MiB;
constexpr size_t WS_END = 1376 * MiB;
constexpr int CW_BAR = 4096;

constexpr int RING_BYTES = 131072;
constexpr int MISC_OFF = RING_BYTES;
constexpr int LDS_BYTES = 147456;

#define LDS_WAIT() asm volatile("s_waitcnt lgkmcnt(0)" ::: "memory")
#define VM_WAIT() asm volatile("s_waitcnt vmcnt(0)" ::: "memory")
__device__ __forceinline__ unsigned cvt_pk_bf16(float lo, float hi) { unsigned r; asm volatile("v_cvt_pk_bf16_f32 %0, %1, %2" : "=v"(r) : "v"(lo), "v"(hi)); return r; }
__device__ __forceinline__ float bf_lo(unsigned w) { return __uint_as_float(w << 16); }
__device__ __forceinline__ float bf_hi(unsigned w) { return __uint_as_float(w & 0xffff0000u); }
__device__ __forceinline__ int fresh_v(int v) { asm volatile("" : "+v"(v)); return v; }
__device__ __forceinline__ int fresh_s(int v) { asm volatile("" : "+s"(v)); return v; }
__device__ __forceinline__ float wave_sum(float v) {
#pragma unroll
    for (int o = 1; o < 64; o <<= 1) v += __shfl_xor(v, o);
    return v;
}

#define XB_TMO      128
#define XB_XCNT(j)  (256  + 64 * (j))
#define XB_XSUB(j)  (1280 + 64 * (j))
#define XB_XGEN(j)  (2304 + 64 * (j))
#define XB_TOP      3328
#define XB_TOPGEN   3392
#define XCD_BAR_WORDS 3456
#define XB_SPIN_CAP (1u << 18)
__device__ __forceinline__ unsigned xb_ld(unsigned* p)              { return __hip_atomic_load(p, __ATOMIC_RELAXED, __HIP_MEMORY_SCOPE_AGENT); }
__device__ __forceinline__ unsigned xb_add(unsigned* p, unsigned v) { return __hip_atomic_fetch_add(p, v, __ATOMIC_RELAXED, __HIP_MEMORY_SCOPE_AGENT); }
__device__ __forceinline__ unsigned xb_xcc_id() { return (unsigned)__builtin_amdgcn_s_getreg((3 << 11) | 20) & 0xFu; }
#define XB_SPIN(cond, bar) do { unsigned _sp = 0; while (cond) { __builtin_amdgcn_s_sleep(1); \
    if ((++_sp & 255u) == 0u) { if (xb_ld(&(bar)[XB_TMO])) break; if (_sp > XB_SPIN_CAP) { atomicAdd(&(bar)[XB_TMO], 1u); break; } } } } while (0)
struct XcdBarrier { unsigned* bar; unsigned x; volatile LAS unsigned* st; };
__device__ __forceinline__ XcdBarrier xcd_barrier_post(unsigned* bar, volatile LAS unsigned* st) {
    XcdBarrier b; b.bar = bar; b.x = xb_xcc_id(); b.st = st;
    if (threadIdx.x == 0) (void)xb_add(&bar[XB_XCNT(b.x)], 1u);
    return b;
}
__device__ __forceinline__ void xcd_barrier_complete(unsigned* bar, unsigned x, unsigned& nloc, unsigned& nx) {
    const unsigned G = gridDim.x * gridDim.y * gridDim.z;
    unsigned sum, cnt, mine, sp = 0u;
    for (;;) {
        sum = 0u; cnt = 0u; mine = 0u;
#pragma unroll
        for (unsigned j = 0; j < 16; ++j) { const unsigned c = xb_ld(&bar[XB_XCNT(j)]); sum += c; cnt += (c > 0u) ? 1u : 0u; mine = (j == x) ? c : mine; }
        if (sum == G) break;
        __builtin_amdgcn_s_sleep(1);
        if ((++sp & 255u) == 0u) { if (xb_ld(&bar[XB_TMO])) break; if (sp > XB_SPIN_CAP) { atomicAdd(&bar[XB_TMO], 1u); break; } }
    }
    nloc = mine > 0u ? mine : 1u; nx = cnt > 0u ? cnt : 1u;
}
__device__ __forceinline__ void xcd_barrier(const XcdBarrier& b) {
    asm volatile("s_waitcnt vmcnt(0)" ::: "memory");
    __syncthreads();
    if (threadIdx.x == 0) {
        unsigned* bar = b.bar;
        __builtin_amdgcn_s_waitcnt(0);
        unsigned nloc = b.st[0], nx = b.st[1];
        if (nloc == 0u) { xcd_barrier_complete(bar, b.x, nloc, nx); b.st[0] = nloc; b.st[1] = nx; }
        const unsigned old = xb_add(&bar[XB_XSUB(b.x)], 1u);
        const unsigned gen = old / nloc;
        if (old + 1u == (gen + 1u) * nloc) {
            __builtin_amdgcn_fence(__ATOMIC_RELEASE, "agent");
            asm volatile("s_waitcnt vmcnt(0)" ::: "memory");
            const unsigned og = xb_add(&bar[XB_TOP], 1u);
            const unsigned tg = og / nx;
            if (og + 1u == (tg + 1u) * nx) xb_add(&bar[XB_TOPGEN], 1u);
            else XB_SPIN(xb_ld(&bar[XB_TOPGEN]) == tg, bar);
            __builtin_amdgcn_fence(__ATOMIC_ACQUIRE, "agent");
            xb_add(&bar[XB_XGEN(b.x)], 1u);
            asm volatile("s_waitcnt vmcnt(0)" ::: "memory");
        } else {
            XB_SPIN(xb_ld(&bar[XB_XGEN(b.x)]) == gen, bar);
            __builtin_amdgcn_fence(__ATOMIC_ACQUIRE, "agent");
            asm volatile("s_waitcnt vmcnt(0)" ::: "memory");
        }
    }
    __syncthreads();
}

namespace gm {
constexpr int BM = 256, BK = 64, HALF = 128, HTB = HALF * BK * 2, STAGE_BYTES = 8 * HTB, NXCD = 8, WGM = 8;
__host__ __device__ __forceinline__ int lds_byte(int r, int c) { const int st = (r >> 4) * 2 + (c >> 5), rr = r & 15, cc = c & 31, ob = rr * 64 + cc * 2; return st * 1024 + (ob ^ (((ob >> 9) & 1) << 5)); }
__host__ __device__ __forceinline__ void stage_rc(int b, int& R, int& C) { const int st = b / 1024, sb = b % 1024, swz = sb ^ (((sb >> 9) & 1) << 5); R = (st >> 1) * 16 + swz / 64; C = (st & 1) * 32 + (swz % 64) / 2; }
__host__ __device__ __forceinline__ int perm32(int rho) { const int n = rho >> 4, i = rho & 15; return 8 * (i >> 2) + 4 * n + (i & 3); }
struct Unit { int pm, pn; };
struct StaticOrder {
    int nM, nN, nwg, G, c;
    __device__ void init(int Mr, int N, int G_, int c_) { nM = Mr / BM; nN = N / BM; nwg = nM * nN; G = G_; c = c_; }
    __device__ bool next(int i, Unit& u) const {
        const long L = (long)i * G + c; if (L >= nwg) return false;
        int wgid = (int)L; { const int q = nwg / NXCD, r = nwg % NXCD, xcd = wgid % NXCD, off = wgid / NXCD; wgid = (xcd < r ? xcd * (q + 1) : r * (q + 1) + (xcd - r) * q) + off; }
        const int nig = WGM * nN, gid = wgid / nig, fm = gid * WGM, gsz = (nM - fm) < WGM ? (nM - fm) : WGM;
        u.pm = fm + ((wgid % nig) % gsz); u.pn = (wgid % nig) / gsz; return true;
    }
};
struct ASrc { const char* base; const int* sel; int K; };
struct BSrc { const char* base; int eshift; size_t estride; };

template <class Epi, bool GATHER>
__device__ __forceinline__ void gemm_phase(LAS unsigned char* lds, const ASrc A, const BSrc B, const StaticOrder& S, const Epi& E) {
    const int tid = fresh_v(threadIdx.x), wid = __builtin_amdgcn_readfirstlane(tid >> 6), lane = tid & 63, wr = wid >> 2, wc = wid & 3, fr = lane & 15, fq = lane >> 4;
    const int K = A.K, nt = K / BK;
    unsigned voffA0, voffA1, voffB0, voffB1; int R0, R1, C0, C1;
    { stage_rc(tid * 16, R0, C0); stage_rc(tid * 16 + 8192, R1, C1);
      const int Rb0 = Epi::PERM ? ((R0 & ~31) + perm32(R0 & 31)) : R0, Rb1 = Epi::PERM ? ((R1 & ~31) + perm32(R1 & 31)) : R1;
      voffA0 = (unsigned)(R0 * K + C0) * 2u; voffA1 = (unsigned)(R1 * K + C1) * 2u; voffB0 = (unsigned)(Rb0 * K + C0) * 2u; voffB1 = (unsigned)(Rb1 * K + C1) * 2u; }
    const size_t kstep = (size_t)(BK * 2);
    const size_t hstep = (size_t)HALF * K * 2;
    const size_t tstep = 2 * hstep;
    const unsigned ldsw = (unsigned)wid * 1024u;
    const int aoff = lds_byte(wr * 64 + fr, fq * 8), boff = lds_byte(wc * 32 + fr, fq * 8);
#define G_SA(b, h) (((b) * 2 + (h)) * HTB)
#define G_SB(b, h) ((4 + (b) * 2 + (h)) * HTB)
#define G_LDS2(bufoff, ub, o0, o1) do { \
        __builtin_amdgcn_global_load_lds((const unsigned*)((const char*)(ub) + (o0)), (LAS unsigned*)(lds + (bufoff) + ldsw), 16, 0, 0); \
        __builtin_amdgcn_global_load_lds((const unsigned*)((const char*)(ub) + (o1)), (LAS unsigned*)(lds + (bufoff) + ldsw + 8192), 16, 0, 0); } while (0)
#define G_STB(bufoff, ub) G_LDS2(bufoff, ub, voffB0, voffB1)
#define G_STA(bufoff, DUB, GUB, g0, g1) do { if constexpr (GATHER) { G_LDS2(bufoff, GUB, g0, g1); } else { G_LDS2(bufoff, DUB, voffA0, voffA1); } } while (0)
#define G_LDA(dst, b, h) do { _Pragma("unroll") for (int m = 0; m < 4; ++m) _Pragma("unroll") for (int k = 0; k < 2; ++k) dst[m][k] = *(const LAS bf16x8*)(lds + G_SA(b, h) + aoff + m * 2048 + k * 1024); } while (0)
#define G_LDB(dst, b, h) do { _Pragma("unroll") for (int n = 0; n < 2; ++n) _Pragma("unroll") for (int k = 0; k < 2; ++k) dst[n][k] = *(const LAS bf16x8*)(lds + G_SB(b, h) + boff + n * 2048 + k * 1024); } while (0)
#define G_MMA(ai, bj, At, Bt) do { __builtin_amdgcn_s_setprio(1); _Pragma("unroll") for (int m = 0; m < 4; ++m) _Pragma("unroll") for (int n = 0; n < 2; ++n) _Pragma("unroll") for (int k = 0; k < 2; ++k) \
        acc[ai][bj][m][n] = __builtin_amdgcn_mfma_f32_16x16x32_bf16(Bt[n][k], At[m][k], acc[ai][bj][m][n], 0, 0, 0); __builtin_amdgcn_s_setprio(0); } while (0)
#define G_WAIT_V(n) asm volatile("s_waitcnt vmcnt(" #n ")" ::: "memory")
#define G_WAIT_L(n) asm volatile("s_waitcnt lgkmcnt(" #n ")" ::: "memory")
#define G_BAR __builtin_amdgcn_s_barrier()
#define G_SCHED __builtin_amdgcn_sched_barrier(0)
#define G_ROWS(u, v00, v01, v10, v11) do { const int rb_ = (u).pm * BM; const unsigned kb_ = (unsigned)K * 2u; \
        v00 = (unsigned)A.sel[rb_ + R0] * kb_ + (unsigned)C0 * 2u; v01 = (unsigned)A.sel[rb_ + R1] * kb_ + (unsigned)C1 * 2u; \
        v10 = (unsigned)A.sel[rb_ + HALF + R0] * kb_ + (unsigned)C0 * 2u; v11 = (unsigned)A.sel[rb_ + HALF + R1] * kb_ + (unsigned)C1 * 2u; \
        asm volatile("" : "+v"(v00), "+v"(v01), "+v"(v10), "+v"(v11)); } while (0)
    Unit cur, nxt; int ui = 0;
    if (!S.next(0, cur)) return;
    f32x4 acc[2][2][4][2];
#pragma unroll
    for (int a = 0; a < 2; ++a)
#pragma unroll
        for (int b = 0; b < 2; ++b)
#pragma unroll
            for (int m = 0; m < 4; ++m)
#pragma unroll
                for (int n = 0; n < 2; ++n) acc[a][b][m][n] = (f32x4){0.f, 0.f, 0.f, 0.f};
    bf16x8 At[4][2], B0[2][2], B1[2][2];
    unsigned vC00 = 0, vC01 = 0, vC10 = 0, vC11 = 0, vN00 = 0, vN01 = 0, vN10 = 0, vN11 = 0;
    const char* const aB = A.base;
    const char* cA = A.base + (size_t)cur.pm * tstep;
    const char* cB = B.base + (size_t)(cur.pm >> B.eshift) * B.estride + (size_t)cur.pn * tstep;
    if constexpr (GATHER) { G_ROWS(cur, vC00, vC01, vC10, vC11); }
    G_STB(G_SB(0, 0), cB); G_STB(G_SB(0, 1), cB + hstep); G_STA(G_SA(0, 0), cA, aB, vC00, vC01); G_STA(G_SA(0, 1), cA + hstep, aB, vC10, vC11);
    if (wr == 1) G_BAR;
    G_WAIT_V(2); G_BAR;
    G_STB(G_SB(1, 0), cB + kstep); G_STA(G_SA(1, 0), cA + kstep, aB + kstep, vC00, vC01); G_STB(G_SB(1, 1), cB + hstep + kstep);
    G_WAIT_V(6); G_BAR;
    for (;;) {
        const bool has_next = S.next(ui + 1, nxt);
        const char* nA = has_next ? A.base + (size_t)nxt.pm * tstep : cA;
        const char* nB = has_next ? B.base + (size_t)(nxt.pm >> B.eshift) * B.estride + (size_t)nxt.pn * tstep : cB;
        if constexpr (GATHER) {
            if (has_next && nxt.pm != cur.pm) { G_ROWS(nxt, vN00, vN01, vN10, vN11); }
            else { vN00 = vC00; vN01 = vC01; vN10 = vC10; vN11 = vC11; }
        }
        for (int t = 0; t < nt; t += 2) {
            const bool last = (t == nt - 2);
            const char* a1 = cA + (size_t)(t + 1) * kstep;
            const char* g1 = aB + (size_t)(t + 1) * kstep;
            const char* a2 = last ? nA : cA + (size_t)(t + 2) * kstep; const char* b2 = last ? nB : cB + (size_t)(t + 2) * kstep;
            const char* g2 = last ? aB : aB + (size_t)(t + 2) * kstep;
            const char* a3 = a2 + kstep; const char* b3 = b2 + kstep; const char* g3 = g2 + kstep;
            unsigned s00 = 0, s01 = 0, s10 = 0, s11 = 0;
            if constexpr (GATHER) { s00 = last ? vN00 : vC00; s01 = last ? vN01 : vC01; s10 = last ? vN10 : vC10; s11 = last ? vN11 : vC11; }
            G_LDB(B0, 0, 0); G_LDB(B1, 0, 1); G_SCHED; G_LDA(At, 0, 0); G_STA(G_SA(1, 1), a1 + hstep, g1, vC10, vC11);
            G_WAIT_V(8); G_WAIT_L(0); G_BAR; G_MMA(0, 0, At, B0); G_MMA(0, 1, At, B1); G_BAR; G_SCHED;
            G_LDA(At, 0, 1); G_STB(G_SB(0, 0), b2); G_STB(G_SB(0, 1), b2 + hstep); G_STA(G_SA(0, 0), a2, g2, s00, s01);
            G_WAIT_V(8); G_WAIT_L(0); G_BAR; G_MMA(1, 0, At, B0); G_MMA(1, 1, At, B1); G_BAR; G_SCHED;
            G_LDB(B0, 1, 0); G_LDB(B1, 1, 1); G_SCHED; G_LDA(At, 1, 0); G_STA(G_SA(0, 1), a2 + hstep, g2, s10, s11);
            G_WAIT_V(8); G_WAIT_L(0); G_BAR; G_MMA(0, 0, At, B0); G_MMA(0, 1, At, B1); G_BAR; G_SCHED;
            G_LDA(At, 1, 1); G_STB(G_SB(1, 0), b3); G_STB(G_SB(1, 1), b3 + hstep); G_STA(G_SA(1, 0), a3, g3, s00, s01);
            G_WAIT_V(8); G_WAIT_L(0); G_BAR; G_MMA(1, 0, At, B0); G_MMA(1, 1, At, B1); G_BAR; G_SCHED;
        }
        if (wr == 0) G_BAR;
        E(acc, cur, wr, wc, fr, fq);
        if (!has_next) break;
#pragma unroll
        for (int a = 0; a < 2; ++a)
#pragma unroll
            for (int b = 0; b < 2; ++b)
#pragma unroll
                for (int m = 0; m < 4; ++m)
#pragma unroll
                    for (int n = 0; n < 2; ++n) acc[a][b][m][n] = (f32x4){0.f, 0.f, 0.f, 0.f};
        cur = nxt; cA = nA; cB = nB; ++ui;
        if constexpr (GATHER) { vC00 = vN00; vC01 = vN01; vC10 = vN10; vC11 = vN11; }
        if (wr == 1) G_BAR;
    }
    G_WAIT_V(0);
    G_BAR;
#undef G_SA
#undef G_SB
#undef G_LDS2
#undef G_STB
#undef G_STA
#undef G_LDA
#undef G_LDB
#undef G_MMA
#undef G_WAIT_V
#undef G_WAIT_L
#undef G_BAR
#undef G_SCHED
#undef G_ROWS
}

struct EpiQKV {
    static constexpr bool PERM = true;
    bf16_t* O; const float* rope;
    __device__ __forceinline__ void operator()(const f32x4 (&acc)[2][2][4][2], const Unit& u, int wr, int wc, int fr, int fq) const {
        const int row0 = u.pm * BM + wr * 64 + fr, col0 = u.pn * BM + wc * 32 + 8 * fq;
        const bool do_rope = u.pn < 4;
        const float sc = (u.pn < 2 || (u.pn >= 6 && u.pn < 8)) ? QSCALE : 1.0f;
        const int i0 = (wc & 1) * 16 + 4 * fq;
#pragma unroll
        for (int ai = 0; ai < 2; ++ai)
#pragma unroll
            for (int m = 0; m < 4; ++m) {
                const int row = row0 + ai * HALF + m * 16;
                bf16_t* rowp = O + (size_t)row * NQKV + col0;
                f32x4 cs0 = (f32x4){1.f, 0.f, 1.f, 0.f}, cs1 = cs0;
                if (do_rope) { const float* rp = rope + ((size_t)(row & (T - 1)) * 32 + i0) * 2; cs0 = *(const f32x4*)rp; cs1 = *(const f32x4*)(rp + 4); }
#pragma unroll
                for (int bj = 0; bj < 2; ++bj) {
                    f32x4 v0 = acc[ai][bj][m][0], v1 = acc[ai][bj][m][1];
                    if (do_rope) {
                        const f32x4 a = v0, b = v1;
                        v0[0] = a[0] * cs0[0] - a[1] * cs0[1]; v0[1] = a[1] * cs0[0] + a[0] * cs0[1];
                        v0[2] = a[2] * cs0[2] - a[3] * cs0[3]; v0[3] = a[3] * cs0[2] + a[2] * cs0[3];
                        v1[0] = b[0] * cs1[0] - b[1] * cs1[1]; v1[1] = b[1] * cs1[0] + b[0] * cs1[1];
                        v1[2] = b[2] * cs1[2] - b[3] * cs1[3]; v1[3] = b[3] * cs1[2] + b[2] * cs1[3];
                    }
                    v0 = v0 * sc; v1 = v1 * sc;
                    u32x4 w; w.x = cvt_pk_bf16(v0[0], v0[1]); w.y = cvt_pk_bf16(v0[2], v0[3]); w.z = cvt_pk_bf16(v1[0], v1[1]); w.w = cvt_pk_bf16(v1[2], v1[3]);
                    *(u32x4*)(rowp + bj * HALF) = w;
                }
            }
    }
};
struct EpiResid {
    static constexpr bool PERM = false;
    const float* resid; float* out;
    __device__ __forceinline__ void operator()(const f32x4 (&acc)[2][2][4][2], const Unit& u, int wr, int wc, int fr, int fq) const {
        const int row0 = u.pm * BM + wr * 64 + fr, col0 = u.pn * BM + wc * 32 + 4 * fq;
#pragma unroll
        for (int ai = 0; ai < 2; ++ai)
#pragma unroll
            for (int m = 0; m < 4; ++m) { const size_t off = (size_t)(row0 + ai * HALF + m * 16) * D + col0;
#pragma unroll
                for (int bj = 0; bj < 2; ++bj)
#pragma unroll
                    for (int n = 0; n < 2; ++n) { const f32x4 r = *(const f32x4*)(resid + off + bj * HALF + n * 16); *(f32x4*)(out + off + bj * HALF + n * 16) = r + acc[ai][bj][m][n]; }
                if (m & 1) asm volatile("" ::: "memory"); }
    }
};
struct EpiSwiGLU {
    static constexpr bool PERM = true;
    bf16_t* O;
    __device__ __forceinline__ void operator()(const f32x4 (&acc)[2][2][4][2], const Unit& u, int wr, int wc, int fr, int fq) const {
        const int row0 = u.pm * BM + wr * 64 + fr, col0 = u.pn * HALF + wc * 32 + 8 * fq;
#pragma unroll
        for (int ai = 0; ai < 2; ++ai)
#pragma unroll
            for (int m = 0; m < 4; ++m) {
                bf16_t* rowp = O + (size_t)(row0 + ai * HALF + m * 16) * FF + col0;
                float r[8];
#pragma unroll
                for (int n = 0; n < 2; ++n)
#pragma unroll
                    for (int j = 0; j < 4; ++j) { const float g = acc[ai][0][m][n][j], up = acc[ai][1][m][n][j];
                        const float sg = __builtin_amdgcn_rcpf(1.0f + __builtin_amdgcn_exp2f(-g * LOG2E)); r[n * 4 + j] = g * sg * up; }
                u32x4 w; w.x = cvt_pk_bf16(r[0], r[1]); w.y = cvt_pk_bf16(r[2], r[3]); w.z = cvt_pk_bf16(r[4], r[5]); w.w = cvt_pk_bf16(r[6], r[7]);
                *(u32x4*)rowp = w;
            }
    }
};
struct EpiDown {
    static constexpr bool PERM = true;
    bf16_t* O; const float* gatev;
    __device__ __forceinline__ void operator()(const f32x4 (&acc)[2][2][4][2], const Unit& u, int wr, int wc, int fr, int fq) const {
        const int row0 = u.pm * BM + wr * 64 + fr, col0 = u.pn * BM + wc * 32 + 8 * fq;
#pragma unroll
        for (int ai = 0; ai < 2; ++ai)
#pragma unroll
            for (int m = 0; m < 4; ++m) {
                const int row = row0 + ai * HALF + m * 16; const float gv = gatev[row];
                bf16_t* rowp = O + (size_t)row * D + col0;
#pragma unroll
                for (int bj = 0; bj < 2; ++bj) { const f32x4 v0 = acc[ai][bj][m][0] * gv, v1 = acc[ai][bj][m][1] * gv;
                    u32x4 w; w.x = cvt_pk_bf16(v0[0], v0[1]); w.y = cvt_pk_bf16(v0[2], v0[3]); w.z = cvt_pk_bf16(v1[0], v1[1]); w.w = cvt_pk_bf16(v1[2], v1[3]);
                    *(u32x4*)(rowp + bj * HALF) = w; }
            }
    }
};
}

struct Frame {
    LAS unsigned char* lds;
    int tid, lane, wave, vcu, G;
    float* out; unsigned char* ws;
};
struct Args { const float* in[13]; float* out; unsigned char* ws; int ph_lo, ph_hi, li, pad; };
typedef __attribute__((address_space(4))) const Args CArgs;
__device__ __forceinline__ CArgs* kargs() { CArgs* p = (CArgs*)__builtin_amdgcn_kernarg_segment_ptr(); asm volatile("" : "+s"(p)); return p; }
#define KIN(k) (kargs()->in[k])

template <int MODE> __device__ __forceinline__ int dest_row(int n, int aux) {
    if (MODE == 1) return n < 1024 ? ((n & ~63) + 2 * (n & 31) + ((n >> 5) & 1)) : n;
    if (MODE == 2) return (n >> 7) * 256 + aux * 128 + (n & 127);
    return n;
}
template <int MODE> __device__ __forceinline__ void conv_item(const float* W, int K, int N, bf16_t* WT, int aux, LAS float* scr, int item, int lane) {
    const int nblk = N / 32, kb = item / nblk, nb = item - kb * nblk, k0 = 64 * kb, n0 = 32 * nb;
    f32x4 v[8];
#pragma unroll
    for (int it = 0; it < 8; ++it) { const int kk = 8 * it + (lane >> 3); v[it] = *(const f32x4*)(W + (size_t)(k0 + kk) * N + n0 + 4 * (lane & 7)); }
#pragma unroll
    for (int it = 0; it < 8; ++it) { const int kk = 8 * it + (lane >> 3); LAS float* s = scr + kk * 33 + 4 * (lane & 7); s[0] = v[it][0]; s[1] = v[it][1]; s[2] = v[it][2]; s[3] = v[it][3]; }
    LDS_WAIT(); asm volatile("" ::: "memory");
    const int c = lane & 7;
#pragma unroll
    for (int j = 0; j < 4; ++j) { const int n = (lane >> 3) + 8 * j; const LAS float* s = scr + (8 * c) * 33 + n;
        u32x4 o; o.x = cvt_pk_bf16(s[0 * 33], s[1 * 33]); o.y = cvt_pk_bf16(s[2 * 33], s[3 * 33]); o.z = cvt_pk_bf16(s[4 * 33], s[5 * 33]); o.w = cvt_pk_bf16(s[6 * 33], s[7 * 33]);
        *(u32x4*)(WT + (size_t)dest_row<MODE>(n0 + n, aux) * K + k0 + 8 * c) = o; }
    LDS_WAIT(); asm volatile("" ::: "memory");
}
__device__ __forceinline__ void conv_weights(Frame& F0, int l) {
    Frame F = F0; F.tid = fresh_v(F0.tid); F.lane = F.tid & 63; F.wave = fresh_s(F0.wave);
    LAS float* scr = (LAS float*)(F.lds + F.wave * 16384);
    const int gw = F.vcu * NWAVES + F.wave, NGW = F.G * NWAVES;
    constexpr int I_IN = (D / 64) * (NQKV / 32), I_OUT = (D / 64) * (D / 32), I_GE = (D / 64) * (FF / 32), I_DE = (FF / 64) * (D / 32);
    constexpr int NITEMS = I_IN + I_OUT + NE * (2 * I_GE + I_DE);
    CArgs* ka = kargs();
    const float* w_in = ka->in[2] + (size_t)l * D * NQKV; const float* w_out = ka->in[6] + (size_t)l * D * D;
    const float* w_gate = ka->in[9] + (size_t)l * NE * D * FF; const float* w_up = ka->in[10] + (size_t)l * NE * D * FF; const float* w_down = ka->in[11] + (size_t)l * NE * FF * D;
    bf16_t* WIN = (bf16_t*)(F.ws + WS_WIN); bf16_t* WOUT = (bf16_t*)(F.ws + WS_WOUT); bf16_t* WGU = (bf16_t*)(F.ws + WS_WGU); bf16_t* WD = (bf16_t*)(F.ws + WS_WD);
    for (int it = gw; it < NITEMS; it += NGW) {
        int r = it;
        if (r < I_IN) { conv_item<1>(w_in, D, NQKV, WIN, 0, scr, r, F.lane); continue; } r -= I_IN;
        if (r < I_OUT) { conv_item<0>(w_out, D, D, WOUT, 0, scr, r, F.lane); continue; } r -= I_OUT;
        if (r < NE * I_GE) { const int e = r / I_GE; conv_item<2>(w_gate + (size_t)e * D * FF, D, FF, WGU + (size_t)e * 2 * FF * D, 0, scr, r - e * I_GE, F.lane); continue; } r -= NE * I_GE;
        if (r < NE * I_GE) { const int e = r / I_GE; conv_item<2>(w_up + (size_t)e * D * FF, D, FF, WGU + (size_t)e * 2 * FF * D, 1, scr, r - e * I_GE, F.lane); continue; } r -= NE * I_GE;
        { const int e = r / I_DE; conv_item<0>(w_down + (size_t)e * FF * D, FF, D, WD + (size_t)e * D * FF, 0, scr, r - e * I_DE, F.lane); }
    }
}
__device__ const double INVF[32] = {
    1.0, 0.7498942093324559, 0.5623413251903491, 0.4216965034285822, 0.31622776601683794, 0.23713737056616552, 0.1778279410038923, 0.1333521432163324,
    0.1, 0.07498942093324558, 0.05623413251903491, 0.042169650342858224, 0.03162277660168379, 0.023713737056616554, 0.01778279410038923, 0.01333521432163324,
    0.01, 0.007498942093324558, 0.005623413251903491, 0.004216965034285823, 0.0031622776601683794, 0.0023713737056616554, 0.0017782794100389228, 0.001333521432163324,
    0.001, 0.0007498942093324559, 0.0005623413251903491, 0.00042169650342858224, 0.00031622776601683794, 0.00023713737056616554, 0.00017782794100389227, 0.0001333521432163324};
__device__ __forceinline__ void rope_table(Frame& F0) {
    Frame F = F0; F.tid = fresh_v(F0.tid); F.lane = F.tid & 63; F.wave = fresh_s(F0.wave);
    float* tab = (float*)(F.ws + WS_ROPE);
    for (int idx = F.vcu * NTHREADS + F.tid; idx < T * 32; idx += F.G * NTHREADS) {
        const int t = idx >> 5, i = idx & 31;
        const double ang = (double)t * INVF[i];
        const double n = __builtin_rint(ang * 0.15915494309189535);
        double r = __builtin_fma(-n, 6.283185307179586, ang); r = __builtin_fma(-n, 2.4492935982947064e-16, r);
        const double x = r * 0.25, x2 = x * x;
        double s = -1.0 / 1307674368000.0; s = s * x2 + 1.0 / 6227020800.0; s = s * x2 - 1.0 / 39916800.0; s = s * x2 + 1.0 / 362880.0; s = s * x2 - 1.0 / 5040.0; s = s * x2 + 1.0 / 120.0; s = s * x2 - 1.0 / 6.0; s = s * x2 + 1.0; s = s * x;
        double c = 1.0 / 20922789888000.0; c = c * x2 - 1.0 / 87178291200.0; c = c * x2 + 1.0 / 479001600.0; c = c * x2 - 1.0 / 3628800.0; c = c * x2 + 1.0 / 40320.0; c = c * x2 - 1.0 / 720.0; c = c * x2 + 1.0 / 24.0; c = c * x2 - 0.5; c = c * x2 + 1.0;
        const double s2 = 2.0 * s * c, c2 = 1.0 - 2.0 * s * s; const double s4 = 2.0 * s2 * c2, c4 = 1.0 - 2.0 * s2 * s2;
        *(f32x2*)(tab + (size_t)idx * 2) = (f32x2){(float)c4, (float)s4};
    }
}
__device__ __forceinline__ void store_bf16_row(bf16_t* orow, const f32x4 (&v)[4], int lane) {
    u32x2* o8 = (u32x2*)orow + lane;
#pragma unroll
    for (int j = 0; j < 4; ++j) { u32x2 w; w.x = cvt_pk_bf16(v[j][0], v[j][1]); w.y = cvt_pk_bf16(v[j][2], v[j][3]); o8[64 * j] = w; }
}
__device__ __forceinline__ float row_rstd(const f32x4 (&v)[4]) {
    float s = 0.f;
#pragma unroll
    for (int j = 0; j < 4; ++j) s += (v[j][0] * v[j][0] + v[j][1] * v[j][1]) + (v[j][2] * v[j][2] + v[j][3] * v[j][3]);
    return 1.0f / sqrtf(wave_sum(s) * (1.0f / D) + EPS);
}
__device__ __forceinline__ void norm1_phase(Frame& F0, const float* x, const float* gain) {
    Frame F = F0; F.tid = fresh_v(F0.tid); F.lane = F.tid & 63; F.wave = fresh_s(F0.wave);
    bf16_t* H = (bf16_t*)(F.ws + WS_H);
    const int gw = F.vcu * NWAVES + F.wave, NGW = F.G * NWAVES;
    f32x4 g[4];
#pragma unroll
    for (int j = 0; j < 4; ++j) g[j] = *((const f32x4*)gain + 64 * j + F.lane);
    for (int m = gw; m < M; m += NGW) {
        const f32x4* xr = (const f32x4*)(x + (size_t)m * D) + F.lane; f32x4 v[4];
#pragma unroll
        for (int j = 0; j < 4; ++j) v[j] = xr[64 * j];
        const float rstd = row_rstd(v);
#pragma unroll
        for (int j = 0; j < 4; ++j) v[j] = v[j] * rstd * g[j];
        store_bf16_row(H + (size_t)m * D, v, F.lane);
    }
}
constexpr int WR_STRIDE = 18;
__device__ __forceinline__ void norm2_router_phase(Frame& F0, const float* x1, const float* gain, const float* wr) {
    Frame F = F0; F.tid = fresh_v(F0.tid); F.lane = F.tid & 63; F.wave = fresh_s(F0.wave);
    bf16_t* H = (bf16_t*)(F.ws + WS_H); float* AFF = (float*)(F.ws + WS_AFF);
    LAS float* W = (LAS float*)F.lds;
    for (int idx = F.tid; idx < D * 4; idx += NTHREADS) { const int d = idx >> 2, q = idx & 3; const f32x4 w = *(const f32x4*)(wr + (size_t)d * NE + 4 * q);
        const int slot = (((d >> 8) * 4 + (d & 3)) << 6) + ((d >> 2) & 63); LAS float* p = W + slot * WR_STRIDE + 4 * q; p[0] = w[0]; p[1] = w[1]; p[2] = w[2]; p[3] = w[3]; }
    __syncthreads();
    const int gw = F.vcu * NWAVES + F.wave, NGW = F.G * NWAVES;
    f32x4 g[4];
#pragma unroll
    for (int j = 0; j < 4; ++j) g[j] = *((const f32x4*)gain + 64 * j + F.lane);
    for (int m = gw; m < M; m += NGW) {
        const f32x4* xr = (const f32x4*)(x1 + (size_t)m * D) + F.lane; f32x4 v[4];
#pragma unroll
        for (int j = 0; j < 4; ++j) v[j] = xr[64 * j];
        const float rstd = row_rstd(v);
#pragma unroll
        for (int j = 0; j < 4; ++j) v[j] = v[j] * rstd * g[j];
        store_bf16_row(H + (size_t)m * D, v, F.lane);
        float p[NE];
#pragma unroll
        for (int e = 0; e < NE; ++e) p[e] = 0.f;
#pragma unroll
        for (int j = 0; j < 4; ++j)
#pragma unroll
            for (int c = 0; c < 4; ++c) { const LAS f32x2* wp = (const LAS f32x2*)(W + (((j * 4 + c) << 6) + F.lane) * WR_STRIDE); const float hv = v[j][c];
#pragma unroll
                for (int q = 0; q < 8; ++q) { const f32x2 w = wp[q]; p[2 * q] += hv * w.x; p[2 * q + 1] += hv * w.y; } }
#pragma unroll
        for (int e = 0; e < NE; ++e) p[e] = wave_sum(p[e]);
        float mx = p[0];
#pragma unroll
        for (int e = 1; e < NE; ++e) mx = fmaxf(mx, p[e]);
        float sum = 0.f;
#pragma unroll
        for (int e = 0; e < NE; ++e) { p[e] = __expf(p[e] - mx); sum += p[e]; }
        const float inv = 1.0f / sum;
        float mine = 0.f;
#pragma unroll
        for (int e = 0; e < NE; ++e) mine = (F.lane == e) ? p[e] * inv : mine;
        if (F.lane < NE) AFF[((size_t)(m >> 13) * NE + F.lane) * T + (m & (T - 1))] = mine;
    }
    __syncthreads();
}
__device__ __forceinline__ void topk_phase(Frame& F0) {
    Frame F = F0; F.tid = fresh_v(F0.tid); F.lane = F.tid & 63; F.wave = fresh_s(F0.wave);
    const float* AFF = (const float*)(F.ws + WS_AFF); int* INV = (int*)(F.ws + WS_INV); int* SEL = (int*)(F.ws + WS_SEL); float* GATEV = (float*)(F.ws + WS_GATEV);
    LAS unsigned* hist = (LAS unsigned*)F.lds;
    LAS unsigned* suf = hist + 256;
    LAS unsigned* ctl = hist + 768;
    LAS unsigned* wtot = hist + 800;
    for (int task = F.vcu; task < BATCH * NE; task += F.G) {
        const int b = task >> 4, e = task & 15;
        const unsigned* src = (const unsigned*)(AFF + (size_t)task * T) + F.tid * 16;
        unsigned v[16];
#pragma unroll
        for (int q = 0; q < 4; ++q) { const u32x4 w = *((const u32x4*)src + q); v[4 * q] = w.x; v[4 * q + 1] = w.y; v[4 * q + 2] = w.z; v[4 * q + 3] = w.w; }
        unsigned prefix = 0, remaining = CAP;
#pragma unroll 1
        for (int pass = 0; pass < 4; ++pass) {
            const int shift = 24 - 8 * pass;
            if (F.tid < 256) hist[F.tid] = 0u;
            __syncthreads();
#pragma unroll
            for (int j = 0; j < 16; ++j) { const bool match = (pass == 0) || ((v[j] >> (shift + 8)) == prefix); if (match) atomicAdd((unsigned*)&hist[(v[j] >> shift) & 255u], 1u); }
            __syncthreads();
            if (F.tid < 256) suf[F.tid] = hist[F.tid];
            if (F.tid == 0) suf[256] = 0u;
            __syncthreads();
#pragma unroll 1
            for (int o = 1; o < 256; o <<= 1) { unsigned a = 0u; if (F.tid < 256) { a = suf[F.tid]; if (F.tid + o < 256) a += suf[F.tid + o]; } __syncthreads(); if (F.tid < 256) suf[F.tid] = a; __syncthreads(); }
            if (F.tid < 256) { const unsigned sd = suf[F.tid], sn = suf[F.tid + 1]; if (sd >= remaining && sn < remaining) { ctl[0] = (unsigned)F.tid; ctl[1] = remaining - sn; } }
            __syncthreads();
            prefix = (prefix << 8) | ctl[0]; remaining = ctl[1];
            __syncthreads();
        }
        const unsigned thr = prefix, need_eq = remaining, n_gt = CAP - remaining;
        unsigned cnt = 0u;
#pragma unroll
        for (int j = 0; j < 16; ++j) cnt += (v[j] > thr ? 1u : 0u) + (v[j] == thr ? 0x10000u : 0u);
        unsigned inc = cnt;
#pragma unroll
        for (int o = 1; o < 64; o <<= 1) { const unsigned t = __shfl_up(inc, o); if (F.lane >= o) inc += t; }
        if (F.lane == 63) wtot[F.wave] = inc;
        __syncthreads();
        unsigned base = 0u;
#pragma unroll
        for (int w = 0; w < NWAVES; ++w) base += (w < F.wave) ? wtot[w] : 0u;
        unsigned run = base + inc - cnt;
        unsigned rg = run & 0xffffu, re = run >> 16;
        const int tbase = F.tid * 16;
#pragma unroll
        for (int j = 0; j < 16; ++j) {
            const int t = tbase + j; int slot = -1;
            if (v[j] > thr) { slot = (int)rg; ++rg; }
            else if (v[j] == thr) { if (re < need_eq) slot = (int)(n_gt + re); ++re; }
            const int gt = b * T + t;
            INV[(size_t)gt * NE + e] = slot >= 0 ? b * CAP + slot : -1;
            if (slot >= 0) { const int sr = e * (BATCH * CAP) + b * CAP + slot; SEL[sr] = gt; GATEV[sr] = __uint_as_float(v[j]); }
        }
        __syncthreads();
    }
}
template <bool FINAL>
__device__ __forceinline__ void combine_phase(Frame& F0, float* x  , const float* gain) {
    Frame F = F0; F.tid = fresh_v(F0.tid); F.lane = F.tid & 63; F.wave = fresh_s(F0.wave);
    const int* INV = (const int*)(F.ws + WS_INV); const bf16_t* YE = (const bf16_t*)(F.ws + WS_YE); bf16_t* H = (bf16_t*)(F.ws + WS_H);
    const int gw = F.vcu * NWAVES + F.wave, NGW = F.G * NWAVES;
    f32x4 g[4];
#pragma unroll
    for (int j = 0; j < 4; ++j) g[j] = *((const f32x4*)gain + 64 * j + F.lane);
    for (int m = gw; m < M; m += NGW) {
        f32x4* xr = (f32x4*)(x + (size_t)m * D) + F.lane; f32x4 v[4];
#pragma unroll
        for (int j = 0; j < 4; ++j) v[j] = xr[64 * j];
        const int myinv = INV[(size_t)m * NE + (F.lane & 15)];
        unsigned long long mask = __ballot(myinv >= 0) & 0xffffull;
        while (mask) {
            const int e = __builtin_ctzll(mask); mask &= mask - 1;
            const int slot = __builtin_amdgcn_readlane(myinv, e);
            const u32x2* yr = (const u32x2*)(YE + ((size_t)e * (BATCH * CAP) + slot) * D) + F.lane;
#pragma unroll
            for (int j = 0; j < 4; ++j) { const u32x2 w = yr[64 * j]; v[j][0] += bf_lo(w.x); v[j][1] += bf_hi(w.x); v[j][2] += bf_lo(w.y); v[j][3] += bf_hi(w.y); }
        }
        const float rstd = row_rstd(v);
        if (FINAL) {
#pragma unroll
            for (int j = 0; j < 4; ++j) xr[64 * j] = v[j] * rstd * g[j];
        } else {
#pragma unroll
            for (int j = 0; j < 4; ++j) xr[64 * j] = v[j];
#pragma unroll
            for (int j = 0; j < 4; ++j) v[j] = v[j] * rstd * g[j];
            store_bf16_row(H + (size_t)m * D, v, F.lane);
        }
    }
}

constexpr int ATT_VROW = 160;
constexpr int ATT_VBYTES = 32 * ATT_VROW;
constexpr int ATT_SSQ_OFF = NWAVES * ATT_VBYTES;
constexpr int ATT_BIAS_OFF = ATT_SSQ_OFF + 2 * 8 * 256 * 4;
constexpr int ATT_BIAS_PADF = 32, ATT_BIAS_TAILF = 64;
typedef short v4i16_t __attribute__((ext_vector_type(4)));
__device__ __forceinline__ s16x4 vtr(const LAS unsigned char* p) { return __builtin_bit_cast(s16x4, __builtin_amdgcn_ds_read_tr16_b64_v4i16((LAS v4i16_t*)p)); }

template <bool NA>
__device__ __forceinline__ void attn_task(const bf16_t* __restrict__ qkv, bf16_t* __restrict__ mix, LAS unsigned char* lds, int lane, int wave,
                                          int b, int h, int mblk, int r, int grow, int cb) {
    const int i = lane & 15, g = lane >> 4;
    const bf16_t* rowbase = qkv + (size_t)b * T * NQKV;
    const int tl = NA ? ((grow & 3) * 64 + 16 * cb + i) : (16 * i + r);
    const int tq = 256 * mblk + tl;
    const int qoff = (NA ? 1536 : 0) + h * 64 + 8 * g, koff = (NA ? 2048 : 512) + h * 64 + 8 * g;
    const bf16x8 Q0 = *(const bf16x8*)(rowbase + (size_t)tq * NQKV + qoff), Q1 = *(const bf16x8*)(rowbase + (size_t)tq * NQKV + qoff + 32);
    const int qrow = grow, qcol = 16 * cb + i;
    const int rs = min(max(qrow - 4, 0), 120), cs = min(max(qcol - 8, 0), 48), kc0 = min(max(16 * cb - 8, 0), 32);
    const LAS float* biasp = (const LAS float*)(lds + ATT_BIAS_OFF) + ATT_BIAS_PADF + ((h * 15 + (rs - qrow + 7)) * 31 + (kc0 - qcol + 15 + 4 * g));
    const int nsteps = NA ? 8 : 23;
    LAS unsigned char* vst = lds + wave * ATT_VBYTES + i * ATT_VROW + 16 * g;
    const LAS unsigned char* vrd = lds + wave * ATT_VBYTES + (4 * g + (i >> 2)) * ATT_VROW + (i & 3) * 8;
    bf16x8 Kn[2][2], Vn[2][2];
#define ATT_SEG(sidx, sl, sh, rp, Lm1, basepos) \
    if ((sidx) < 5) { sl = (sidx); sh = 4; rp = r; Lm1 = 511; basepos = 16 * mblk - 64; } \
    else if ((sidx) < 11) { sl = (sidx) - 5; sh = 2; rp = r & 3; Lm1 = 2047; basepos = 64 * mblk - 64; } \
    else { sl = (sidx) - 11; sh = 0; rp = 0; Lm1 = 8191; basepos = 256 * mblk - 64; }
#define ATT_LOAD(sidx) do { int sl_, sh_, rp_, Lm1_, bp_; if (!NA) { ATT_SEG(sidx, sl_, sh_, rp_, Lm1_, bp_) } \
        _Pragma("unroll") for (int T_ = 0; T_ < 2; ++T_) { int tok_; \
            if (NA) tok_ = (rs + (sidx)) * 64 + kc0 + 16 * T_ + i; \
            else { const int pos_ = bp_ + 32 * sl_ + 16 * T_ + i; tok_ = (min(max(pos_, 0), Lm1_) << sh_) + rp_; } \
            const bf16_t* p_ = rowbase + (size_t)tok_ * NQKV + koff; \
            Kn[T_][0] = *(const bf16x8*)p_; Kn[T_][1] = *(const bf16x8*)(p_ + 32); Vn[T_][0] = *(const bf16x8*)(p_ + 512); Vn[T_][1] = *(const bf16x8*)(p_ + 544); } } while (0)
    ATT_LOAD(0);
    f32x4 O[4];
#pragma unroll
    for (int n = 0; n < 4; ++n) O[n] = (f32x4){0.f, 0.f, 0.f, 0.f};
    float mrun = -1e30f, lrun = 0.f;
#pragma unroll 1
    for (int s = 0; s < nsteps; ++s) {
        bf16x8 Kc[2][2];
#pragma unroll
        for (int T_ = 0; T_ < 2; ++T_) { Kc[T_][0] = Kn[T_][0]; Kc[T_][1] = Kn[T_][1];
            *(LAS bf16x8*)(vst + T_ * 16 * ATT_VROW) = Vn[T_][0]; *(LAS bf16x8*)(vst + T_ * 16 * ATT_VROW + 64) = Vn[T_][1]; }
        if (s + 1 < nsteps) ATT_LOAD(s + 1);
        f32x4 sc[2];
#pragma unroll
        for (int T_ = 0; T_ < 2; ++T_) { sc[T_] = __builtin_amdgcn_mfma_f32_16x16x32_bf16(Kc[T_][0], Q0, (f32x4){0.f, 0.f, 0.f, 0.f}, 0, 0, 0);
            sc[T_] = __builtin_amdgcn_mfma_f32_16x16x32_bf16(Kc[T_][1], Q1, sc[T_], 0, 0, 0); }
        int lo, span, x0;
        if (NA) { lo = cs - kc0 - 4 * g; span = 15; x0 = 0; }
        else { int sl_, sh_, rp_, Lm1_, bp_; ATT_SEG(s, sl_, sh_, rp_, Lm1_, bp_) (void)rp_;
            const int pq = tq >> sh_;
            lo = max(pq - 64, 0) - bp_ - 4 * g; span = (min(pq + 64, Lm1_) - bp_ - 4 * g) - lo; x0 = 32 * sl_; }
        bool valid[2][4]; float mloc = -1e30f;
#pragma unroll
        for (int T_ = 0; T_ < 2; ++T_)
#pragma unroll
            for (int q = 0; q < 4; ++q) { valid[T_][q] = (unsigned)(x0 + 16 * T_ + q - lo) <= (unsigned)span;
                float v = sc[T_][q]; if (NA) v += biasp[s * 31 + 16 * T_ + q];
                v = valid[T_][q] ? v : -1e30f; sc[T_][q] = v; mloc = fmaxf(mloc, v); }
        mloc = fmaxf(mloc, __shfl_xor(mloc, 16)); mloc = fmaxf(mloc, __shfl_xor(mloc, 32));
        const float mnew = fmaxf(mrun, mloc), alpha = __builtin_amdgcn_exp2f(mrun - mnew); mrun = mnew;
        float psum = 0.f;
#pragma unroll
        for (int T_ = 0; T_ < 2; ++T_)
#pragma unroll
            for (int q = 0; q < 4; ++q) { const float p = valid[T_][q] ? __builtin_amdgcn_exp2f(sc[T_][q] - mnew) : 0.f; sc[T_][q] = p; psum += p; }
        lrun = lrun * alpha + psum;
#pragma unroll
        for (int n = 0; n < 4; ++n) O[n] = O[n] * alpha;
        u32x4 pw; pw.x = cvt_pk_bf16(sc[0][0], sc[0][1]); pw.y = cvt_pk_bf16(sc[0][2], sc[0][3]); pw.z = cvt_pk_bf16(sc[1][0], sc[1][1]); pw.w = cvt_pk_bf16(sc[1][2], sc[1][3]);
        const bf16x8 Pf = __builtin_bit_cast(bf16x8, pw);
#pragma unroll
        for (int n = 0; n < 4; ++n) { const s16x4 a = vtr(vrd + n * 32), c = vtr(vrd + 16 * ATT_VROW + n * 32);
            const bf16x8 Vf = (bf16x8){a[0], a[1], a[2], a[3], c[0], c[1], c[2], c[3]};
            O[n] = __builtin_amdgcn_mfma_f32_16x16x32_bf16(Vf, Pf, O[n], 0, 0, 0); }
    }
#undef ATT_LOAD
#undef ATT_SEG
    float lt = lrun; lt += __shfl_xor(lt, 16); lt += __shfl_xor(lt, 32);
    const float inv = 1.0f / lt;
    float ssq = 0.f;
    bf16_t* op = mix + ((size_t)b * T + tq) * D + (NA ? 512 : 0) + h * 64 + 4 * g;
#pragma unroll
    for (int n = 0; n < 4; ++n) { const f32x4 o = O[n] * inv; ssq += (o[0] * o[0] + o[1] * o[1]) + (o[2] * o[2] + o[3] * o[3]);
        u32x2 w; w.x = cvt_pk_bf16(o[0], o[1]); w.y = cvt_pk_bf16(o[2], o[3]); *(u32x2*)(op + 16 * n) = w; }
    ssq += __shfl_xor(ssq, 16); ssq += __shfl_xor(ssq, 32);
    if (g == 0) ((LAS float*)(lds + ATT_SSQ_OFF))[((NA ? 8 : 0) + h) * 256 + tl] = ssq;
}

__device__ __forceinline__ void attn_phase(Frame& F0, int l) {
    Frame F = F0; F.tid = fresh_v(F0.tid); F.lane = F.tid & 63; F.wave = fresh_s(F0.wave);
    const bf16_t* qkv = (const bf16_t*)(F.ws + WS_QKV); bf16_t* mix = (bf16_t*)(F.ws + WS_MIX);
    CArgs* ka = kargs();
    const float* rpb = ka->in[5] + (size_t)l * 8 * 15 * 31;
    const float* gd = ka->in[3] + (size_t)l * 512; const float* gn = ka->in[4] + (size_t)l * 512;
    LAS float* bias = (LAS float*)(F.lds + ATT_BIAS_OFF);
    for (int idx = F.tid; idx < ATT_BIAS_PADF + 8 * 15 * 31 + ATT_BIAS_TAILF; idx += NTHREADS) { const int j = idx - ATT_BIAS_PADF; bias[idx] = (j >= 0 && j < 8 * 15 * 31) ? rpb[j] * LOG2E : 0.f; }
    f32x4 gg[4];
    { const float* gp = (F.lane < 32) ? gd + 16 * F.lane : gn + 16 * (F.lane - 32);
#pragma unroll
      for (int j = 0; j < 4; ++j) gg[j] = *(const f32x4*)(gp + 4 * j); }
    __syncthreads();
    for (int tile = F.vcu; tile < 256; tile += F.G) {
        const int b = tile >> 5, mblk = tile & 31;
#pragma unroll 1
        for (int rd = 0; rd < 16; ++rd) attn_task<false>(qkv, mix, F.lds, F.lane, F.wave, b, rd >> 1, mblk, 8 * (rd & 1) + F.wave, 0, 0);
#pragma unroll 1
        for (int rd = 0; rd < 16; ++rd) attn_task<true>(qkv, mix, F.lds, F.lane, F.wave, b, rd >> 1, mblk, 0, 4 * mblk + 2 * (rd & 1) + (F.wave >> 2), F.wave & 3);
        VM_WAIT(); __syncthreads();
        const LAS float* ssq = (const LAS float*)(F.lds + ATT_SSQ_OFF);
        const int br = F.lane >> 5;
#pragma unroll 1
        for (int k = 0; k < 32; ++k) {
            const int tl = 32 * F.wave + k;
            float s = 0.f;
#pragma unroll
            for (int hh = 0; hh < 8; ++hh) s += ssq[(br * 8 + hh) * 256 + tl];
            const float rstd = 1.0f / sqrtf(s * (1.0f / 512.0f) + EPS);
            u32x4* p = (u32x4*)(mix + ((size_t)b * T + 256 * mblk + tl) * D + 16 * F.lane);
            u32x4 w0 = p[0], w1 = p[1];
            const unsigned in[8] = {w0.x, w0.y, w0.z, w0.w, w1.x, w1.y, w1.z, w1.w}; unsigned o[8];
#pragma unroll
            for (int q = 0; q < 8; ++q) { const float ga = gg[q >> 1][(q & 1) * 2], gb = gg[q >> 1][(q & 1) * 2 + 1]; o[q] = cvt_pk_bf16(bf_lo(in[q]) * rstd * ga, bf_hi(in[q]) * rstd * gb); }
            p[0] = (u32x4){o[0], o[1], o[2], o[3]}; p[1] = (u32x4){o[4], o[5], o[6], o[7]};
        }
        __syncthreads();
    }
}

__global__ void __launch_bounds__(NTHREADS, 2) mk_fwd(Args args) {
    extern __shared__ __attribute__((aligned(16))) unsigned char lds_raw[];
    Frame F;
    F.lds = (LAS unsigned char*)lds_raw;
    F.tid = threadIdx.x; F.lane = F.tid & 63; F.wave = __builtin_amdgcn_readfirstlane(F.tid >> 6);
    F.G = gridDim.x; { const int bx = blockIdx.x; F.vcu = (F.G % 8 == 0) ? (bx % 8) * (F.G / 8) + bx / 8 : bx; }
    F.out = args.out; F.ws = args.ws;
    volatile LAS unsigned* MISC = (volatile LAS unsigned*)(F.lds + MISC_OFF);
    if (F.tid < 16) MISC[F.tid] = 0u;
    __syncthreads();
    XcdBarrier bar; bar.bar = (unsigned*)(F.ws + WS_CTL) + CW_BAR; bar.x = 0; bar.st = nullptr;
    if (MK_N_LAUNCHES == 1) bar = xcd_barrier_post((unsigned*)(F.ws + WS_CTL) + CW_BAR, MISC + 8);
    const int lo = args.ph_lo, hi = args.ph_hi;
#define IN(k) (lo <= (k) && (k) < hi)
#define SEAM(k) do { if (IN(k) && IN((k) + 1)) xcd_barrier(bar); } while (0)
    bf16_t* H = (bf16_t*)(F.ws + WS_H); bf16_t* QKV = (bf16_t*)(F.ws + WS_QKV); bf16_t* MIX = (bf16_t*)(F.ws + WS_MIX);
    bf16_t* ACT = (bf16_t*)(F.ws + WS_ACT); bf16_t* YE = (bf16_t*)(F.ws + WS_YE);

    if (IN(0)) {
#if PM & 1
        conv_weights(F, 0);
#endif
#if PM & 2
        rope_table(F);
#endif
#if PM & 4
        norm1_phase(F, KIN(0), KIN(1));
#endif
    }
    SEAM(0);
#pragma unroll 1
    for (int l = 0; l < 2; ++l) {
        const int pb = 1 + 8 * l;
#if PM & 8
        if (IN(pb + 0)) {
            gm::StaticOrder S; S.init(M, NQKV, F.G, (int)blockIdx.x);
            gm::ASrc A{(const char*)H, nullptr, D}; gm::BSrc B{(const char*)(F.ws + WS_WIN), 31, 0};
            gm::EpiQKV E{QKV, (const float*)(F.ws + WS_ROPE)};
            gm::gemm_phase<gm::EpiQKV, false>(F.lds, A, B, S, E);
        }
#endif
        SEAM(pb + 0);
#if PM & 16
        if (IN(pb + 1)) attn_phase(F, l);
#endif
        SEAM(pb + 1);
#if PM & 32
        if (IN(pb + 2)) {
            gm::StaticOrder S; S.init(M, D, F.G, (int)blockIdx.x);
            gm::ASrc A{(const char*)MIX, nullptr, D}; gm::BSrc B{(const char*)(F.ws + WS_WOUT), 31, 0};
            gm::EpiResid E{l == 0 ? KIN(0) : (const float*)F.out, F.out};
            gm::gemm_phase<gm::EpiResid, false>(F.lds, A, B, S, E);
        }
#endif
        SEAM(pb + 2);
#if PM & 64
        if (IN(pb + 3)) norm2_router_phase(F, F.out, KIN(7) + (size_t)l * D, KIN(8) + (size_t)l * D * NE);
#endif
        SEAM(pb + 3);
#if PM & 128
        if (IN(pb + 4)) topk_phase(F);
#endif
        SEAM(pb + 4);
#if PM & 256
        if (IN(pb + 5)) {
            gm::StaticOrder S; S.init(MS, 2 * FF, F.G, (int)blockIdx.x);
            gm::ASrc A{(const char*)H, (const int*)(F.ws + WS_SEL), D}; gm::BSrc B{(const char*)(F.ws + WS_WGU), 5, (size_t)2 * FF * D * 2};
            gm::EpiSwiGLU E{ACT};
            gm::gemm_phase<gm::EpiSwiGLU, true>(F.lds, A, B, S, E);
        }
#endif
        SEAM(pb + 5);
#if PM & 512
        if (IN(pb + 6)) {
            gm::StaticOrder S; S.init(MS, D, F.G, (int)blockIdx.x);
            gm::ASrc A{(const char*)ACT, nullptr, FF}; gm::BSrc B{(const char*)(F.ws + WS_WD), 5, (size_t)D * FF * 2};
            gm::EpiDown E{YE, (const float*)(F.ws + WS_GATEV)};
            gm::gemm_phase<gm::EpiDown, false>(F.lds, A, B, S, E);
        }
#endif
        SEAM(pb + 6);
#if PM & 1024
        if (IN(pb + 7)) {
            if (l == 0) { conv_weights(F, 1); combine_phase<false>(F, F.out, KIN(1) + D); }
            else combine_phase<true>(F, F.out, KIN(12));
        }
#endif
        if (l == 0) SEAM(pb + 7);
    }
#undef IN
#undef SEAM
}

extern "C" void kernel_launch(void* const* d_in, const int* in_sizes, int n_in, void* d_out, int out_size, void* d_ws, size_t ws_size, hipStream_t stream) {
    static int grid = 0;
    if (grid == 0) {
        if (n_in != 13 || in_sizes[0] != M * D || out_size != M * D || ws_size < WS_END) {
            fprintf(stderr, "kernel_launch: unexpected problem (n_in %d, in0 %d, out %d, ws %zu < %zu); nothing launched\n", n_in, n_in > 0 ? in_sizes[0] : -1, out_size, ws_size, (size_t)WS_END); grid = -1; return; }
        int dev = 0, cus = 0, per_cu = 0;
        if (hipGetDevice(&dev) != hipSuccess || hipDeviceGetAttribute(&cus, hipDeviceAttributeMultiprocessorCount, dev) != hipSuccess) { grid = -1; return; }
        if (hipFuncSetAttribute((const void*)mk_fwd, hipFuncAttributeMaxDynamicSharedMemorySize, LDS_BYTES) != hipSuccess) { fprintf(stderr, "kernel_launch: hipFuncSetAttribute failed\n"); grid = -1; return; }
        if (hipOccupancyMaxActiveBlocksPerMultiprocessor(&per_cu, (const void*)mk_fwd, NTHREADS, LDS_BYTES) != hipSuccess || per_cu < 1) {
            fprintf(stderr, "kernel_launch: occupancy query reports %d workgroups per CU; nothing launched\n", per_cu); (void)hipGetLastError(); grid = -1; return; }
        grid = cus;
    }
    if (grid < 0) return;
    (void)hipMemsetAsync((char*)d_ws + WS_CTL, 0, CTL_BYTES, stream);
    Args a{};
    for (int i = 0; i < 13; ++i) a.in[i] = (const float*)d_in[i];
    a.out = (float*)d_out; a.ws = (unsigned char*)d_ws;
    if (MK_N_LAUNCHES == 1) {
        a.ph_lo = 0; a.ph_hi = NPH; a.li = 0;
        hipLaunchKernelGGL(mk_fwd, dim3(grid), dim3(NTHREADS), LDS_BYTES, stream, a);
    } else {
        for (int p = 0; p < NPH; ++p) { a.ph_lo = p; a.ph_hi = p + 1; a.li = p; hipLaunchKernelGGL(mk_fwd, dim3(grid), dim3(NTHREADS), LDS_BYTES, stream, a); }
    }
    const hipError_t le = hipPeekAtLastError();
    if (le != hipSuccess) fprintf(stderr, "kernel_launch: launch failed: %s\n", hipGetErrorName(le));
}
```

```cpp
#include <hip/hip_runtime.h>
#include <cstdio>
#include <cstdint>

#ifndef PM
#define PM 0xffff
#endif
#ifndef MK_N_LAUNCHES
#define MK_N_LAUNCHES 1
#endif

#define GAS __attribute__((address_space(1)))
#define LAS __attribute__((address_space(3)))
typedef unsigned short bf16_t;
typedef short bf16x8 __attribute__((ext_vector_type(8)));
typedef short s16x4 __attribute__((ext_vector_type(4)));
typedef float f32x4 __attribute__((ext_vector_type(4)));
typedef float f32x2 __attribute__((ext_vector_type(2)));
typedef unsigned u32x4 __attribute__((ext_vector_type(4)));
typedef unsigned u32x2 __attribute__((ext_vector_type(2)));
typedef int i32x4 __attribute__((ext_vector_type(4)));
typedef int v8i32 __attribute__((ext_vector_type(8)));
typedef GAS unsigned gu32;

constexpr int D = 1024, BATCH = 8, T = 8192, M = BATCH * T, NQKV = 3072, NE = 16, FF = 2816, CAP = 1024, MS = NE * BATCH * CAP;
constexpr int NWAVES = 8, NTHREADS = 512;
constexpr float EPS = 1e-6f;
constexpr float LOG2E = 1.4426950408889634f;
constexpr float QSCALE = 0.125f * LOG2E;
constexpr int NPH = 19;

constexpr size_t MiB = 1u << 20;
constexpr size_t WS_CTL = 0, CTL_BYTES = 1 * MiB;
constexpr size_t WS_ROPE = 2 * MiB;
constexpr size_t WS_AFF = 4 * MiB;
constexpr size_t WS_INV = 8 * MiB;
constexpr size_t WS_SEL = 12 * MiB;
constexpr size_t WS_GATEV = 12 * MiB + 512 * 1024;
constexpr size_t WS_RSTD = 13 * MiB;
constexpr size_t WS_RSS = 13 * MiB + 512 * 1024;
constexpr size_t WS_WIN = 16 * MiB;
constexpr size_t WS_WOUT = 22 * MiB;
constexpr size_t WS_WGU = 24 * MiB;
constexpr size_t WS_WD = 200 * MiB;
constexpr size_t WGU_BYTES = 88 * MiB, WD_BYTES = 44 * MiB;
constexpr size_t WS_H = 288 * MiB;
constexpr size_t WS_ACT = 416 * MiB;
constexpr size_t WS_QKV = 416 * MiB;
constexpr size_t WS_MIX = 800 * MiB;
constexpr size_t WS_YE = 1120 * MiB;
constexpr size_t WS_END = 1376 * MiB;
constexpr size_t WS_PARTA = 928 * MiB, WS_PARTB = 992 * MiB, WS_LSEP = 1056 * MiB;
constexpr int CW_BAR = 4096;

constexpr int RING_BYTES = 131072;
constexpr int MISC_OFF = RING_BYTES;
constexpr int GOFF_OFF = MISC_OFF + 64;
constexpr int LDS_BYTES = 147456;

#define LDS_WAIT() asm volatile("s_waitcnt lgkmcnt(0)" ::: "memory")
#define VM_WAIT() asm volatile("s_waitcnt vmcnt(0)" ::: "memory")
__device__ __forceinline__ unsigned cvt_pk_bf16(float lo, float hi) { unsigned r; asm volatile("v_cvt_pk_bf16_f32 %0, %1, %2" : "=v"(r) : "v"(lo), "v"(hi)); return r; }
constexpr float YSCALE = 8.0f;
constexpr float WSCALE = 32.0f, WINV = 1.0f / 32.0f;
__device__ __forceinline__ unsigned pk4_fp8(float a, float b, float c, float d) { int w = __builtin_amdgcn_cvt_pk_fp8_f32(a, b, 0, false); w = __builtin_amdgcn_cvt_pk_fp8_f32(c, d, w, true); return (unsigned)w; }
__device__ __forceinline__ float bf_lo(unsigned w) { return __uint_as_float(w << 16); }
__device__ __forceinline__ float bf_hi(unsigned w) { return __uint_as_float(w & 0xffff0000u); }
__device__ __forceinline__ int fresh_v(int v) { asm volatile("" : "+v"(v)); return v; }
__device__ __forceinline__ int fresh_s(int v) { asm volatile("" : "+s"(v)); return v; }
__device__ __forceinline__ float wave_sum(float v) {
#pragma unroll
    for (int o = 1; o < 64; o <<= 1) v += __shfl_xor(v, o);
    return v;
}

#define XB_TMO      128
#define XB_XCNT(j)  (256  + 64 * (j))
#define XB_XSUB(j)  (1280 + 64 * (j))
#define XB_XGEN(j)  (2304 + 64 * (j))
#define XB_TOP      3328
#define XB_TOPGEN   3392
#define XCD_BAR_WORDS 3456
#define XB_SPIN_CAP (1u << 18)
__device__ __forceinline__ unsigned xb_ld(unsigned* p)              { return __hip_atomic_load(p, __ATOMIC_RELAXED, __HIP_MEMORY_SCOPE_AGENT); }
__device__ __forceinline__ unsigned xb_add(unsigned* p, unsigned v) { return __hip_atomic_fetch_add(p, v, __ATOMIC_RELAXED, __HIP_MEMORY_SCOPE_AGENT); }
__device__ __forceinline__ unsigned xb_xcc_id() { return (unsigned)__builtin_amdgcn_s_getreg((3 << 11) | 20) & 0xFu; }
#define XB_SPIN(cond, bar) do { unsigned _sp = 0; while (cond) { __builtin_amdgcn_s_sleep(1); \
    if ((++_sp & 255u) == 0u) { if (xb_ld(&(bar)[XB_TMO])) break; if (_sp > XB_SPIN_CAP) { atomicAdd(&(bar)[XB_TMO], 1u); break; } } } } while (0)
struct XcdBarrier { unsigned* bar; unsigned x; volatile LAS unsigned* st; };
__device__ __forceinline__ XcdBarrier xcd_barrier_post(unsigned* bar, volatile LAS unsigned* st) {
    XcdBarrier b; b.bar = bar; b.x = xb_xcc_id(); b.st = st;
    if (threadIdx.x == 0) (void)xb_add(&bar[XB_XCNT(b.x)], 1u);
    return b;
}
__device__ __forceinline__ void xcd_barrier_complete(unsigned* bar, unsigned x, unsigned& nloc, unsigned& nx) {
    const unsigned G = gridDim.x * gridDim.y * gridDim.z;
    unsigned sum, cnt, mine, sp = 0u;
    for (;;) {
        sum = 0u; cnt = 0u; mine = 0u;
#pragma unroll
        for (unsigned j = 0; j < 16; ++j) { const unsigned c = xb_ld(&bar[XB_XCNT(j)]); sum += c; cnt += (c > 0u) ? 1u : 0u; mine = (j == x) ? c : mine; }
        if (sum == G) break;
        __builtin_amdgcn_s_sleep(1);
        if ((++sp & 255u) == 0u) { if (xb_ld(&bar[XB_TMO])) break; if (sp > XB_SPIN_CAP) { atomicAdd(&bar[XB_TMO], 1u); break; } }
    }
    nloc = mine > 0u ? mine : 1u; nx = cnt > 0u ? cnt : 1u;
}
__device__ __forceinline__ void xcd_barrier(const XcdBarrier& b) {
    asm volatile("s_waitcnt vmcnt(0)" ::: "memory");
    __syncthreads();
    if (threadIdx.x == 0) {
        unsigned* bar = b.bar;
        __builtin_amdgcn_s_waitcnt(0);
        unsigned nloc = b.st[0], nx = b.st[1];
        if (nloc == 0u) { xcd_barrier_complete(bar, b.x, nloc, nx); b.st[0] = nloc; b.st[1] = nx; }
        const unsigned old = xb_add(&bar[XB_XSUB(b.x)], 1u);
        const unsigned gen = old / nloc;
        if (old + 1u == (gen + 1u) * nloc) {
            __builtin_amdgcn_fence(__ATOMIC_RELEASE, "agent");
            asm volatile("s_waitcnt vmcnt(0)" ::: "memory");
            const unsigned og = xb_add(&bar[XB_TOP], 1u);
            const unsigned tg = og / nx;
            if (og + 1u == (tg + 1u) * nx) xb_add(&bar[XB_TOPGEN], 1u);
            else XB_SPIN(xb_ld(&bar[XB_TOPGEN]) == tg, bar);
            __builtin_amdgcn_fence(__ATOMIC_ACQUIRE, "agent");
            xb_add(&bar[XB_XGEN(b.x)], 1u);
            asm volatile("s_waitcnt vmcnt(0)" ::: "memory");
        } else {
            XB_SPIN(xb_ld(&bar[XB_XGEN(b.x)]) == gen, bar);
            __builtin_amdgcn_fence(__ATOMIC_ACQUIRE, "agent");
            asm volatile("s_waitcnt vmcnt(0)" ::: "memory");
        }
    }
    __syncthreads();
}

struct Args { const float* in[13]; float* out; unsigned char* ws; int ph_lo, ph_hi, li, pad; };
typedef __attribute__((address_space(4))) const Args CArgs;
__device__ __forceinline__ CArgs* kargs() { CArgs* p = (CArgs*)__builtin_amdgcn_kernarg_segment_ptr(); asm volatile("" : "+s"(p)); return p; }
#define KIN(k) (kargs()->in[k])

constexpr int CV_IGE = (D / 64) * (FF / 32), CV_IDE = (FF / 64) * (D / 32);
constexpr int CV_ITEMS = NE * (2 * CV_IGE + CV_IDE);
struct CvDesc { const float* W; unsigned char* WT; int N, K, rowb; };
__device__ __forceinline__ CvDesc cv_desc(unsigned char* ws, int l, int g) {
    CArgs* ka = kargs(); CvDesc d; int r = g < CV_ITEMS ? g : CV_ITEMS - 1;
    if (r < 2 * NE * CV_IGE) { const int aux = r >= NE * CV_IGE ? 1 : 0; r -= aux * NE * CV_IGE; const int e = r / CV_IGE, it = r - e * CV_IGE, kb = it / (FF / 32), nb = it - kb * (FF / 32), n0 = 32 * nb;
        d.W = (aux ? ka->in[10] : ka->in[9]) + (size_t)l * NE * D * FF + (size_t)e * D * FF + (size_t)(64 * kb) * FF + n0; d.N = FF; d.K = D;
        d.WT = ws + WS_WGU + (size_t)l * WGU_BYTES + (size_t)e * 2 * FF * D + 64 * kb; d.rowb = (n0 >> 7) * 256 + aux * 128 + (n0 & 127); }
    else { r -= 2 * NE * CV_IGE; const int e = r / CV_IDE, it = r - e * CV_IDE, kb = it >> 5, nb = it & 31;
        d.W = ka->in[11] + (size_t)l * NE * FF * D + (size_t)e * FF * D + (size_t)(64 * kb) * D + 32 * nb; d.N = D; d.K = FF;
        d.WT = ws + WS_WD + (size_t)l * WD_BYTES + (size_t)e * D * FF + 64 * kb; d.rowb = 32 * nb; }
    return d;
}
__device__ __forceinline__ void cv_load_tile(f32x4 (&cv)[4], const CvDesc& d, int tt, int lane) {
    const float* p = d.W + (size_t)(4 * (lane >> 3) + 32 * tt) * d.N + 4 * (lane & 7);
#pragma unroll
    for (int kk = 0; kk < 4; ++kk) cv[kk] = *(const f32x4*)(p + (size_t)kk * d.N);
}
__device__ __forceinline__ void cv_store_tile(const f32x4 (&cv)[4], const CvDesc& d, int tt, int lane) {
    unsigned char* q = d.WT + (size_t)(d.rowb + 4 * (lane & 7)) * d.K + 4 * (lane >> 3) + 32 * tt;
#pragma unroll
    for (int j = 0; j < 4; ++j) *(unsigned*)(q + (size_t)j * d.K) = pk4_fp8(cv[0][j] * WSCALE, cv[1][j] * WSCALE, cv[2][j] * WSCALE, cv[3][j] * WSCALE);
}
template <bool B> struct BoolC { static constexpr bool value = B; };
namespace gm {
constexpr int BM = 256, BK = 64, HALF = 128, HTB = HALF * BK * 2, STAGE_BYTES = 8 * HTB, NXCD = 8, WGM = 8;
__host__ __device__ __forceinline__ int lds_byte(int r, int c) { const int st = (r >> 4) * 2 + (c >> 5), rr = r & 15, cc = c & 31, ob = rr * 64 + cc * 2; return st * 1024 + (ob ^ (((ob >> 9) & 1) << 5)); }
__host__ __device__ __forceinline__ void stage_rc(int b, int& R, int& C) { const int st = b / 1024, sb = b % 1024, swz = sb ^ (((sb >> 9) & 1) << 5); R = (st >> 1) * 16 + swz / 64; C = (st & 1) * 32 + (swz % 64) / 2; }
__host__ __device__ __forceinline__ int sig2(int x) { return ((x & 1) << 1) | (x >> 1); }
__host__ __device__ __forceinline__ int perm32(int rho) { const int n = rho >> 4, i = rho & 15; return 8 * sig2(i >> 2) + 4 * n + (i & 3); }
struct Unit { int pm, pn; };
struct StaticOrder {
    int nM, nN, nwg, G, c;
    __device__ void init(int Mr, int N, int G_, int c_) { nM = Mr / BM; nN = N / BM; nwg = nM * nN; G = G_; c = c_; }
    __device__ bool next(int i, Unit& u) const {
        const long L = (long)i * G + c; if (L >= nwg) return false;
        int wgid = (int)L; { const int q = nwg / NXCD, r = nwg % NXCD, xcd = wgid % NXCD, off = wgid / NXCD; wgid = (xcd < r ? xcd * (q + 1) : r * (q + 1) + (xcd - r) * q) + off; }
        const int nig = WGM * nN, gid = wgid / nig, fm = gid * WGM, gsz = (nM - fm) < WGM ? (nM - fm) : WGM;
        u.pm = fm + ((wgid % nig) % gsz); u.pn = (wgid % nig) / gsz; return true;
    }
};
struct ASrc { const char* base; const int* sel; int K; const float* rss; };
struct BSrc { const char* base; int eshift; size_t estride; };

template <class Epi, bool GATHER, bool FP8>
#ifndef GPROBE
#define GPROBE 0
#endif
__device__ __forceinline__ void gemm_phase(LAS unsigned char* lds, const ASrc A, const BSrc B, const StaticOrder& S, const Epi& E, unsigned long long& gp_acc) {
    unsigned long long gp_t = 0ull; (void)gp_t; (void)gp_acc;
    const int tid = fresh_v(threadIdx.x), wid = __builtin_amdgcn_readfirstlane(tid >> 6), lane = tid & 63, wr = wid >> 2, wc = wid & 3, fr = lane & 15, fq = lane >> 4;
    const int K = A.K, KB = FP8 ? K : 2 * K, nt = KB / (BK * 2);
    unsigned voffA0, voffA1, voffB0, voffB1;
    { int R0, R1, C0, C1; stage_rc(tid * 16, R0, C0); stage_rc(tid * 16 + 8192, R1, C1);
      const int Rb0 = Epi::PERM ? ((R0 & ~31) + perm32(R0 & 31)) : R0, Rb1 = Epi::PERM ? ((R1 & ~31) + perm32(R1 & 31)) : R1;
      voffA0 = (unsigned)(R0 * KB + C0 * 2); voffA1 = (unsigned)(R1 * KB + C1 * 2); voffB0 = (unsigned)(Rb0 * KB + C0 * 2); voffB1 = (unsigned)(Rb1 * KB + C1 * 2); }
    const unsigned kstep = (unsigned)(BK * 2);
    const unsigned hstep = (unsigned)HALF * (unsigned)KB;
    const unsigned tstep = 2u * hstep;
    const unsigned ldsw = (unsigned)wid * 1024u;
    const int aoff = lds_byte(wr * 64 + fr, fq * 8), boff = lds_byte(wc * 32 + fr, fq * 8);
    const __amdgpu_buffer_rsrc_t rA = __builtin_amdgcn_make_buffer_rsrc((void*)A.base, 0, 0xffffffff, 0x00020000);
    const __amdgpu_buffer_rsrc_t rB = __builtin_amdgcn_make_buffer_rsrc((void*)B.base, 0, 0xffffffff, 0x00020000);
#define G_SA(b, h) (((b) * 2 + (h)) * HTB)
#define G_SB(b, h) ((4 + (b) * 2 + (h)) * HTB)
#define G_LDS2(bufoff, rs, so, o0, o1) do { \
        __builtin_amdgcn_raw_ptr_buffer_load_lds(rs, (LAS unsigned*)(lds + (bufoff) + ldsw), 16, (o0), (so), 0, 0); \
        __builtin_amdgcn_raw_ptr_buffer_load_lds(rs, (LAS unsigned*)(lds + (bufoff) + ldsw + 8192), 16, (o1), (so), 0, 0); } while (0)
#define G_STB(bufoff, so) G_LDS2(bufoff, rB, so, voffB0, voffB1)
#define G_STA(bufoff, DSO, GSO, g0, g1) do { if constexpr (GATHER) { G_LDS2(bufoff, rA, GSO, g0, g1); } else { G_LDS2(bufoff, rA, DSO, voffA0, voffA1); } } while (0)
#define G_RD8(p) __builtin_shufflevector(*(const LAS i32x4*)(p), *(const LAS i32x4*)((p) + 1024), 0, 1, 2, 3, 4, 5, 6, 7)
#define G_LDA(dst, b, h) do { if constexpr (FP8) { _Pragma("unroll") for (int m = 0; m < 4; ++m) dst##8[m] = G_RD8(lds + G_SA(b, h) + aoff + m * 2048); } \
        else { _Pragma("unroll") for (int m = 0; m < 4; ++m) _Pragma("unroll") for (int k = 0; k < 2; ++k) dst[m][k] = *(const LAS bf16x8*)(lds + G_SA(b, h) + aoff + m * 2048 + k * 1024); } } while (0)
#define G_LDB(dst, b, h) do { if constexpr (FP8) { _Pragma("unroll") for (int n = 0; n < 2; ++n) dst##8[n] = G_RD8(lds + G_SB(b, h) + boff + n * 2048); } \
        else { _Pragma("unroll") for (int n = 0; n < 2; ++n) _Pragma("unroll") for (int k = 0; k < 2; ++k) dst[n][k] = *(const LAS bf16x8*)(lds + G_SB(b, h) + boff + n * 2048 + k * 1024); } } while (0)
#define G_MMA(ai, bj, At, Bt) do { __builtin_amdgcn_s_setprio(1); _Pragma("unroll") for (int m = 0; m < 4; ++m) _Pragma("unroll") for (int n = 0; n < 2; ++n) { \
        if constexpr (FP8) acc[ai][bj][m][n] = __builtin_amdgcn_mfma_scale_f32_16x16x128_f8f6f4(Bt##8[n], At##8[m], acc[ai][bj][m][n], 0, 0, 0, 0, 0, 0); \
        else { _Pragma("unroll") for (int k = 0; k < 2; ++k) acc[ai][bj][m][n] = __builtin_amdgcn_mfma_f32_16x16x32_bf16(Bt[n][k], At[m][k], acc[ai][bj][m][n], 0, 0, 0); } } \
        __builtin_amdgcn_s_setprio(0); } while (0)
#define G_WAIT_V(n) asm volatile("s_waitcnt vmcnt(" #n ")" ::: "memory")
#define G_WAIT_L(n) asm volatile("s_waitcnt lgkmcnt(" #n ")" ::: "memory")
#define G_WAIT_V8F() do { if (fresh) { if (Epi::HOST && hprev) asm volatile("s_waitcnt vmcnt(%0)" :: "n"(8 + Epi::NST + 4) : "memory"); else asm volatile("s_waitcnt vmcnt(%0)" :: "n"(8 + Epi::NST) : "memory"); } \
        else asm volatile("s_waitcnt vmcnt(8)" ::: "memory"); } while (0)
#define G_BAR __builtin_amdgcn_s_barrier()
#define G_SCHED __builtin_amdgcn_sched_barrier(0)
#define G_ROWS(u, v00, v01, v10, v11) do { const int rb_ = (u).pm * BM; const unsigned kb_ = (unsigned)KB; int r0_, c0_, r1_, c1_; { const int tz_ = fresh_v(tid); stage_rc(tz_ * 16, r0_, c0_); stage_rc(tz_ * 16 + 8192, r1_, c1_); } \
        if (A.sel) { v00 = (unsigned)A.sel[rb_ + r0_] * kb_ + (unsigned)c0_ * 2u; v01 = (unsigned)A.sel[rb_ + r1_] * kb_ + (unsigned)c1_ * 2u; \
        v10 = (unsigned)A.sel[rb_ + HALF + r0_] * kb_ + (unsigned)c0_ * 2u; v11 = (unsigned)A.sel[rb_ + HALF + r1_] * kb_ + (unsigned)c1_ * 2u; } \
        else { v00 = (unsigned)(rb_ + r0_) * kb_ + (unsigned)c0_ * 2u; v01 = (unsigned)(rb_ + r1_) * kb_ + (unsigned)c1_ * 2u; \
        v10 = (unsigned)(rb_ + HALF + r0_) * kb_ + (unsigned)c0_ * 2u; v11 = (unsigned)(rb_ + HALF + r1_) * kb_ + (unsigned)c1_ * 2u; } \
        asm volatile("" : "+v"(v00), "+v"(v01), "+v"(v10), "+v"(v11)); } while (0)
#define G_BOFF(u) ((unsigned)((u).pm >> B.eshift) * (unsigned)B.estride + (unsigned)(u).pn * tstep)
    Unit cur, nxt; int ui = 0; bool fresh = false, hprev = false;
    if (!S.next(0, cur)) return;
    f32x4 acc[2][2][4][2];
#pragma unroll
    for (int a = 0; a < 2; ++a)
#pragma unroll
        for (int b = 0; b < 2; ++b)
#pragma unroll
            for (int m = 0; m < 4; ++m)
#pragma unroll
                for (int n = 0; n < 2; ++n) acc[a][b][m][n] = (f32x4){0.f, 0.f, 0.f, 0.f};
    bf16x8 At[4][2], B0[2][2], B1[2][2]; v8i32 At8[4], B08[2], B18[2];
    unsigned vC00 = 0, vC01 = 0, vC10 = 0, vC11 = 0;
    LAS u32x4* const gslot = (LAS u32x4*)(lds + GOFF_OFF) + tid;
    LAS float* const rstab = (LAS float*)(lds + GOFF_OFF + 8192);
    int rspar = 0;
    if constexpr (Epi::NEED_RS) { if (tid < BM) rstab[tid] = A.rss[cur.pm * BM + tid]; }
    unsigned cA = (unsigned)cur.pm * tstep;
    unsigned cB = G_BOFF(cur);
    if constexpr (GATHER) { G_ROWS(cur, vC00, vC01, vC10, vC11); }
    G_STB(G_SB(0, 0), cB); G_STB(G_SB(0, 1), cB + hstep); G_STA(G_SA(0, 0), cA, 0u, vC00, vC01); G_STA(G_SA(0, 1), cA + hstep, 0u, vC10, vC11);
    if (wr == 1) G_BAR;
    G_WAIT_V(2); G_BAR;
    G_STB(G_SB(1, 0), cB + kstep); G_STA(G_SA(1, 0), cA + kstep, kstep, vC00, vC01); G_STB(G_SB(1, 1), cB + hstep + kstep);
    G_WAIT_V(6); G_BAR;
    for (;;) {
        const bool has_next = S.next(ui + 1, nxt);
        const unsigned nA = has_next ? (unsigned)nxt.pm * tstep : cA;
        const unsigned nB = has_next ? G_BOFF(nxt) : cB;
        if constexpr (GATHER) {
            unsigned n00 = vC00, n01 = vC01, n10 = vC10, n11 = vC11;
            if (has_next && nxt.pm != cur.pm) { G_ROWS(nxt, n00, n01, n10, n11);
                if constexpr (Epi::NEED_RS) { if (tid < BM) rstab[(rspar ^ 1) * BM + tid] = A.rss[nxt.pm * BM + tid]; } }
            *gslot = (u32x4){n00, n01, n10, n11};
        }
        if (GPROBE == 1 && ui > 0) gp_acc += __builtin_amdgcn_s_memrealtime() - gp_t;
#pragma unroll 1
        for (int t = 0; t < nt; t += 2) {
            if (GPROBE == 2 && ui > 0 && t == 0) gp_t = __builtin_amdgcn_s_memrealtime();
            if (GPROBE == 2 && ui > 0 && t == 2) gp_acc += __builtin_amdgcn_s_memrealtime() - gp_t;
            if (GPROBE == 3 && t == 2) gp_t = __builtin_amdgcn_s_memrealtime();
            const bool last = (t == nt - 2);
            const unsigned a1 = cA + (unsigned)(t + 1) * kstep;
            const unsigned g1 = (unsigned)(t + 1) * kstep;
            const unsigned a2 = last ? nA : cA + (unsigned)(t + 2) * kstep; const unsigned b2 = last ? nB : cB + (unsigned)(t + 2) * kstep;
            const unsigned g2 = last ? 0u : (unsigned)(t + 2) * kstep;
            const unsigned a3 = a2 + kstep; const unsigned b3 = b2 + kstep; const unsigned g3 = g2 + kstep;
            G_LDB(B0, 0, 0); G_LDB(B1, 0, 1); G_SCHED; G_LDA(At, 0, 0); if (!fresh) G_STA(G_SA(1, 1), a1 + hstep, g1, vC10, vC11);
            if constexpr (GATHER) { if (last) { const u32x4 nv = *gslot; vC00 = nv.x; vC01 = nv.y; vC10 = nv.z; vC11 = nv.w; } }
            G_WAIT_V8F(); G_WAIT_L(0); G_BAR; G_MMA(0, 0, At, B0); G_MMA(0, 1, At, B1); G_BAR; G_SCHED;
            G_LDA(At, 0, 1); G_STB(G_SB(0, 0), b2); G_STB(G_SB(0, 1), b2 + hstep); G_STA(G_SA(0, 0), a2, g2, vC00, vC01);
            G_WAIT_V8F(); G_WAIT_L(0); G_BAR; G_MMA(1, 0, At, B0); G_MMA(1, 1, At, B1); G_BAR; G_SCHED;
            G_LDB(B0, 1, 0); G_LDB(B1, 1, 1); G_SCHED; G_LDA(At, 1, 0); G_STA(G_SA(0, 1), a2 + hstep, g2, vC10, vC11);
            G_WAIT_V8F(); fresh = false; G_WAIT_L(0); G_BAR; G_MMA(0, 0, At, B0); G_MMA(0, 1, At, B1); G_BAR; G_SCHED;
            G_LDA(At, 1, 1); G_STB(G_SB(1, 0), b3); G_STB(G_SB(1, 1), b3 + hstep); G_STA(G_SA(1, 0), a3, g3, vC00, vC01);
            G_WAIT_V(8); G_WAIT_L(0); G_BAR; G_MMA(1, 0, At, B0); G_MMA(1, 1, At, B1); G_BAR; G_SCHED;
        }
        if (GPROBE == 3) gp_acc += __builtin_amdgcn_s_memrealtime() - gp_t;
        if (GPROBE == 1) gp_t = __builtin_amdgcn_s_memrealtime();
        G_STA(G_SA(1, 1), nA + kstep + hstep, kstep, vC10, vC11);
        if (wr == 0) G_BAR;
        f32x4 cvr[4]; bool hnow = false;
        if constexpr (Epi::HOST) { hnow = ui < E.hostn; if (hnow) { const CvDesc cd = cv_desc(E.ws, 1, E.cvg0 + E.cvstep * (ui >> 1)); cv_load_tile(cvr, cd, ui & 1, lane); } }
        if constexpr (Epi::NEED_RS) E(acc, cur, wr, wc, fr, fq, rstab + rspar * BM); else E(acc, cur, wr, wc, fr, fq);
        if constexpr (Epi::HOST) { if (hnow) { const CvDesc cd = cv_desc(E.ws, 1, E.cvg0 + E.cvstep * (ui >> 1)); cv_store_tile(cvr, cd, ui & 1, lane); } }
        if (!has_next) break;
        if constexpr (Epi::NEED_RS) { if (nxt.pm != cur.pm) rspar ^= 1; }
#pragma unroll
        for (int a = 0; a < 2; ++a)
#pragma unroll
            for (int b = 0; b < 2; ++b)
#pragma unroll
                for (int m = 0; m < 4; ++m)
#pragma unroll
                    for (int n = 0; n < 2; ++n) acc[a][b][m][n] = (f32x4){0.f, 0.f, 0.f, 0.f};
        cur = nxt; cA = nA; cB = nB; ++ui; fresh = true; hprev = hnow;
        if (wr == 1) G_BAR;
    }
    G_WAIT_V(0);
    G_BAR;
#undef G_SA
#undef G_SB
#undef G_LDS2
#undef G_STB
#undef G_STA
#undef G_LDA
#undef G_LDB
#undef G_MMA
#undef G_RD8
#undef G_WAIT_V
#undef G_WAIT_L
#undef G_WAIT_V8F
#undef G_BAR
#undef G_SCHED
#undef G_ROWS
#undef G_BOFF
}

struct EpiQKV {
    static constexpr bool NEED_RS = false; static constexpr bool PERM = true; static constexpr bool HOST = false; static constexpr int NST = 16;
    bf16_t* O; const float* rope;
    __device__ __forceinline__ void operator()(const f32x4 (&acc)[2][2][4][2], const Unit& u, int wr, int wc, int fr, int fq) const {
        const int row0 = u.pm * BM + wr * 64 + fr, col0 = u.pn * BM + wc * 32 + 8 * sig2(fq);
        const bool do_rope = u.pn < 4;
        const float sc = (u.pn < 2 || (u.pn >= 6 && u.pn < 8)) ? QSCALE : 1.0f;
        const int i0 = (wc & 1) * 16 + 4 * sig2(fq);
        f32x4 cs[2][4][2];
#pragma unroll
        for (int ai = 0; ai < 2; ++ai)
#pragma unroll
            for (int m = 0; m < 4; ++m) { cs[ai][m][0] = (f32x4){1.f, 0.f, 1.f, 0.f}; cs[ai][m][1] = cs[ai][m][0];
                if (do_rope) { const float* rp = rope + ((size_t)((row0 + ai * HALF + m * 16) & (T - 1)) * 32 + i0) * 2; cs[ai][m][0] = *(const f32x4*)rp; cs[ai][m][1] = *(const f32x4*)(rp + 4); } }
#pragma unroll
        for (int ai = 0; ai < 2; ++ai)
#pragma unroll
            for (int m = 0; m < 4; ++m) {
                const int row = row0 + ai * HALF + m * 16;
                const int bb = row >> 13, tt = row & (T - 1);
                const f32x4 cs0 = cs[ai][m][0], cs1 = cs[ai][m][1];
#pragma unroll
                for (int bj = 0; bj < 2; ++bj) {
                    f32x4 v0 = acc[ai][bj][m][0], v1 = acc[ai][bj][m][1];
                    if (do_rope) {
                        const f32x4 a = v0, b = v1;
                        v0[0] = a[0] * cs0[0] - a[1] * cs0[1]; v0[1] = a[1] * cs0[0] + a[0] * cs0[1];
                        v0[2] = a[2] * cs0[2] - a[3] * cs0[3]; v0[3] = a[3] * cs0[2] + a[2] * cs0[3];
                        v1[0] = b[0] * cs1[0] - b[1] * cs1[1]; v1[1] = b[1] * cs1[0] + b[0] * cs1[1];
                        v1[2] = b[2] * cs1[2] - b[3] * cs1[3]; v1[3] = b[3] * cs1[2] + b[2] * cs1[3];
                    }
                    v0 = v0 * sc; v1 = v1 * sc;
                    u32x4 w; w.x = cvt_pk_bf16(v0[0], v0[1]); w.y = cvt_pk_bf16(v0[2], v0[3]); w.z = cvt_pk_bf16(v1[0], v1[1]); w.w = cvt_pk_bf16(v1[2], v1[3]);
                    const int cc = col0 + bj * HALF;
                    *(u32x4*)(O + ((((size_t)((cc >> 9) * BATCH + bb) * 8 + ((cc >> 6) & 7)) * T + tt) << 6) + (cc & 63)) = w;
                }
            }
    }
};
struct EpiBf16Out {
    static constexpr bool NEED_RS = false; static constexpr bool PERM = true; static constexpr bool HOST = false; static constexpr int NST = 16;
    bf16_t* O;
    __device__ __forceinline__ void operator()(const f32x4 (&acc)[2][2][4][2], const Unit& u, int wr, int wc, int fr, int fq) const {
        const int row0 = u.pm * BM + wr * 64 + fr, col0 = u.pn * BM + wc * 32 + 8 * sig2(fq);
#pragma unroll
        for (int ai = 0; ai < 2; ++ai)
#pragma unroll
            for (int m = 0; m < 4; ++m) { bf16_t* rowp = O + (size_t)(row0 + ai * HALF + m * 16) * D + col0;
#pragma unroll
                for (int bj = 0; bj < 2; ++bj) { const f32x4 v0 = acc[ai][bj][m][0], v1 = acc[ai][bj][m][1];
                    u32x4 w; w.x = cvt_pk_bf16(v0[0], v0[1]); w.y = cvt_pk_bf16(v0[2], v0[3]); w.z = cvt_pk_bf16(v1[0], v1[1]); w.w = cvt_pk_bf16(v1[2], v1[3]);
                    *(u32x4*)(rowp + bj * HALF) = w; } }
    }
};
struct EpiResid {
    static constexpr bool NEED_RS = false; static constexpr bool PERM = false; static constexpr bool HOST = false; static constexpr int NST = 0;
    const float* resid; float* out;
    __device__ __forceinline__ void operator()(const f32x4 (&acc)[2][2][4][2], const Unit& u, int wr, int wc, int fr, int fq) const {
        const int row0 = u.pm * BM + wr * 64 + fr, col0 = u.pn * BM + wc * 32 + 4 * fq;
#pragma unroll
        for (int ai = 0; ai < 2; ++ai)
#pragma unroll
            for (int m = 0; m < 4; ++m) { const size_t off = (size_t)(row0 + ai * HALF + m * 16) * D + col0;
#pragma unroll
                for (int bj = 0; bj < 2; ++bj)
#pragma unroll
                    for (int n = 0; n < 2; ++n) { const f32x4 r = *(const f32x4*)(resid + off + bj * HALF + n * 16); *(f32x4*)(out + off + bj * HALF + n * 16) = r + acc[ai][bj][m][n]; }
                if (m & 1) asm volatile("" ::: "memory"); }
    }
};
struct EpiSwiGLU {
    static constexpr bool NEED_RS = true; static constexpr bool PERM = true; static constexpr bool HOST = true; static constexpr int NST = 4;
    unsigned char* O; unsigned char* ws; int hostn, cvg0, cvstep;
    __device__ __forceinline__ void operator()(const f32x4 (&acc)[2][2][4][2], const Unit& u, int wr, int wc, int fr, int fq, const LAS float* rst) const {
        const int hi = fq >> 1;
        const int row0 = u.pm * BM + wr * 64 + fr + 16 * hi, col0 = u.pn * HALF + wc * 32 + 8 * sig2(fq) - 8 * hi;
#pragma unroll
        for (int ai = 0; ai < 2; ++ai)
#pragma unroll
            for (int mp = 0; mp < 2; ++mp) {
                u32x2 w[2];
#pragma unroll
                for (int mm = 0; mm < 2; ++mm) { const int m = 2 * mp + mm;
                    const float rs = rst[ai * HALF + wr * 64 + m * 16 + fr], ce = rs * (-LOG2E * WINV), q = (WSCALE * WSCALE) * __builtin_amdgcn_rcpf(rs * rs);
                    float r[8];
                    const f32x2 ce2 = (f32x2){ce, ce}, q2 = (f32x2){q, q};
#pragma unroll
                    for (int n = 0; n < 2; ++n)
#pragma unroll
                        for (int jp = 0; jp < 2; ++jp) {
                            const f32x2 G2 = (f32x2){acc[ai][0][m][n][2 * jp], acc[ai][0][m][n][2 * jp + 1]}, U2 = (f32x2){acc[ai][1][m][n][2 * jp], acc[ai][1][m][n][2 * jp + 1]};
                            const f32x2 x2 = G2 * ce2;
                            const f32x2 e2 = (f32x2){__builtin_amdgcn_exp2f(x2[0]), __builtin_amdgcn_exp2f(x2[1])};
                            const f32x2 d2 = __builtin_elementwise_fma(e2, q2, q2);
                            const f32x2 r2 = (f32x2){__builtin_amdgcn_rcpf(d2[0]), __builtin_amdgcn_rcpf(d2[1])};
                            const f32x2 o2 = (G2 * U2) * r2;
                            r[n * 4 + 2 * jp] = o2[0]; r[n * 4 + 2 * jp + 1] = o2[1]; }
                    w[mm].x = pk4_fp8(r[0], r[1], r[2], r[3]); w[mm].y = pk4_fp8(r[4], r[5], r[6], r[7]); }
                const auto sx = __builtin_amdgcn_permlane32_swap(w[0].x, w[1].x, false, false), sy = __builtin_amdgcn_permlane32_swap(w[0].y, w[1].y, false, false);
                u32x4 v; v.x = sx[0]; v.y = sy[0]; v.z = sx[1]; v.w = sy[1];
                *(u32x4*)(O + (size_t)(row0 + ai * HALF + mp * 32) * FF + col0) = v;
            }
    }
};
struct EpiDown {
    static constexpr bool NEED_RS = false; static constexpr bool PERM = true; static constexpr bool HOST = false; static constexpr int NST = 8;
    unsigned char* O; const float* gatev;
    __device__ __forceinline__ void operator()(const f32x4 (&acc)[2][2][4][2], const Unit& u, int wr, int wc, int fr, int fq) const {
        const int hi = fq >> 1;
        const int row0 = u.pm * BM + wr * 64 + fr + 16 * hi, col0 = u.pn * BM + wc * 32 + 8 * sig2(fq) - 8 * hi;
        const float gv = WINV * YSCALE;
#pragma unroll
        for (int ai = 0; ai < 2; ++ai)
#pragma unroll
            for (int mp = 0; mp < 2; ++mp) {
                unsigned char* rowp = O + (size_t)(row0 + ai * HALF + mp * 32) * D + col0;
#pragma unroll
                for (int bj = 0; bj < 2; ++bj) {
                    u32x2 w[2];
#pragma unroll
                    for (int mm = 0; mm < 2; ++mm) { const f32x4 v0 = acc[ai][bj][2 * mp + mm][0] * gv, v1 = acc[ai][bj][2 * mp + mm][1] * gv;
                        w[mm].x = pk4_fp8(v0[0], v0[1], v0[2], v0[3]); w[mm].y = pk4_fp8(v1[0], v1[1], v1[2], v1[3]); }
                    const auto sx = __builtin_amdgcn_permlane32_swap(w[0].x, w[1].x, false, false), sy = __builtin_amdgcn_permlane32_swap(w[0].y, w[1].y, false, false);
                    u32x4 v; v.x = sx[0]; v.y = sy[0]; v.z = sx[1]; v.w = sy[1];
                    *(u32x4*)(rowp + bj * HALF) = v; }
            }
    }
};
}

struct Frame {
    LAS unsigned char* lds;
    int tid, lane, wave, vcu, G;
    float* out; unsigned char* ws;
};
template <int MODE> __device__ __forceinline__ int dest_row(int n, int aux) {
    if (MODE == 1) return n < 1024 ? ((n & ~63) + 2 * (n & 31) + ((n >> 5) & 1)) : n;
    if (MODE == 2) return (n >> 7) * 256 + aux * 128 + (n & 127);
    return n;
}
template <int MODE> __device__ __forceinline__ void conv_item(const float* W, int K, int N, bf16_t* WT, int aux, LAS float* scr, int item, int lane) {
    const int nblk = N / 32, kb = item / nblk, nb = item - kb * nblk, k0 = 64 * kb, n0 = 32 * nb;
    f32x4 v[8];
#pragma unroll
    for (int it = 0; it < 8; ++it) { const int kk = 8 * it + (lane >> 3); v[it] = *(const f32x4*)(W + (size_t)(k0 + kk) * N + n0 + 4 * (lane & 7)); }
#pragma unroll
    for (int it = 0; it < 8; ++it) { const int kk = 8 * it + (lane >> 3); LAS float* s = scr + kk * 33 + 4 * (lane & 7); s[0] = v[it][0]; s[1] = v[it][1]; s[2] = v[it][2]; s[3] = v[it][3]; }
    LDS_WAIT(); asm volatile("" ::: "memory");
    const int c = lane & 7;
#pragma unroll
    for (int j = 0; j < 4; ++j) { const int n = (lane >> 3) + 8 * j; const LAS float* s = scr + (8 * c) * 33 + n;
        u32x4 o; o.x = cvt_pk_bf16(s[0 * 33], s[1 * 33]); o.y = cvt_pk_bf16(s[2 * 33], s[3 * 33]); o.z = cvt_pk_bf16(s[4 * 33], s[5 * 33]); o.w = cvt_pk_bf16(s[6 * 33], s[7 * 33]);
        *(u32x4*)(WT + (size_t)dest_row<MODE>(n0 + n, aux) * K + k0 + 8 * c) = o; }
    LDS_WAIT(); asm volatile("" ::: "memory");
}
template <int MODE> __device__ __forceinline__ void conv_item8(const float* W, int K, int N, unsigned char* WT, int aux, LAS float* scr, int item, int lane) {
    const int nblk = N / 32, kb = item / nblk, nb = item - kb * nblk, k0 = 64 * kb, n0 = 32 * nb;
    f32x4 v[8];
#pragma unroll
    for (int it = 0; it < 8; ++it) { const int kk = 8 * it + (lane >> 3); v[it] = *(const f32x4*)(W + (size_t)(k0 + kk) * N + n0 + 4 * (lane & 7)); }
#pragma unroll
    for (int it = 0; it < 8; ++it) { const int kk = 8 * it + (lane >> 3); LAS float* s = scr + kk * 33 + 4 * (lane & 7); s[0] = v[it][0]; s[1] = v[it][1]; s[2] = v[it][2]; s[3] = v[it][3]; }
    LDS_WAIT(); asm volatile("" ::: "memory");
    const int c = lane & 3;
#pragma unroll
    for (int j = 0; j < 2; ++j) { const int n = (lane >> 2) + 16 * j; const LAS float* s = scr + (16 * c) * 33 + n;
        u32x4 o;
        o.x = pk4_fp8(s[0 * 33] * WSCALE, s[1 * 33] * WSCALE, s[2 * 33] * WSCALE, s[3 * 33] * WSCALE); o.y = pk4_fp8(s[4 * 33] * WSCALE, s[5 * 33] * WSCALE, s[6 * 33] * WSCALE, s[7 * 33] * WSCALE);
        o.z = pk4_fp8(s[8 * 33] * WSCALE, s[9 * 33] * WSCALE, s[10 * 33] * WSCALE, s[11 * 33] * WSCALE); o.w = pk4_fp8(s[12 * 33] * WSCALE, s[13 * 33] * WSCALE, s[14 * 33] * WSCALE, s[15 * 33] * WSCALE);
        *(u32x4*)(WT + (size_t)dest_row<MODE>(n0 + n, aux) * K + k0 + 16 * c) = o; }
    LDS_WAIT(); asm volatile("" ::: "memory");
}
__device__ __forceinline__ void conv_weights(Frame& F0, int l, bool experts, int jlo) {
    Frame F = F0; F.tid = fresh_v(F0.tid); F.lane = F.tid & 63; F.wave = fresh_s(F0.wave);
    LAS float* scr = (LAS float*)(F.lds + F.wave * 16384);
    const int gw = F.vcu * NWAVES + F.wave, NGW = F.G * NWAVES;
    constexpr int I_IN = (D / 64) * (NQKV / 32), I_OUT = (D / 64) * (D / 32), I_GE = (D / 64) * (FF / 32), I_DE = (FF / 64) * (D / 32);
    constexpr int NITEMS = I_IN + I_OUT + NE * (2 * I_GE + I_DE);
    CArgs* ka = kargs();
    const float* w_in = ka->in[2] + (size_t)l * D * NQKV; const float* w_out = ka->in[6] + (size_t)l * D * D;
    const float* w_gate = ka->in[9] + (size_t)l * NE * D * FF; const float* w_up = ka->in[10] + (size_t)l * NE * D * FF; const float* w_down = ka->in[11] + (size_t)l * NE * FF * D;
    bf16_t* WIN = (bf16_t*)(F.ws + WS_WIN); bf16_t* WOUT = (bf16_t*)(F.ws + WS_WOUT); unsigned char* WGU = F.ws + WS_WGU + (size_t)l * WGU_BYTES; unsigned char* WD = F.ws + WS_WD + (size_t)l * WD_BYTES;
    const int nit = experts ? NITEMS : I_IN + I_OUT;
    for (int it = gw; it < nit; it += NGW) {
        int r = it;
        if (r < I_IN) { conv_item<1>(w_in, D, NQKV, WIN, 0, scr, r, F.lane); continue; } r -= I_IN;
        if (r < I_OUT) { conv_item<0>(w_out, D, D, WOUT, 0, scr, r, F.lane); continue; } r -= I_OUT;
        if (r < NE * I_GE) { const int e = r / I_GE; conv_item8<2>(w_gate + (size_t)e * D * FF, D, FF, WGU + (size_t)e * 2 * FF * D, 0, scr, r - e * I_GE, F.lane); continue; } r -= NE * I_GE;
        if (r < NE * I_GE) { const int e = r / I_GE; conv_item8<2>(w_up + (size_t)e * D * FF, D, FF, WGU + (size_t)e * 2 * FF * D, 1, scr, r - e * I_GE, F.lane); continue; } r -= NE * I_GE;
        { const int e = r / I_DE; conv_item8<0>(w_down + (size_t)e * FF * D, FF, D, WD + (size_t)e * D * FF, 0, scr, r - e * I_DE, F.lane); }
    }
    if (!experts) {
#pragma unroll 1
        for (int j = jlo; gw + NGW * j < CV_ITEMS; ++j) { const CvDesc cd = cv_desc(F.ws, l, gw + NGW * j); f32x4 c0[4], c1[4];
            cv_load_tile(c0, cd, 0, F.lane); cv_load_tile(c1, cd, 1, F.lane); cv_store_tile(c0, cd, 0, F.lane); cv_store_tile(c1, cd, 1, F.lane); }
    }
}
__device__ const double INVF[32] = {
    1.0, 0.7498942093324559, 0.5623413251903491, 0.4216965034285822, 0.31622776601683794, 0.23713737056616552, 0.1778279410038923, 0.1333521432163324,
    0.1, 0.07498942093324558, 0.05623413251903491, 0.042169650342858224, 0.03162277660168379, 0.023713737056616554, 0.01778279410038923, 0.01333521432163324,
    0.01, 0.007498942093324558, 0.005623413251903491, 0.004216965034285823, 0.0031622776601683794, 0.0023713737056616554, 0.0017782794100389228, 0.001333521432163324,
    0.001, 0.0007498942093324559, 0.0005623413251903491, 0.00042169650342858224, 0.00031622776601683794, 0.00023713737056616554, 0.00017782794100389227, 0.0001333521432163324};
__device__ __forceinline__ void rope_table(Frame& F0) {
    Frame F = F0; F.tid = fresh_v(F0.tid); F.lane = F.tid & 63; F.wave = fresh_s(F0.wave);
    float* tab = (float*)(F.ws + WS_ROPE);
    for (int idx = F.vcu * NTHREADS + F.tid; idx < T * 32; idx += F.G * NTHREADS) {
        const int t = idx >> 5, i = idx & 31;
        const double ang = (double)t * INVF[i];
        const double n = __builtin_rint(ang * 0.15915494309189535);
        double r = __builtin_fma(-n, 6.283185307179586, ang); r = __builtin_fma(-n, 2.4492935982947064e-16, r);
        const double x = r * 0.25, x2 = x * x;
        double s = -1.0 / 1307674368000.0; s = s * x2 + 1.0 / 6227020800.0; s = s * x2 - 1.0 / 39916800.0; s = s * x2 + 1.0 / 362880.0; s = s * x2 - 1.0 / 5040.0; s = s * x2 + 1.0 / 120.0; s = s * x2 - 1.0 / 6.0; s = s * x2 + 1.0; s = s * x;
        double c = 1.0 / 20922789888000.0; c = c * x2 - 1.0 / 87178291200.0; c = c * x2 + 1.0 / 479001600.0; c = c * x2 - 1.0 / 3628800.0; c = c * x2 + 1.0 / 40320.0; c = c * x2 - 1.0 / 720.0; c = c * x2 + 1.0 / 24.0; c = c * x2 - 0.5; c = c * x2 + 1.0;
        const double s2 = 2.0 * s * c, c2 = 1.0 - 2.0 * s * s; const double s4 = 2.0 * s2 * c2, c4 = 1.0 - 2.0 * s2 * s2;
        *(f32x2*)(tab + (size_t)idx * 2) = (f32x2){(float)c4, (float)s4};
    }
}
__device__ __forceinline__ void store_bf16_row(bf16_t* orow, const f32x4 (&v)[4], int lane) {
    u32x2* o8 = (u32x2*)orow + lane;
#pragma unroll
    for (int j = 0; j < 4; ++j) { u32x2 w; w.x = cvt_pk_bf16(v[j][0], v[j][1]); w.y = cvt_pk_bf16(v[j][2], v[j][3]); o8[64 * j] = w; }
}
__device__ __forceinline__ float row_rstd(const f32x4 (&v)[4]) {
    float s = 0.f;
#pragma unroll
    for (int j = 0; j < 4; ++j) s += (v[j][0] * v[j][0] + v[j][1] * v[j][1]) + (v[j][2] * v[j][2] + v[j][3] * v[j][3]);
    return 1.0f / sqrtf(wave_sum(s) * (1.0f / D) + EPS);
}
__device__ __forceinline__ void norm1_phase(Frame& F0, const float* x, const float* gain) {
    Frame F = F0; F.tid = fresh_v(F0.tid); F.lane = F.tid & 63; F.wave = fresh_s(F0.wave);
    bf16_t* H = (bf16_t*)(F.ws + WS_H);
    const int gw = F.vcu * NWAVES + F.wave, NGW = F.G * NWAVES;
    f32x4 g[4];
#pragma unroll
    for (int j = 0; j < 4; ++j) g[j] = *((const f32x4*)gain + 64 * j + F.lane);
#pragma unroll 1
    for (int m = gw; m < M; m += NGW) {
        const f32x4* xr = (const f32x4*)(x + (size_t)m * D) + F.lane; f32x4 v[4];
#pragma unroll
        for (int j = 0; j < 4; ++j) v[j] = xr[64 * j];
        const float rstd = row_rstd(v);
#pragma unroll
        for (int j = 0; j < 4; ++j) v[j] = v[j] * rstd * g[j];
        store_bf16_row(H + (size_t)m * D, v, F.lane);
    }
}
constexpr int N2_WHI = 0, N2_WLO = 32768, N2_GAIN = 65536;
template <bool XBF>
__device__ __forceinline__ void norm2_router_phase(Frame& F0, const void* xin, bf16_t* x1, const float* gain, const float* wr) {
    Frame F = F0; F.tid = fresh_v(F0.tid); F.lane = F.tid & 63; F.wave = fresh_s(F0.wave);
    unsigned char* H8 = F.ws + WS_H; float* AFF = (float*)(F.ws + WS_AFF); const bf16_t* Aat = (const bf16_t*)(F.ws + WS_PARTA); float* RSTD = (float*)(F.ws + WS_RSTD);
    for (int idx = F.tid; idx < D * NE; idx += NTHREADS) { const int d = idx >> 4, e = idx & 15; const float w = wr[idx];
        const unsigned hi = cvt_pk_bf16(w, 0.f) & 0xffffu; const float rem = w - __uint_as_float(hi << 16); const unsigned lo = cvt_pk_bf16(rem, 0.f) & 0xffffu;
        const int o = ((((d >> 5) * 4 + ((d >> 3) & 3)) * 16 + e) * 8 + (d & 7)) * 2;
        *(LAS bf16_t*)(F.lds + N2_WHI + o) = (bf16_t)hi; *(LAS bf16_t*)(F.lds + N2_WLO + o) = (bf16_t)lo; }
    for (int idx = F.tid; idx < D; idx += NTHREADS) ((LAS float*)(F.lds + N2_GAIN))[idx] = gain[idx];
    __syncthreads();
    const int lane = F.lane, i = lane & 15, g = lane >> 4;
    const int gw = F.vcu * NWAVES + F.wave, NGW = F.G * NWAVES;
#pragma unroll 1
    for (int tile = gw; tile < M / 16; tile += NGW) {
        const int row = tile * 16 + i;
        const f32x4* xr = (const f32x4*)((const float*)xin + (size_t)row * D + 8 * g); const u32x4* xrb = (const u32x4*)((const bf16_t*)xin + (size_t)row * D + 8 * g);
        u32x4* xo = (u32x4*)(x1 + (size_t)row * D + 8 * g);
        const u32x4* ar = (const u32x4*)(Aat + (size_t)row * D + 8 * g); u32x2* ho = (u32x2*)(H8 + (size_t)row * D + 8 * g);
        f32x4 acc = (f32x4){0.f, 0.f, 0.f, 0.f}; float ssq = 0.f;
#pragma unroll 1
        for (int kq = 0; kq < 8; ++kq) {
            f32x4 xa[4], xb[4]; u32x4 aw[4], xw[4];
#pragma unroll
            for (int s = 0; s < 4; ++s) { const int ks = 4 * kq + s; if (XBF) xw[s] = xrb[4 * ks]; else { xa[s] = xr[8 * ks]; xb[s] = xr[8 * ks + 1]; } aw[s] = ar[4 * ks]; }
#pragma unroll
            for (int s = 0; s < 4; ++s) { const int ks = 4 * kq + s;
                f32x4 va, vb;
                if (XBF) { va = (f32x4){bf_lo(xw[s].x), bf_hi(xw[s].x), bf_lo(xw[s].y), bf_hi(xw[s].y)}; vb = (f32x4){bf_lo(xw[s].z), bf_hi(xw[s].z), bf_lo(xw[s].w), bf_hi(xw[s].w)}; } else { va = xa[s]; vb = xb[s]; }
                va[0] += bf_lo(aw[s].x); va[1] += bf_hi(aw[s].x); va[2] += bf_lo(aw[s].y); va[3] += bf_hi(aw[s].y);
                vb[0] += bf_lo(aw[s].z); vb[1] += bf_hi(aw[s].z); vb[2] += bf_lo(aw[s].w); vb[3] += bf_hi(aw[s].w);
                { u32x4 xw1; xw1.x = cvt_pk_bf16(va[0], va[1]); xw1.y = cvt_pk_bf16(va[2], va[3]); xw1.z = cvt_pk_bf16(vb[0], vb[1]); xw1.w = cvt_pk_bf16(vb[2], vb[3]); xo[4 * ks] = xw1; }
                ssq += (va[0] * va[0] + va[1] * va[1]) + (va[2] * va[2] + va[3] * va[3]) + (vb[0] * vb[0] + vb[1] * vb[1]) + (vb[2] * vb[2] + vb[3] * vb[3]);
                const f32x4 ga = *(const LAS f32x4*)(F.lds + N2_GAIN + (32 * ks + 8 * g) * 4), gb = *(const LAS f32x4*)(F.lds + N2_GAIN + (32 * ks + 8 * g + 4) * 4);
                va = va * ga; vb = vb * gb;
                u32x2 h8; h8.x = pk4_fp8(va[0], va[1], va[2], va[3]); h8.y = pk4_fp8(vb[0], vb[1], vb[2], vb[3]); ho[4 * ks] = h8;
                u32x4 hi; hi.x = cvt_pk_bf16(va[0], va[1]); hi.y = cvt_pk_bf16(va[2], va[3]); hi.z = cvt_pk_bf16(vb[0], vb[1]); hi.w = cvt_pk_bf16(vb[2], vb[3]);
                u32x4 lo; lo.x = cvt_pk_bf16(va[0] - bf_lo(hi.x), va[1] - bf_hi(hi.x)); lo.y = cvt_pk_bf16(va[2] - bf_lo(hi.y), va[3] - bf_hi(hi.y));
                lo.z = cvt_pk_bf16(vb[0] - bf_lo(hi.z), vb[1] - bf_hi(hi.z)); lo.w = cvt_pk_bf16(vb[2] - bf_lo(hi.w), vb[3] - bf_hi(hi.w));
                const bf16x8 whi = *(const LAS bf16x8*)(F.lds + N2_WHI + (ks * 64 + lane) * 16), wlo = *(const LAS bf16x8*)(F.lds + N2_WLO + (ks * 64 + lane) * 16);
                const bf16x8 thi = __builtin_bit_cast(bf16x8, hi), tlo = __builtin_bit_cast(bf16x8, lo);
                acc = __builtin_amdgcn_mfma_f32_16x16x32_bf16(whi, thi, acc, 0, 0, 0);
                acc = __builtin_amdgcn_mfma_f32_16x16x32_bf16(wlo, thi, acc, 0, 0, 0);
                acc = __builtin_amdgcn_mfma_f32_16x16x32_bf16(whi, tlo, acc, 0, 0, 0);
            }
        }
        ssq += __shfl_xor(ssq, 16); ssq += __shfl_xor(ssq, 32);
        const float rstd = 1.0f / sqrtf(ssq * (1.0f / D) + EPS);
        if (g == 0) RSTD[row] = rstd;
        f32x4 lg = acc * rstd;
        float mx = fmaxf(fmaxf(lg[0], lg[1]), fmaxf(lg[2], lg[3])); mx = fmaxf(mx, __shfl_xor(mx, 16)); mx = fmaxf(mx, __shfl_xor(mx, 32));
        f32x4 ex; ex[0] = __expf(lg[0] - mx); ex[1] = __expf(lg[1] - mx); ex[2] = __expf(lg[2] - mx); ex[3] = __expf(lg[3] - mx);
        float sum = (ex[0] + ex[1]) + (ex[2] + ex[3]); sum += __shfl_xor(sum, 16); sum += __shfl_xor(sum, 32);
        const float inv = 1.0f / sum;
        float* ap = AFF + ((size_t)(row >> 13) * NE + 4 * g) * T + (row & (T - 1));
#pragma unroll
        for (int r = 0; r < 4; ++r) ap[(size_t)r * T] = ex[r] * inv;
    }
    __syncthreads();
}
__device__ __forceinline__ void topk_phase(Frame& F0) {
    Frame F = F0; F.tid = fresh_v(F0.tid); F.lane = F.tid & 63; F.wave = fresh_s(F0.wave);
    const float* AFF = (const float*)(F.ws + WS_AFF); int* INV = (int*)(F.ws + WS_INV); int* SEL = (int*)(F.ws + WS_SEL); float* GATEV = (float*)(F.ws + WS_GATEV);
    const float* RSTD = (const float*)(F.ws + WS_RSTD); float* RSS = (float*)(F.ws + WS_RSS);
    LAS unsigned* hist = (LAS unsigned*)F.lds;
    LAS unsigned* suf = hist + 256;
    LAS unsigned* ctl = hist + 768;
    LAS unsigned* wtot = hist + 800;
    for (int task = F.vcu; task < BATCH * NE; task += F.G) {
        const int b = task >> 4, e = task & 15;
        const unsigned* src = (const unsigned*)(AFF + (size_t)task * T) + F.tid * 16;
        unsigned v[16];
#pragma unroll
        for (int q = 0; q < 4; ++q) { const u32x4 w = *((const u32x4*)src + q); v[4 * q] = w.x; v[4 * q + 1] = w.y; v[4 * q + 2] = w.z; v[4 * q + 3] = w.w; }
        unsigned prefix = 0, remaining = CAP;
#pragma unroll 1
        for (int pass = 0; pass < 4; ++pass) {
            const int shift = 24 - 8 * pass;
            if (F.tid < 256) hist[F.tid] = 0u;
            __syncthreads();
#pragma unroll
            for (int j = 0; j < 16; ++j) { const bool match = (pass == 0) || ((v[j] >> (shift + 8)) == prefix); if (match) atomicAdd((unsigned*)&hist[(v[j] >> shift) & 255u], 1u); }
            __syncthreads();
            if (F.tid < 256) suf[F.tid] = hist[F.tid];
            if (F.tid == 0) suf[256] = 0u;
            __syncthreads();
#pragma unroll 1
            for (int o = 1; o < 256; o <<= 1) { unsigned a = 0u; if (F.tid < 256) { a = suf[F.tid]; if (F.tid + o < 256) a += suf[F.tid + o]; } __syncthreads(); if (F.tid < 256) suf[F.tid] = a; __syncthreads(); }
            if (F.tid < 256) { const unsigned sd = suf[F.tid], sn = suf[F.tid + 1]; if (sd >= remaining && sn < remaining) { ctl[0] = (unsigned)F.tid; ctl[1] = remaining - sn; } }
            __syncthreads();
            prefix = (prefix << 8) | ctl[0]; remaining = ctl[1];
            __syncthreads();
        }
        const unsigned thr = prefix, need_eq = remaining, n_gt = CAP - remaining;
        unsigned cnt = 0u;
#pragma unroll
        for (int j = 0; j < 16; ++j) cnt += (v[j] > thr ? 1u : 0u) + (v[j] == thr ? 0x10000u : 0u);
        unsigned inc = cnt;
#pragma unroll
        for (int o = 1; o < 64; o <<= 1) { const unsigned t = __shfl_up(inc, o); if (F.lane >= o) inc += t; }
        if (F.lane == 63) wtot[F.wave] = inc;
        __syncthreads();
        unsigned base = 0u;
#pragma unroll
        for (int w = 0; w < NWAVES; ++w) base += (w < F.wave) ? wtot[w] : 0u;
        unsigned run = base + inc - cnt;
        unsigned rg = run & 0xffffu, re = run >> 16;
        const int tbase = F.tid * 16;
#pragma unroll
        for (int j = 0; j < 16; ++j) {
            const int t = tbase + j; int slot = -1;
            if (v[j] > thr) { slot = (int)rg; ++rg; }
            else if (v[j] == thr) { if (re < need_eq) slot = (int)(n_gt + re); ++re; }
            const int gt = b * T + t;
            INV[(size_t)gt * NE + e] = slot >= 0 ? b * CAP + slot : -1;
            if (slot >= 0) { const int sr = e * (BATCH * CAP) + b * CAP + slot; SEL[sr] = gt; GATEV[sr] = __uint_as_float(v[j]); RSS[sr] = RSTD[gt]; }
        }
        __syncthreads();
    }
}
template <bool FINAL>
__device__ __forceinline__ void combine_phase(Frame& F0, float* x  , const float* gain) {
    Frame F = F0; F.tid = fresh_v(F0.tid); F.lane = F.tid & 63; F.wave = fresh_s(F0.wave);
    const int* INV = (const int*)(F.ws + WS_INV); const unsigned char* YE = F.ws + WS_YE; bf16_t* H = (bf16_t*)(F.ws + WS_H); const float* GATEV = (const float*)(F.ws + WS_GATEV);
    const int gw = F.vcu * NWAVES + F.wave, NGW = F.G * NWAVES;
    f32x4 g[4];
#pragma unroll
    for (int j = 0; j < 4; ++j) g[j] = *((const f32x4*)gain + 64 * j + F.lane);
#pragma unroll 1
    for (int m = gw; m < M; m += NGW) {
        f32x4* xr = (f32x4*)(x + (size_t)m * D) + F.lane; f32x4 v[4];
        { const u32x2* x1r = (const u32x2*)((const bf16_t*)(F.ws + WS_MIX) + (size_t)m * D) + F.lane;
#pragma unroll
          for (int j = 0; j < 4; ++j) { const u32x2 w = x1r[64 * j]; v[j] = (f32x4){bf_lo(w.x), bf_hi(w.x), bf_lo(w.y), bf_hi(w.y)}; } }
        const int myinv = INV[(size_t)m * NE + (F.lane & 15)];
        unsigned long long mask = __ballot(myinv >= 0) & 0xffffull;
        while (mask) {
            const int e = __builtin_ctzll(mask); mask &= mask - 1;
            const int slot = __builtin_amdgcn_readlane(myinv, e);
            const float gvv = __hip_atomic_load(GATEV + (size_t)e * (BATCH * CAP) + slot, __ATOMIC_RELAXED, __HIP_MEMORY_SCOPE_AGENT) * (1.0f / YSCALE);
            const int* yr = (const int*)(YE + ((size_t)e * (BATCH * CAP) + slot) * D) + F.lane;
#pragma unroll
            for (int j = 0; j < 4; ++j) { const int w = yr[64 * j]; const f32x2 a = __builtin_amdgcn_cvt_pk_f32_fp8(w, false), c = __builtin_amdgcn_cvt_pk_f32_fp8(w, true);
                v[j][0] += gvv * a.x; v[j][1] += gvv * a.y; v[j][2] += gvv * c.x; v[j][3] += gvv * c.y; }
        }
        const float rstd = row_rstd(v);
        if (FINAL) {
#pragma unroll
            for (int j = 0; j < 4; ++j) xr[64 * j] = v[j] * rstd * g[j];
        } else {
            store_bf16_row((bf16_t*)x + (size_t)m * D, v, F.lane);
#pragma unroll
            for (int j = 0; j < 4; ++j) v[j] = v[j] * rstd * g[j];
            store_bf16_row(H + (size_t)m * D, v, F.lane);
        }
    }
}

constexpr int ATT_VROW = 160;
constexpr int ATT_VBYTES = 32 * ATT_VROW;
constexpr int ATT_SSQ_OFF = NWAVES * ATT_VBYTES;
constexpr int ATT_BIAS_OFF = ATT_SSQ_OFF + 2 * 8 * 256 * 4;
constexpr int ATT_BIAS_PADF = 32, ATT_BIAS_TAILF = 64;
typedef short v4i16_t __attribute__((ext_vector_type(4)));
__device__ __forceinline__ s16x4 vtr(const LAS unsigned char* p) { return __builtin_bit_cast(s16x4, __builtin_amdgcn_ds_read_tr16_b64_v4i16((LAS v4i16_t*)p)); }

template <bool NA>
__device__ __forceinline__ void attn_task(const bf16_t* __restrict__ qkv, bf16_t* __restrict__ mix, LAS unsigned char* lds, int lane, int wave,
                                          int b, int h, int mblk, int r, int grow, int cb) {
    const int i = lane & 15, g = lane >> 4;
    constexpr size_t TENS = (size_t)BATCH * 8 * T * 64;
    const bf16_t* qbase = qkv + (size_t)(NA ? 3 : 0) * TENS + ((size_t)(b * 8 + h) * T << 6) + 8 * g;
    const bf16_t* kbase = qbase + TENS;
    const int tl = NA ? ((grow & 3) * 64 + 16 * cb + i) : (16 * i + r);
    const int tq = 256 * mblk + tl;
    const bf16x8 Q0 = *(const bf16x8*)(qbase + ((size_t)tq << 6)), Q1 = *(const bf16x8*)(qbase + ((size_t)tq << 6) + 32);
    const int qrow = grow, qcol = 16 * cb + i;
    const int rs = min(max(qrow - 4, 0), 120), cs = min(max(qcol - 8, 0), 48), kc0 = min(max(16 * cb - 8, 0), 32);
    const LAS float* biasp = (const LAS float*)(lds + ATT_BIAS_OFF) + ATT_BIAS_PADF + ((h * 15 + (rs - qrow + 7)) * 31 + (kc0 - qcol + 15 + 4 * g));
    constexpr int NSTEP = NA ? 9 : 24;
    LAS unsigned char* vst = lds + wave * ATT_VBYTES + i * ATT_VROW + 16 * g;
    const LAS unsigned char* vrd = lds + wave * ATT_VBYTES + (4 * g + (i >> 2)) * ATT_VROW + (i & 3) * 8;
    bf16x8 K0[2][2], V0[2][2], K1[2][2], V1[2][2], K2[2][2], V2[2][2];
#define ATT_SEG(sidx, sl, sh, rp, Lm1, basepos) \
    if ((sidx) < 5) { sl = (sidx); sh = 4; rp = r; Lm1 = 511; basepos = 16 * mblk - 64; } \
    else if ((sidx) < 11) { sl = (sidx) - 5; sh = 2; rp = r & 3; Lm1 = 2047; basepos = 64 * mblk - 64; } \
    else { sl = (sidx) - 11; sh = 0; rp = 0; Lm1 = 8191; basepos = 256 * mblk - 64; }
#define ATT_LOAD(KB, VB, sidx) do { int sl_, sh_, rp_, Lm1_, bp_; if (!NA) { ATT_SEG(sidx, sl_, sh_, rp_, Lm1_, bp_) } \
        _Pragma("unroll") for (int T_ = 0; T_ < 2; ++T_) { int tok_; \
            if (NA) tok_ = min(rs + (sidx), 127) * 64 + kc0 + 16 * T_ + i; \
            else { const int pos_ = bp_ + 32 * sl_ + 16 * T_ + i; tok_ = (min(max(pos_, 0), Lm1_) << sh_) + rp_; } \
            const bf16_t* p_ = kbase + ((size_t)tok_ << 6); \
            KB[T_][0] = *(const bf16x8*)p_; KB[T_][1] = *(const bf16x8*)(p_ + 32); VB[T_][0] = *(const bf16x8*)(p_ + TENS); VB[T_][1] = *(const bf16x8*)(p_ + TENS + 32); } } while (0)
    f32x4 O[4];
#pragma unroll
    for (int n = 0; n < 4; ++n) O[n] = (f32x4){0.f, 0.f, 0.f, 0.f};
    float mrun = -1e30f, lrun = 0.f;
#define ATT_STEP(KB, VB, s) do { \
        _Pragma("unroll") for (int T_ = 0; T_ < 2; ++T_) { *(LAS bf16x8*)(vst + T_ * 16 * ATT_VROW) = VB[T_][0]; *(LAS bf16x8*)(vst + T_ * 16 * ATT_VROW + 64) = VB[T_][1]; } \
        f32x4 sc[2]; \
        _Pragma("unroll") for (int T_ = 0; T_ < 2; ++T_) { sc[T_] = __builtin_amdgcn_mfma_f32_16x16x32_bf16(KB[T_][0], Q0, (f32x4){0.f, 0.f, 0.f, 0.f}, 0, 0, 0); \
            sc[T_] = __builtin_amdgcn_mfma_f32_16x16x32_bf16(KB[T_][1], Q1, sc[T_], 0, 0, 0); } \
        ATT_LOAD(KB, VB, min((s) + 3, NSTEP - 1)); \
        int lo, span, x0; \
        if (NA) { lo = ((s) < 8) ? cs - kc0 - 4 * g : (1 << 20); span = 15; x0 = 0; } \
        else { int sl_, sh_, rp_, Lm1_, bp_; ATT_SEG(s, sl_, sh_, rp_, Lm1_, bp_) (void)rp_; \
            const int pq = tq >> sh_; \
            lo = max(pq - 64, 0) - bp_ - 4 * g; span = (min(pq + 64, Lm1_) - bp_ - 4 * g) - lo; x0 = 32 * sl_; } \
        float mloc = -INFINITY; \
        _Pragma("unroll") for (int T_ = 0; T_ < 2; ++T_) \
            _Pragma("unroll") for (int q = 0; q < 4; ++q) { const bool valid = (unsigned)(x0 + 16 * T_ + q - lo) <= (unsigned)span; \
                float v = sc[T_][q]; if (NA) v += biasp[(s) * 31 + 16 * T_ + q]; \
                v = valid ? v : -INFINITY; sc[T_][q] = v; mloc = fmaxf(mloc, v); } \
        mloc = fmaxf(mloc, __shfl_xor(mloc, 16)); mloc = fmaxf(mloc, __shfl_xor(mloc, 32)); \
        const float mnew = fmaxf(mrun, mloc), alpha = __builtin_amdgcn_exp2f(mrun - mnew); mrun = mnew; \
        float psum = 0.f; \
        _Pragma("unroll") for (int T_ = 0; T_ < 2; ++T_) \
            _Pragma("unroll") for (int q = 0; q < 4; ++q) { const float p = __builtin_amdgcn_exp2f(sc[T_][q] - mnew); sc[T_][q] = p; psum += p; } \
        lrun = lrun * alpha + psum; \
        _Pragma("unroll") for (int n = 0; n < 4; ++n) O[n] = O[n] * alpha; \
        u32x4 pw; pw.x = cvt_pk_bf16(sc[0][0], sc[0][1]); pw.y = cvt_pk_bf16(sc[0][2], sc[0][3]); pw.z = cvt_pk_bf16(sc[1][0], sc[1][1]); pw.w = cvt_pk_bf16(sc[1][2], sc[1][3]); \
        const bf16x8 Pf = __builtin_bit_cast(bf16x8, pw); \
        _Pragma("unroll") for (int n = 0; n < 4; ++n) { const s16x4 a = vtr(vrd + n * 32), c = vtr(vrd + 16 * ATT_VROW + n * 32); \
            const bf16x8 Vf = (bf16x8){a[0], a[1], a[2], a[3], c[0], c[1], c[2], c[3]}; \
            O[n] = __builtin_amdgcn_mfma_f32_16x16x32_bf16(Vf, Pf, O[n], 0, 0, 0); } \
    } while (0)
    ATT_LOAD(K0, V0, 0); ATT_LOAD(K1, V1, 1); ATT_LOAD(K2, V2, 2);
#pragma unroll 1
    for (int s = 0; s < NSTEP; s += 3) {
        ATT_STEP(K0, V0, s);
        ATT_STEP(K1, V1, s + 1);
        ATT_STEP(K2, V2, s + 2);
    }
#undef ATT_STEP
#undef ATT_LOAD
#undef ATT_SEG
    float lt = lrun; lt += __shfl_xor(lt, 16); lt += __shfl_xor(lt, 32);
    const float inv = 1.0f / lt;
    float ssq = 0.f;
    bf16_t* op = mix + ((size_t)b * T + tq) * D + (NA ? 512 : 0) + h * 64 + 4 * g;
#pragma unroll
    for (int n = 0; n < 4; ++n) { const f32x4 o = O[n] * inv; ssq += (o[0] * o[0] + o[1] * o[1]) + (o[2] * o[2] + o[3] * o[3]);
        u32x2 w; w.x = cvt_pk_bf16(o[0], o[1]); w.y = cvt_pk_bf16(o[2], o[3]); *(u32x2*)(op + 16 * n) = w; }
    (void)ssq; (void)tl;
}

constexpr int NA_BIAS_OFF = MISC_OFF + 64;
constexpr int DU_NK = 256, DU_KB = DU_NK * 128, DU_BUF = 2 * DU_KB;
struct DUnit { int sh, res, Lm1, P0, type; };
__device__ __forceinline__ DUnit du_decode(int q, int u) {
    DUnit d;
    if (u < 16) { d.type = 0; d.sh = 4; d.res = 4 * q + (u >> 2); d.Lm1 = 511; d.P0 = 128 * (u & 3); }
    else if (u < 32) { d.type = 1; d.sh = 2; d.res = q; d.Lm1 = 2047; d.P0 = 128 * (u - 16); }
    else { d.type = 2; d.sh = 0; d.res = 0; d.Lm1 = 8191; d.P0 = 128 * (16 * q + (u - 32)); }
    return d;
}
__device__ __forceinline__ void attn_units_phase(Frame& F0, int l) {
    Frame F = F0; F.tid = fresh_v(F0.tid); F.lane = F.tid & 63; F.wave = fresh_s(F0.wave);
    constexpr size_t TENS = (size_t)BATCH * 8 * T * 64;
    const bf16_t* qkv = (const bf16_t*)(F.ws + WS_QKV); bf16_t* mix = (bf16_t*)(F.ws + WS_MIX);
    bf16_t* partA = (bf16_t*)(F.ws + WS_PARTA); bf16_t* partB = (bf16_t*)(F.ws + WS_PARTB); float* lsep = (float*)(F.ws + WS_LSEP);
    const int lane = F.lane, w = F.wave, i = lane & 15, g = lane >> 4;
    for (int c = F.vcu; c < 256; c += F.G) {
        const int bh = c >> 2, q = c & 3, b = bh >> 3, h = bh & 7;
        const bf16_t* qb = qkv + ((size_t)(b * 8 + h) * T << 6);
        const bf16_t* kb = qb + TENS;
        const __amdgpu_buffer_rsrc_t rKV = __builtin_amdgcn_make_buffer_rsrc((void*)kb, 0, 0xffffffff, 0x00020000);
        const int fK = (i >> 1) & 7;
        const int kof0 = i * 128 + ((g ^ fK) << 4), kof1 = i * 128 + (((4 + g) ^ fK) << 4);
        const int fV = ((2 * g + (i >> 3)) & 3) << 1;
        int vof[4];
#pragma unroll
        for (int n = 0; n < 4; ++n) vof[n] = (4 * g + (i >> 2)) * 128 + (((2 * n + ((i & 3) >> 1)) ^ fV) << 4) + (i & 1) * 8;
#define DU_ISSUE(u_, bufb_) do { const DUnit d_ = du_decode(q, (u_)); \
        _Pragma("unroll") for (int k_ = 0; k_ < 4; ++k_) { const int row_ = 32 * w + 8 * k_ + (lane >> 3); \
            const int pos_ = min(max(d_.P0 - 64 + row_, 0), d_.Lm1); const size_t tok_ = (size_t)((pos_ << d_.sh) + d_.res); \
            const int cK_ = (lane & 7) ^ ((row_ >> 1) & 7), cV_ = (lane & 7) ^ (((row_ >> 1) & 3) << 1); \
            __builtin_amdgcn_raw_ptr_buffer_load_lds(rKV, (LAS unsigned*)(F.lds + (bufb_) + (32 * w + 8 * k_) * 128), 16, (unsigned)(tok_ << 7) + (unsigned)(cK_ * 16), 0, 0, 0); \
            __builtin_amdgcn_raw_ptr_buffer_load_lds(rKV, (LAS unsigned*)(F.lds + (bufb_) + DU_KB + (32 * w + 8 * k_) * 128), 16, (unsigned)(tok_ << 7) + (unsigned)(cV_ * 16), (unsigned)(TENS * 2), 0, 0); } } while (0)
#define DU_QLOAD(u_, Qa, Qb) do { const DUnit d_ = du_decode(q, (u_)); const size_t tq_ = (size_t)(((d_.P0 + 16 * w + i) << d_.sh) + d_.res); \
        Qa = *(const bf16x8*)(qb + (tq_ << 6) + 8 * g); Qb = *(const bf16x8*)(qb + (tq_ << 6) + 8 * g + 32); } while (0)
        bf16x8 Qn0, Qn1;
        __syncthreads();
        DU_ISSUE(0, 0); DU_QLOAD(0, Qn0, Qn1);
#pragma unroll 1
        for (int u = 0; u < 48; ++u) {
            const bf16x8 Q0 = Qn0, Q1 = Qn1;
            if (u == 0) VM_WAIT(); else asm volatile("s_waitcnt vmcnt(5)" ::: "memory");
            asm volatile("" ::: "memory"); __builtin_amdgcn_s_barrier(); asm volatile("" ::: "memory");
            const int bufb = (u & 1) * DU_BUF;
            if (u + 1 < 48) { DU_ISSUE(u + 1, DU_BUF - bufb); DU_QLOAD(u + 1, Qn0, Qn1); }
            const DUnit d = du_decode(q, u);
            const LAS unsigned char* Kb = F.lds + bufb; const LAS unsigned char* Vb = Kb + DU_KB;
            const int lo = max(i, 64 - d.P0 - 16 * w) - 4 * g, span = min(i + 128, d.Lm1 + 64 - d.P0 - 16 * w) - 4 * g - lo;
            f32x4 sc[9];
#pragma unroll
            for (int t_ = 0; t_ < 9; ++t_) { const int rb = 16 * w + 16 * t_;
                const bf16x8 k0 = *(const LAS bf16x8*)(Kb + rb * 128 + kof0), k1 = *(const LAS bf16x8*)(Kb + rb * 128 + kof1);
                sc[t_] = __builtin_amdgcn_mfma_f32_16x16x32_bf16(k0, Q0, (f32x4){0.f, 0.f, 0.f, 0.f}, 0, 0, 0);
                sc[t_] = __builtin_amdgcn_mfma_f32_16x16x32_bf16(k1, Q1, sc[t_], 0, 0, 0); }
            float mrow = -INFINITY;
#pragma unroll
            for (int t_ = 0; t_ < 9; ++t_)
#pragma unroll
                for (int r_ = 0; r_ < 4; ++r_) { const bool valid = (unsigned)(16 * t_ + r_ - lo) <= (unsigned)span;
                    const float v = valid ? sc[t_][r_] : -INFINITY; sc[t_][r_] = v; mrow = fmaxf(mrow, v); }
            mrow = fmaxf(mrow, __shfl_xor(mrow, 16)); mrow = fmaxf(mrow, __shfl_xor(mrow, 32));
            float lt = 0.f;
#pragma unroll
            for (int t_ = 0; t_ < 9; ++t_)
#pragma unroll
                for (int r_ = 0; r_ < 4; ++r_) { const float p = __builtin_amdgcn_exp2f(sc[t_][r_] - mrow); sc[t_][r_] = p; lt += p; }
            f32x4 O[4];
#pragma unroll
            for (int n = 0; n < 4; ++n) O[n] = (f32x4){0.f, 0.f, 0.f, 0.f};
            unsigned vad[4];
#pragma unroll
            for (int n = 0; n < 4; ++n) vad[n] = (unsigned)(__SIZE_TYPE__)(Vb + (16 * w) * 128 + vof[n]);
            s16x4 va[2][4], vc[2][4];
#define DU_VTR(dst, ad, off) asm volatile("ds_read_b64_tr_b16 %0, %1 offset:%2" : "=v"(dst) : "v"(ad), "n"(off))
#define DU_VISSUE(s_) do { _Pragma("unroll") for (int n = 0; n < 4; ++n) { DU_VTR(va[(s_) & 1][n], vad[n], (s_) * 4096); DU_VTR(vc[(s_) & 1][n], vad[n], ((s_) < 4 ? (s_) * 4096 + 2048 : (s_) * 4096)); } } while (0)
            __builtin_amdgcn_sched_barrier(0);
            DU_VISSUE(0);
#pragma unroll
            for (int s = 0; s < 5; ++s) {
                u32x4 pw; pw.x = cvt_pk_bf16(sc[2 * s][0], sc[2 * s][1]); pw.y = cvt_pk_bf16(sc[2 * s][2], sc[2 * s][3]);
                if (s < 4) { pw.z = cvt_pk_bf16(sc[2 * s + 1][0], sc[2 * s + 1][1]); pw.w = cvt_pk_bf16(sc[2 * s + 1][2], sc[2 * s + 1][3]); } else { pw.z = 0u; pw.w = 0u; }
                const bf16x8 Pf = __builtin_bit_cast(bf16x8, pw);
                if (s < 4) { DU_VISSUE(s + 1);
                    asm volatile("s_waitcnt lgkmcnt(8)" : "+v"(va[s & 1][0]), "+v"(va[s & 1][1]), "+v"(va[s & 1][2]), "+v"(va[s & 1][3]), "+v"(vc[s & 1][0]), "+v"(vc[s & 1][1]), "+v"(vc[s & 1][2]), "+v"(vc[s & 1][3])); }
                else asm volatile("s_waitcnt lgkmcnt(0)" : "+v"(va[s & 1][0]), "+v"(va[s & 1][1]), "+v"(va[s & 1][2]), "+v"(va[s & 1][3]), "+v"(vc[s & 1][0]), "+v"(vc[s & 1][1]), "+v"(vc[s & 1][2]), "+v"(vc[s & 1][3]));
#pragma unroll
                for (int n = 0; n < 4; ++n) { const s16x4 a = va[s & 1][n], cc = vc[s & 1][n];
                    const bf16x8 Vf = (bf16x8){a[0], a[1], a[2], a[3], cc[0], cc[1], cc[2], cc[3]};
                    O[n] = __builtin_amdgcn_mfma_f32_16x16x32_bf16(Vf, Pf, O[n], 0, 0, 0); }
                __builtin_amdgcn_sched_barrier(0);
            }
#undef DU_VTR
#undef DU_VISSUE
            lt += __shfl_xor(lt, 16); lt += __shfl_xor(lt, 32);
            const float inv = 1.0f / lt; const float mrun = mrow;
            const size_t tokq = (size_t)b * T + (size_t)(((d.P0 + 16 * w + i) << d.sh) + d.res);
            bf16_t* op = (d.type == 0 ? partA + tokq * 512 : d.type == 1 ? partB + tokq * 512 : mix + tokq * D) + h * 64 + 4 * g;
#pragma unroll
            for (int n = 0; n < 4; ++n) { const f32x4 o = O[n] * inv; u32x2 ww; ww.x = cvt_pk_bf16(o[0], o[1]); ww.y = cvt_pk_bf16(o[2], o[3]); *(u32x2*)(op + 16 * n) = ww; }
            if (g == 0) lsep[((size_t)d.type * M + tokq) * 8 + h] = mrun + __builtin_amdgcn_logf(lt);
        }
#undef DU_ISSUE
#undef DU_QLOAD
    }
    __syncthreads();
    { CArgs* ka = kargs(); const float* rpb = ka->in[5] + (size_t)l * 8 * 15 * 31; LAS float* bias = (LAS float*)(F.lds + NA_BIAS_OFF);
      for (int idx = F.tid; idx < ATT_BIAS_PADF + 8 * 15 * 31 + ATT_BIAS_TAILF; idx += NTHREADS) { const int j = idx - ATT_BIAS_PADF; bias[idx] = (j >= 0 && j < 8 * 15 * 31) ? rpb[j] * LOG2E : 0.f; } }
    for (int c = F.vcu; c < 256; c += F.G) {
        const int b = c >> 5, h = (c >> 2) & 7, cb = c & 3, kc0 = min(max(16 * cb - 8, 0), 32);
        const bf16_t* qb = qkv + 3 * TENS + ((size_t)(b * 8 + h) * T << 6);
        const bf16_t* kb = qb + TENS;
        const int fK = (i >> 1) & 7, kof0 = i * 128 + ((g ^ fK) << 4), kof1 = i * 128 + (((4 + g) ^ fK) << 4);
        const int fV = ((2 * g + (i >> 3)) & 3) << 1;
        int vof[4];
#pragma unroll
        for (int n = 0; n < 4; ++n) vof[n] = (4 * g + (i >> 2)) * 128 + (((2 * n + ((i & 3) >> 1)) ^ fV) << 4) + (i & 1) * 8;
        const int pkk = (F.tid >> 3) & 31, pc = F.tid & 7, pr = F.tid >> 8;
        u32x4 st[8];
#define NA_FETCH(row0_, nrow_) do { _Pragma("unroll") for (int k_ = 0; k_ < 8; ++k_) { const int ro_ = 2 * (k_ & 3) + pr; const int kr_ = min((row0_) + ro_, 127); \
            st[k_] = *(const u32x4*)(kb + (size_t)(k_ >> 2) * TENS + ((size_t)(kr_ * 64 + kc0 + pkk) << 6) + pc * 8); } } while (0)
#define NA_STORE(row0_, nrow_) do { _Pragma("unroll") for (int k_ = 0; k_ < 8; ++k_) { const int ro_ = 2 * (k_ & 3) + pr; if (ro_ < (nrow_)) { const int R_ = (((row0_) + ro_) & 15) * 32 + pkk; \
            const int f_ = (k_ >> 2) ? (((R_ >> 1) & 3) << 1) : ((R_ >> 1) & 7); \
            *(LAS u32x4*)(F.lds + (k_ >> 2) * 65536 + R_ * 128 + ((pc ^ f_) << 4)) = st[k_]; } } } while (0)
        __syncthreads();
        NA_FETCH(0, 8); NA_STORE(0, 8); NA_FETCH(8, 3); NA_STORE(8, 3);
        bf16x8 Qn0, Qn1;
        { const size_t tq0 = (size_t)(w * 64 + 16 * cb + i); Qn0 = *(const bf16x8*)(qb + (tq0 << 6) + 8 * g); Qn1 = *(const bf16x8*)(qb + (tq0 << 6) + 8 * g + 32); }
        __syncthreads();
#pragma unroll 1
        for (int j = 0; j < 16; ++j) {
            const int hi_cur = min(8 * j + 10, 127), hi_nxt = min(8 * j + 18, 127), nnew = (j < 15) ? hi_nxt - hi_cur : 0;
            if (nnew > 0) NA_FETCH(hi_cur + 1, nnew);
            const int qrow = 8 * j + w, qcol = 16 * cb + i, rs = min(max(qrow - 4, 0), 120), cs = min(max(qcol - 8, 0), 48);
            const size_t tq = (size_t)(qrow * 64 + qcol);
            const bf16x8 Q0 = Qn0, Q1 = Qn1;
            { const int qn = min(8 * (j + 1) + w, 127); const size_t tqn = (size_t)(qn * 64 + qcol); Qn0 = *(const bf16x8*)(qb + (tqn << 6) + 8 * g); Qn1 = *(const bf16x8*)(qb + (tqn << 6) + 8 * g + 32); }
            const LAS float* biasp = (const LAS float*)(F.lds + NA_BIAS_OFF) + ATT_BIAS_PADF + ((h * 15 + (rs - qrow + 7)) * 31 + (kc0 - qcol + 15 + 4 * g));
            const int lo = cs - kc0 - 4 * g;
            f32x4 sc[16];
#pragma unroll
            for (int s = 0; s < 8; ++s) { const int R0 = ((rs + s) & 15) * 32;
#pragma unroll
                for (int T_ = 0; T_ < 2; ++T_) { const bf16x8 k0 = *(const LAS bf16x8*)(F.lds + (R0 + 16 * T_) * 128 + kof0), k1 = *(const LAS bf16x8*)(F.lds + (R0 + 16 * T_) * 128 + kof1);
                    sc[2 * s + T_] = __builtin_amdgcn_mfma_f32_16x16x32_bf16(k0, Q0, (f32x4){0.f, 0.f, 0.f, 0.f}, 0, 0, 0);
                    sc[2 * s + T_] = __builtin_amdgcn_mfma_f32_16x16x32_bf16(k1, Q1, sc[2 * s + T_], 0, 0, 0); } }
            bool first[4]; int boff[4];
#pragma unroll
            for (int r_ = 0; r_ < 4; ++r_) { first[r_] = r_ >= lo; boff[r_] = first[r_] ? r_ : 16 + r_; }
            float w[8][4]; float mrow = -INFINITY;
#pragma unroll
            for (int s = 0; s < 8; ++s)
#pragma unroll
                for (int r_ = 0; r_ < 4; ++r_) { const float v = (first[r_] ? sc[2 * s][r_] : sc[2 * s + 1][r_]) + biasp[s * 31 + boff[r_]]; w[s][r_] = v; mrow = fmaxf(mrow, v); }
            mrow = fmaxf(mrow, __shfl_xor(mrow, 16)); mrow = fmaxf(mrow, __shfl_xor(mrow, 32));
            float lt = 0.f;
#pragma unroll
            for (int s = 0; s < 8; ++s)
#pragma unroll
                for (int r_ = 0; r_ < 4; ++r_) { const float p = __builtin_amdgcn_exp2f(w[s][r_] - mrow); lt += p; sc[2 * s][r_] = first[r_] ? p : 0.f; sc[2 * s + 1][r_] = first[r_] ? 0.f : p; }
            f32x4 O[4];
#pragma unroll
            for (int n = 0; n < 4; ++n) O[n] = (f32x4){0.f, 0.f, 0.f, 0.f};
#pragma unroll
            for (int s = 0; s < 8; ++s) { const int R0 = ((rs + s) & 15) * 32;
                u32x4 pw; pw.x = cvt_pk_bf16(sc[2 * s][0], sc[2 * s][1]); pw.y = cvt_pk_bf16(sc[2 * s][2], sc[2 * s][3]); pw.z = cvt_pk_bf16(sc[2 * s + 1][0], sc[2 * s + 1][1]); pw.w = cvt_pk_bf16(sc[2 * s + 1][2], sc[2 * s + 1][3]);
                const bf16x8 Pf = __builtin_bit_cast(bf16x8, pw);
#pragma unroll
                for (int n = 0; n < 4; ++n) { const s16x4 a = vtr(F.lds + 65536 + R0 * 128 + vof[n]), cc = vtr(F.lds + 65536 + (R0 + 16) * 128 + vof[n]);
                    const bf16x8 Vf = (bf16x8){a[0], a[1], a[2], a[3], cc[0], cc[1], cc[2], cc[3]};
                    O[n] = __builtin_amdgcn_mfma_f32_16x16x32_bf16(Vf, Pf, O[n], 0, 0, 0); }
            }
            lt += __shfl_xor(lt, 16); lt += __shfl_xor(lt, 32);
            const float inv = 1.0f / lt;
            bf16_t* op = mix + ((size_t)b * T + tq) * D + 512 + h * 64 + 4 * g;
#pragma unroll
            for (int n = 0; n < 4; ++n) { const f32x4 o = O[n] * inv; u32x2 ww; ww.x = cvt_pk_bf16(o[0], o[1]); ww.y = cvt_pk_bf16(o[2], o[3]); *(u32x2*)(op + 16 * n) = ww; }
            __syncthreads();
            if (nnew > 0) NA_STORE(hi_cur + 1, nnew);
            __syncthreads();
        }
#undef NA_FETCH
#undef NA_STORE
    }
}
__device__ __forceinline__ void attn_merge_phase(Frame& F0, int l) {
    Frame F = F0; F.tid = fresh_v(F0.tid); F.lane = F.tid & 63; F.wave = fresh_s(F0.wave);
    bf16_t* mix = (bf16_t*)(F.ws + WS_MIX); const bf16_t* partA = (const bf16_t*)(F.ws + WS_PARTA); const bf16_t* partB = (const bf16_t*)(F.ws + WS_PARTB); const float* lsep = (const float*)(F.ws + WS_LSEP);
    CArgs* ka = kargs();
    const float* gd = ka->in[3] + (size_t)l * 512; const float* gn = ka->in[4] + (size_t)l * 512;
    const int lane = F.lane; const bool dil = lane < 32;
    f32x4 gg[4];
    { const float* gp = dil ? gd + 16 * lane : gn + 16 * (lane - 32);
#pragma unroll
      for (int j = 0; j < 4; ++j) gg[j] = *(const f32x4*)(gp + 4 * j); }
    const int gw = F.vcu * NWAVES + F.wave, NGW = F.G * NWAVES;
#pragma unroll 1
    for (int m = gw; m < M; m += NGW) {
        u32x4* p = (u32x4*)(mix + (size_t)m * D + 16 * lane);
        const u32x4 c0 = p[0], c1 = p[1];
        const int l5 = lane & 31;
        const u32x4 a0 = *(const u32x4*)(partA + (size_t)m * 512 + 16 * l5), a1 = *(const u32x4*)(partA + (size_t)m * 512 + 16 * l5 + 8);
        const u32x4 b0 = *(const u32x4*)(partB + (size_t)m * 512 + 16 * l5), b1 = *(const u32x4*)(partB + (size_t)m * 512 + 16 * l5 + 8);
        const int hh = l5 >> 2;
        const float la = lsep[((size_t)0 * M + m) * 8 + hh], lb = lsep[((size_t)1 * M + m) * 8 + hh], lc = lsep[((size_t)2 * M + m) * 8 + hh];
        const float mx = fmaxf(fmaxf(la, lb), lc);
        float wa = __builtin_amdgcn_exp2f(la - mx), wb = __builtin_amdgcn_exp2f(lb - mx), wc = __builtin_amdgcn_exp2f(lc - mx);
        const float wi = 1.0f / (wa + wb + wc); wa *= wi; wb *= wi; wc *= wi;
        if (!dil) { wa = 0.f; wb = 0.f; wc = 1.f; }
        const unsigned cw[8] = {c0.x, c0.y, c0.z, c0.w, c1.x, c1.y, c1.z, c1.w}, aw[8] = {a0.x, a0.y, a0.z, a0.w, a1.x, a1.y, a1.z, a1.w}, bw[8] = {b0.x, b0.y, b0.z, b0.w, b1.x, b1.y, b1.z, b1.w};
        float o[16]; float ssq = 0.f;
#pragma unroll
        for (int k = 0; k < 8; ++k) { o[2 * k] = wa * bf_lo(aw[k]) + wb * bf_lo(bw[k]) + wc * bf_lo(cw[k]); o[2 * k + 1] = wa * bf_hi(aw[k]) + wb * bf_hi(bw[k]) + wc * bf_hi(cw[k]);
            ssq += o[2 * k] * o[2 * k] + o[2 * k + 1] * o[2 * k + 1]; }
#pragma unroll
        for (int of = 1; of < 32; of <<= 1) ssq += __shfl_xor(ssq, of);
        const float rstd = 1.0f / sqrtf(ssq * (1.0f / 512.0f) + EPS);
        unsigned ow[8];
#pragma unroll
        for (int k = 0; k < 8; ++k) ow[k] = cvt_pk_bf16(o[2 * k] * rstd * gg[k >> 1][(k & 1) * 2], o[2 * k + 1] * rstd * gg[k >> 1][(k & 1) * 2 + 1]);
        p[0] = (u32x4){ow[0], ow[1], ow[2], ow[3]}; p[1] = (u32x4){ow[4], ow[5], ow[6], ow[7]};
    }
}

__global__ void __launch_bounds__(NTHREADS, 2) mk_fwd(Args args) {
    extern __shared__ __attribute__((aligned(16))) unsigned char lds_raw[];
    Frame F;
    F.lds = (LAS unsigned char*)lds_raw;
    F.tid = threadIdx.x; F.lane = F.tid & 63; F.wave = __builtin_amdgcn_readfirstlane(F.tid >> 6);
    F.G = gridDim.x; { const int bx = blockIdx.x; F.vcu = (F.G % 8 == 0) ? (bx % 8) * (F.G / 8) + bx / 8 : bx; }
    F.out = args.out; F.ws = args.ws;
    volatile LAS unsigned* MISC = (volatile LAS unsigned*)(F.lds + MISC_OFF);
    if (F.tid < 16) MISC[F.tid] = 0u;
    __syncthreads();
    XcdBarrier bar; bar.bar = (unsigned*)(F.ws + WS_CTL) + CW_BAR; bar.x = 0; bar.st = nullptr;
    if (MK_N_LAUNCHES == 1) bar = xcd_barrier_post((unsigned*)(F.ws + WS_CTL) + CW_BAR, MISC + 8);
    const int lo = args.ph_lo, hi = args.ph_hi;
#define IN(k) (lo <= (k) && (k) < hi)
#ifdef PROBE_PHASE
    unsigned long long pr_last = __builtin_amdgcn_s_memrealtime(), pr_acc = 0ull;
#define SEAM(k) do { if (IN(k) && IN((k) + 1)) xcd_barrier(bar); { const unsigned long long now_ = __builtin_amdgcn_s_memrealtime(); const int ty_ = (k) == 0 ? 0 : 1 + ((k) - 1) % 9; if (ty_ == PROBE_PHASE) pr_acc += now_ - pr_last; pr_last = now_; } } while (0)
#else
#define SEAM(k) do { if (IN(k) && IN((k) + 1)) xcd_barrier(bar); } while (0)
#endif
#ifndef GPH
#define GPH 0
#endif
#ifndef GPROBE_AMP
#define GPROBE_AMP 1
#endif
    unsigned long long gp_acc = 0ull, gp_dummy = 0ull; (void)gp_dummy;
    bf16_t* H = (bf16_t*)(F.ws + WS_H); bf16_t* QKV = (bf16_t*)(F.ws + WS_QKV); bf16_t* MIX = (bf16_t*)(F.ws + WS_MIX);
    bf16_t* ACT = (bf16_t*)(F.ws + WS_ACT); bf16_t* YE = (bf16_t*)(F.ws + WS_YE);

    if (IN(0)) {
#if PM & 1
        conv_weights(F, 0, true, 0);
#endif
#if PM & 2
        rope_table(F);
#endif
#if PM & 4
        norm1_phase(F, KIN(0), KIN(1));
#endif
    }
    SEAM(0);
#pragma unroll 1
    for (int l = 0; l < 2; ++l) {
        const int pb = 1 + 9 * l;
#if PM & 8
        if (IN(pb + 0)) {
            gm::StaticOrder S; S.init(M, NQKV, F.G, (int)blockIdx.x);
            gm::ASrc A{(const char*)H, nullptr, D, nullptr}; gm::BSrc B{(const char*)(F.ws + WS_WIN), 31, 0};
            gm::EpiQKV E{QKV, (const float*)(F.ws + WS_ROPE)};
            gm::gemm_phase<gm::EpiQKV, false, false>(F.lds, A, B, S, E, GPH == 1 ? gp_acc : gp_dummy);
        }
#endif
        SEAM(pb + 0);
#if PM & 16
        if (IN(pb + 1)) attn_units_phase(F, l);
#endif
        SEAM(pb + 1);
#if PM & 16
        if (IN(pb + 2)) attn_merge_phase(F, l);
#endif
        SEAM(pb + 2);
#if PM & 32
        if (IN(pb + 3)) {
            gm::StaticOrder S; S.init(M, D, F.G, (int)blockIdx.x);
            gm::ASrc A{(const char*)MIX, nullptr, D, nullptr}; gm::BSrc B{(const char*)(F.ws + WS_WOUT), 31, 0};
            gm::EpiBf16Out E{(bf16_t*)(F.ws + WS_PARTA)};
            gm::gemm_phase<gm::EpiBf16Out, false, false>(F.lds, A, B, S, E, GPH == 2 ? gp_acc : gp_dummy);
        }
#endif
        SEAM(pb + 3);
#if PM & 64
        if (IN(pb + 4)) { if (l == 0) norm2_router_phase<false>(F, (const void*)KIN(0), MIX, KIN(7), KIN(8)); else norm2_router_phase<true>(F, (const void*)F.out, MIX, KIN(7) + D, KIN(8) + (size_t)D * NE); }
#endif
        SEAM(pb + 4);
#if PM & 128
        if (IN(pb + 5)) topk_phase(F);
#endif
        SEAM(pb + 5);
#if PM & 256
        if (IN(pb + 6)) {
            gm::StaticOrder S; S.init(MS, 2 * FF, F.G, (int)blockIdx.x);
            gm::ASrc A{(const char*)H, (const int*)(F.ws + WS_SEL), D, (const float*)(F.ws + WS_RSS)}; gm::BSrc B{(const char*)(F.ws + WS_WGU + (size_t)l * WGU_BYTES), 5, (size_t)2 * FF * D};
            const int nun = ((MS / 256) * (2 * FF / 256) + F.G - 1 - (int)blockIdx.x) / F.G;
            gm::EpiSwiGLU E{(unsigned char*)ACT, F.ws, l == 0 ? (nun & ~1) : 0, F.vcu * NWAVES + F.wave, F.G * NWAVES};
            gm::gemm_phase<gm::EpiSwiGLU, true, true>(F.lds, A, B, S, E, GPH == 3 ? gp_acc : gp_dummy);
        }
#endif
        SEAM(pb + 6);
#if PM & 512
        if (IN(pb + 7)) {
            gm::StaticOrder S; S.init(MS, D, F.G, (int)blockIdx.x);
            gm::ASrc A{(const char*)ACT, nullptr, FF, nullptr}; gm::BSrc B{(const char*)(F.ws + WS_WD + (size_t)l * WD_BYTES), 5, (size_t)D * FF};
            gm::EpiDown E{(unsigned char*)YE, (const float*)(F.ws + WS_GATEV)};
            gm::gemm_phase<gm::EpiDown, true, true>(F.lds, A, B, S, E, GPH == 4 ? gp_acc : gp_dummy);
        }
#endif
        SEAM(pb + 7);
#if PM & 1024
        if (IN(pb + 8)) {
            if (l == 0) { const int nun = ((MS / 256) * (2 * FF / 256) + F.G - 1 - (int)blockIdx.x) / F.G;
                conv_weights(F, 1, false, nun >> 1); combine_phase<false>(F, F.out, KIN(1) + D); }
            else combine_phase<true>(F, F.out, KIN(12));
        }
#endif
        if (l == 0) SEAM(pb + 8);
    }
#if GPROBE
    { const unsigned long long t0_ = __builtin_amdgcn_s_memrealtime(); while (__builtin_amdgcn_s_memrealtime() - t0_ < gp_acc * GPROBE_AMP) __builtin_amdgcn_s_sleep(8); }
#endif
#ifdef PROBE_PHASE
    { const unsigned long long now_ = __builtin_amdgcn_s_memrealtime(); if (PROBE_PHASE == 9) pr_acc += now_ - pr_last;
      const unsigned long long t0_ = __builtin_amdgcn_s_memrealtime(); while (__builtin_amdgcn_s_memrealtime() - t0_ < pr_acc * PROBE_AMP) __builtin_amdgcn_s_sleep(8); }
#endif
#undef IN
#undef SEAM
}

extern "C" void kernel_launch(void* const* d_in, const int* in_sizes, int n_in, void* d_out, int out_size, void* d_ws, size_t ws_size, hipStream_t stream) {
    static int grid = 0;
    if (grid == 0) {
        if (n_in != 13 || in_sizes[0] != M * D || out_size != M * D || ws_size < WS_END) {
            fprintf(stderr, "kernel_launch: unexpected problem (n_in %d, in0 %d, out %d, ws %zu < %zu); nothing launched\n", n_in, n_in > 0 ? in_sizes[0] : -1, out_size, ws_size, (size_t)WS_END); grid = -1; return; }
        int dev = 0, cus = 0, per_cu = 0;
        if (hipGetDevice(&dev) != hipSuccess || hipDeviceGetAttribute(&cus, hipDeviceAttributeMultiprocessorCount, dev) != hipSuccess) { grid = -1; return; }
        if (hipFuncSetAttribute((const void*)mk_fwd, hipFuncAttributeMaxDynamicSharedMemorySize, LDS_BYTES) != hipSuccess) { fprintf(stderr, "kernel_launch: hipFuncSetAttribute failed\n"); grid = -1; return; }
        if (hipOccupancyMaxActiveBlocksPerMultiprocessor(&per_cu, (const void*)mk_fwd, NTHREADS, LDS_BYTES) != hipSuccess || per_cu < 1) {
            fprintf(stderr, "kernel_launch: occupancy query reports %d workgroups per CU; nothing launched\n", per_cu); (void)hipGetLastError(); grid = -1; return; }
        grid = cus;
    }
    if (grid < 0) return;
    (void)hipMemsetAsync((char*)d_ws + WS_CTL, 0, CTL_BYTES, stream);
    Args a{};
    for (int i = 0; i < 13; ++i) a.in[i] = (const float*)d_in[i];
    a.out = (float*)d_out; a.ws = (unsigned char*)d_ws;
    if (MK_N_LAUNCHES == 1) {
        a.ph_lo = 0; a.ph_hi = NPH; a.li = 0;
        hipLaunchKernelGGL(mk_fwd, dim3(grid), dim3(NTHREADS), LDS_BYTES, stream, a);
    } else {
        for (int p = 0; p < NPH; ++p) { a.ph_lo = p; a.ph_hi = p + 1; a.li = p; hipLaunchKernelGGL(mk_fwd, dim3(grid), dim3(NTHREADS), LDS_BYTES, stream, a); }
    }
    const hipError_t le = hipPeekAtLastError();
    if (le != hipSuccess) fprintf(stderr, "kernel_launch: launch failed: %s\n", hipGetErrorName(le));
}
```

```cpp
#include <hip/hip_runtime.h>
#include <cstdio>
#include <cstdint>

#ifndef PM
#define PM 0xffff
#endif
#ifndef MK_N_LAUNCHES
#define MK_N_LAUNCHES 1
#endif

#define GAS __attribute__((address_space(1)))
#define LAS __attribute__((address_space(3)))
typedef unsigned short bf16_t;
typedef short bf16x8 __attribute__((ext_vector_type(8)));
typedef short s16x4 __attribute__((ext_vector_type(4)));
typedef float f32x4 __attribute__((ext_vector_type(4)));
typedef float f32x2 __attribute__((ext_vector_type(2)));
typedef unsigned u32x4 __attribute__((ext_vector_type(4)));
typedef unsigned u32x2 __attribute__((ext_vector_type(2)));
typedef int i32x4 __attribute__((ext_vector_type(4)));
typedef int v8i32 __attribute__((ext_vector_type(8)));
typedef GAS unsigned gu32;

constexpr int D = 1024, BATCH = 8, T = 8192, M = BATCH * T, NQKV = 3072, NE = 16, FF = 2816, CAP = 1024, MS = NE * BATCH * CAP;
constexpr int NWAVES = 8, NTHREADS = 512;
constexpr float EPS = 1e-6f;
constexpr float LOG2E = 1.4426950408889634f;
constexpr float QSCALE = 0.125f * LOG2E;
constexpr int NPH = 19;

constexpr size_t MiB = 1u << 20;
constexpr size_t WS_CTL = 0, CTL_BYTES = 1 * MiB;
constexpr size_t WS_ROPE = 2 * MiB;
constexpr size_t WS_AFF = 4 * MiB;
constexpr size_t WS_INV = 8 * MiB;
constexpr size_t WS_SEL = 12 * MiB;
constexpr size_t WS_GATEV = 12 * MiB + 512 * 1024;
constexpr size_t WS_RSTD = 13 * MiB;
constexpr size_t WS_RSS = 13 * MiB + 512 * 1024;
constexpr size_t WS_WIN = 16 * MiB;
constexpr size_t WS_WOUT = 22 * MiB;
constexpr size_t WS_WGU = 24 * MiB;
constexpr size_t WS_WD = 200 * MiB;
constexpr size_t WGU_BYTES = 88 * MiB, WD_BYTES = 44 * MiB;
constexpr size_t WS_H = 288 * MiB;
constexpr size_t WS_ACT = 416 * MiB;
constexpr size_t WS_QKV = 416 * MiB;
constexpr size_t WS_MIX = 800 * MiB;
constexpr size_t WS_YE = 1120 * MiB;
constexpr size_t WS_END = 1376 * MiB;
constexpr size_t WS_PARTA = 928 * MiB, WS_PARTB = 992 * MiB, WS_LSEP = 1056 * MiB;
constexpr int CW_BAR = 4096;

constexpr int RING_BYTES = 131072;
constexpr int MISC_OFF = RING_BYTES;
constexpr int GOFF_OFF = MISC_OFF + 64;
constexpr int LDS_BYTES = 147456;

#define LDS_WAIT() asm volatile("s_waitcnt lgkmcnt(0)" ::: "memory")
#define VM_WAIT() asm volatile("s_waitcnt vmcnt(0)" ::: "memory")
__device__ __forceinline__ unsigned cvt_pk_bf16(float lo, float hi) { unsigned r; asm volatile("v_cvt_pk_bf16_f32 %0, %1, %2" : "=v"(r) : "v"(lo), "v"(hi)); return r; }
constexpr float YSCALE = 8.0f;
constexpr float WSCALE = 32.0f, WINV = 1.0f / 32.0f;
__device__ __forceinline__ unsigned pk4_fp8(float a, float b, float c, float d) { int w = __builtin_amdgcn_cvt_pk_fp8_f32(a, b, 0, false); w = __builtin_amdgcn_cvt_pk_fp8_f32(c, d, w, true); return (unsigned)w; }
__device__ __forceinline__ float bf_lo(unsigned w) { return __uint_as_float(w << 16); }
__device__ __forceinline__ float bf_hi(unsigned w) { return __uint_as_float(w & 0xffff0000u); }
__device__ __forceinline__ int fresh_v(int v) { asm volatile("" : "+v"(v)); return v; }
__device__ __forceinline__ int fresh_s(int v) { asm volatile("" : "+s"(v)); return v; }
__device__ __forceinline__ float wave_sum(float v) {
#pragma unroll
    for (int o = 1; o < 64; o <<= 1) v += __shfl_xor(v, o);
    return v;
}

#define XB_TMO      128
#define XB_XCNT(j)  (256  + 64 * (j))
#define XB_XSUB(j)  (1280 + 64 * (j))
#define XB_XGEN(j)  (2304 + 64 * (j))
#define XB_TOP      3328
#define XB_TOPGEN   3392
#define XCD_BAR_WORDS 3456
#define XB_SPIN_CAP (1u << 18)
__device__ __forceinline__ unsigned xb_ld(unsigned* p)              { return __hip_atomic_load(p, __ATOMIC_RELAXED, __HIP_MEMORY_SCOPE_AGENT); }
__device__ __forceinline__ unsigned xb_add(unsigned* p, unsigned v) { return __hip_atomic_fetch_add(p, v, __ATOMIC_RELAXED, __HIP_MEMORY_SCOPE_AGENT); }
__device__ __forceinline__ unsigned xb_xcc_id() { return (unsigned)__builtin_amdgcn_s_getreg((3 << 11) | 20) & 0xFu; }
#define XB_SPIN(cond, bar) do { unsigned _sp = 0; while (cond) { __builtin_amdgcn_s_sleep(1); \
    if ((++_sp & 255u) == 0u) { if (xb_ld(&(bar)[XB_TMO])) break; if (_sp > XB_SPIN_CAP) { atomicAdd(&(bar)[XB_TMO], 1u); break; } } } } while (0)
struct XcdBarrier { unsigned* bar; unsigned x; volatile LAS unsigned* st; };
__device__ __forceinline__ XcdBarrier xcd_barrier_post(unsigned* bar, volatile LAS unsigned* st) {
    XcdBarrier b; b.bar = bar; b.x = xb_xcc_id(); b.st = st;
    if (threadIdx.x == 0) (void)xb_add(&bar[XB_XCNT(b.x)], 1u);
    return b;
}
__device__ __forceinline__ void xcd_barrier_complete(unsigned* bar, unsigned x, unsigned& nloc, unsigned& nx) {
    const unsigned G = gridDim.x * gridDim.y * gridDim.z;
    unsigned sum, cnt, mine, sp = 0u;
    for (;;) {
        sum = 0u; cnt = 0u; mine = 0u;
#pragma unroll
        for (unsigned j = 0; j < 16; ++j) { const unsigned c = xb_ld(&bar[XB_XCNT(j)]); sum += c; cnt += (c > 0u) ? 1u : 0u; mine = (j == x) ? c : mine; }
        if (sum == G) break;
        __builtin_amdgcn_s_sleep(1);
        if ((++sp & 255u) == 0u) { if (xb_ld(&bar[XB_TMO])) break; if (sp > XB_SPIN_CAP) { atomicAdd(&bar[XB_TMO], 1u); break; } }
    }
    nloc = mine > 0u ? mine : 1u; nx = cnt > 0u ? cnt : 1u;
}
__device__ __forceinline__ void xcd_barrier(const XcdBarrier& b) {
    asm volatile("s_waitcnt vmcnt(0)" ::: "memory");
    __syncthreads();
    if (threadIdx.x == 0) {
        unsigned* bar = b.bar;
        __builtin_amdgcn_s_waitcnt(0);
        unsigned nloc = b.st[0], nx = b.st[1];
        if (nloc == 0u) { xcd_barrier_complete(bar, b.x, nloc, nx); b.st[0] = nloc; b.st[1] = nx; }
        const unsigned old = xb_add(&bar[XB_XSUB(b.x)], 1u);
        const unsigned gen = old / nloc;
        if (old + 1u == (gen + 1u) * nloc) {
            __builtin_amdgcn_fence(__ATOMIC_RELEASE, "agent");
            asm volatile("s_waitcnt vmcnt(0)" ::: "memory");
            const unsigned og = xb_add(&bar[XB_TOP], 1u);
            const unsigned tg = og / nx;
            if (og + 1u == (tg + 1u) * nx) xb_add(&bar[XB_TOPGEN], 1u);
            else XB_SPIN(xb_ld(&bar[XB_TOPGEN]) == tg, bar);
            __builtin_amdgcn_fence(__ATOMIC_ACQUIRE, "agent");
            xb_add(&bar[XB_XGEN(b.x)], 1u);
            asm volatile("s_waitcnt vmcnt(0)" ::: "memory");
        } else {
            XB_SPIN(xb_ld(&bar[XB_XGEN(b.x)]) == gen, bar);
            __builtin_amdgcn_fence(__ATOMIC_ACQUIRE, "agent");
            asm volatile("s_waitcnt vmcnt(0)" ::: "memory");
        }
    }
    __syncthreads();
}

struct Args { const float* in[13]; float* out; unsigned char* ws; int ph_lo, ph_hi, li, pad; };
typedef __attribute__((address_space(4))) const Args CArgs;
__device__ __forceinline__ CArgs* kargs() { CArgs* p = (CArgs*)__builtin_amdgcn_kernarg_segment_ptr(); asm volatile("" : "+s"(p)); return p; }
#define KIN(k) (kargs()->in[k])

constexpr int CV_IGE = (D / 64) * (FF / 32), CV_IDE = (FF / 64) * (D / 32);
constexpr int CV_ITEMS = NE * (2 * CV_IGE + CV_IDE);
struct CvDesc { const float* W; unsigned char* WT; int N, K, rowb; };
__device__ __forceinline__ CvDesc cv_desc(unsigned char* ws, int l, int g) {
    CArgs* ka = kargs(); CvDesc d; int r = g < CV_ITEMS ? g : CV_ITEMS - 1;
    if (r < 2 * NE * CV_IGE) { const int aux = r >= NE * CV_IGE ? 1 : 0; r -= aux * NE * CV_IGE; const int e = r / CV_IGE, it = r - e * CV_IGE, kb = it / (FF / 32), nb = it - kb * (FF / 32), n0 = 32 * nb;
        d.W = (aux ? ka->in[10] : ka->in[9]) + (size_t)l * NE * D * FF + (size_t)e * D * FF + (size_t)(64 * kb) * FF + n0; d.N = FF; d.K = D;
        d.WT = ws + WS_WGU + (size_t)l * WGU_BYTES + (size_t)e * 2 * FF * D + 64 * kb; d.rowb = (n0 >> 7) * 256 + aux * 128 + (n0 & 127); }
    else { r -= 2 * NE * CV_IGE; const int e = r / CV_IDE, it = r - e * CV_IDE, kb = it >> 5, nb = it & 31;
        d.W = ka->in[11] + (size_t)l * NE * FF * D + (size_t)e * FF * D + (size_t)(64 * kb) * D + 32 * nb; d.N = D; d.K = FF;
        d.WT = ws + WS_WD + (size_t)l * WD_BYTES + (size_t)e * D * FF + 64 * kb; d.rowb = 32 * nb; }
    return d;
}
__device__ __forceinline__ void cv_load(f32x4 (&cv)[8], const CvDesc& d, int lane) {
    const float* p = d.W + (size_t)(4 * (lane >> 3)) * d.N + 4 * (lane & 7);
#pragma unroll
    for (int tt = 0; tt < 2; ++tt)
#pragma unroll
        for (int kk = 0; kk < 4; ++kk) cv[4 * tt + kk] = *(const f32x4*)(p + (size_t)(32 * tt + kk) * d.N);
}
__device__ __forceinline__ void cv_store(const f32x4 (&cv)[8], const CvDesc& d, int lane) {
    unsigned char* q = d.WT + (size_t)(d.rowb + 4 * (lane & 7)) * d.K + 4 * (lane >> 3);
#pragma unroll
    for (int tt = 0; tt < 2; ++tt)
#pragma unroll
        for (int j = 0; j < 4; ++j)
            *(unsigned*)(q + (size_t)j * d.K + 32 * tt) = pk4_fp8(cv[4 * tt][j] * WSCALE, cv[4 * tt + 1][j] * WSCALE, cv[4 * tt + 2][j] * WSCALE, cv[4 * tt + 3][j] * WSCALE);
}
template <bool B> struct BoolC { static constexpr bool value = B; };
namespace gm {
constexpr int BM = 256, BK = 64, HALF = 128, HTB = HALF * BK * 2, STAGE_BYTES = 8 * HTB, NXCD = 8, WGM = 8;
__host__ __device__ __forceinline__ int lds_byte(int r, int c) { const int st = (r >> 4) * 2 + (c >> 5), rr = r & 15, cc = c & 31, ob = rr * 64 + cc * 2; return st * 1024 + (ob ^ (((ob >> 9) & 1) << 5)); }
__host__ __device__ __forceinline__ void stage_rc(int b, int& R, int& C) { const int st = b / 1024, sb = b % 1024, swz = sb ^ (((sb >> 9) & 1) << 5); R = (st >> 1) * 16 + swz / 64; C = (st & 1) * 32 + (swz % 64) / 2; }
__host__ __device__ __forceinline__ int sig2(int x) { return ((x & 1) << 1) | (x >> 1); }
__host__ __device__ __forceinline__ int perm32(int rho) { const int n = rho >> 4, i = rho & 15; return 8 * sig2(i >> 2) + 4 * n + (i & 3); }
struct Unit { int pm, pn; };
struct StaticOrder {
    int nM, nN, nwg, G, c;
    __device__ void init(int Mr, int N, int G_, int c_) { nM = Mr / BM; nN = N / BM; nwg = nM * nN; G = G_; c = c_; }
    __device__ bool next(int i, Unit& u) const {
        const long L = (long)i * G + c; if (L >= nwg) return false;
        int wgid = (int)L; { const int q = nwg / NXCD, r = nwg % NXCD, xcd = wgid % NXCD, off = wgid / NXCD; wgid = (xcd < r ? xcd * (q + 1) : r * (q + 1) + (xcd - r) * q) + off; }
        const int nig = WGM * nN, gid = wgid / nig, fm = gid * WGM, gsz = (nM - fm) < WGM ? (nM - fm) : WGM;
        u.pm = fm + ((wgid % nig) % gsz); u.pn = (wgid % nig) / gsz; return true;
    }
};
struct ASrc { const char* base; const int* sel; int K; const float* rss; };
struct BSrc { const char* base; int eshift; size_t estride; };

template <class Epi, bool GATHER, bool FP8>
#ifndef GPROBE
#define GPROBE 0
#endif
__device__ __forceinline__ void gemm_phase(LAS unsigned char* lds, const ASrc A, const BSrc B, const StaticOrder& S, const Epi& E, unsigned long long& gp_acc) {
    unsigned long long gp_t = 0ull; (void)gp_t; (void)gp_acc;
    const int tid = fresh_v(threadIdx.x), wid = __builtin_amdgcn_readfirstlane(tid >> 6), lane = tid & 63, wr = wid >> 2, wc = wid & 3, fr = lane & 15, fq = lane >> 4;
    const int K = A.K, KB = FP8 ? K : 2 * K, nt = KB / (BK * 2);
    unsigned voffA0, voffA1, voffB0, voffB1;
    { int R0, R1, C0, C1; stage_rc(tid * 16, R0, C0); stage_rc(tid * 16 + 8192, R1, C1);
      const int Rb0 = Epi::PERM ? ((R0 & ~31) + perm32(R0 & 31)) : R0, Rb1 = Epi::PERM ? ((R1 & ~31) + perm32(R1 & 31)) : R1;
      voffA0 = (unsigned)(R0 * KB + C0 * 2); voffA1 = (unsigned)(R1 * KB + C1 * 2); voffB0 = (unsigned)(Rb0 * KB + C0 * 2); voffB1 = (unsigned)(Rb1 * KB + C1 * 2); }
    const unsigned kstep = (unsigned)(BK * 2);
    const unsigned hstep = (unsigned)HALF * (unsigned)KB;
    const unsigned tstep = 2u * hstep;
    const unsigned ldsw = (unsigned)wid * 1024u;
    const int aoff = lds_byte(wr * 64 + fr, fq * 8), boff = lds_byte(wc * 32 + fr, fq * 8);
    const __amdgpu_buffer_rsrc_t rA = __builtin_amdgcn_make_buffer_rsrc((void*)A.base, 0, 0xffffffff, 0x00020000);
    const __amdgpu_buffer_rsrc_t rB = __builtin_amdgcn_make_buffer_rsrc((void*)B.base, 0, 0xffffffff, 0x00020000);
#define G_SA(b, h) (((b) * 2 + (h)) * HTB)
#define G_SB(b, h) ((4 + (b) * 2 + (h)) * HTB)
#define G_LDS2(bufoff, rs, so, o0, o1) do { \
        __builtin_amdgcn_raw_ptr_buffer_load_lds(rs, (LAS unsigned*)(lds + (bufoff) + ldsw), 16, (o0), (so), 0, 0); \
        __builtin_amdgcn_raw_ptr_buffer_load_lds(rs, (LAS unsigned*)(lds + (bufoff) + ldsw + 8192), 16, (o1), (so), 0, 0); } while (0)
#define G_STB(bufoff, so) G_LDS2(bufoff, rB, so, voffB0, voffB1)
#define G_STA(bufoff, DSO, GSO, g0, g1) do { if constexpr (GATHER) { G_LDS2(bufoff, rA, GSO, g0, g1); } else { G_LDS2(bufoff, rA, DSO, voffA0, voffA1); } } while (0)
#define G_RD8(p) __builtin_shufflevector(*(const LAS i32x4*)(p), *(const LAS i32x4*)((p) + 1024), 0, 1, 2, 3, 4, 5, 6, 7)
#define G_LDA(dst, b, h) do { if constexpr (FP8) { _Pragma("unroll") for (int m = 0; m < 4; ++m) dst##8[m] = G_RD8(lds + G_SA(b, h) + aoff + m * 2048); } \
        else { _Pragma("unroll") for (int m = 0; m < 4; ++m) _Pragma("unroll") for (int k = 0; k < 2; ++k) dst[m][k] = *(const LAS bf16x8*)(lds + G_SA(b, h) + aoff + m * 2048 + k * 1024); } } while (0)
#define G_LDB(dst, b, h) do { if constexpr (FP8) { _Pragma("unroll") for (int n = 0; n < 2; ++n) dst##8[n] = G_RD8(lds + G_SB(b, h) + boff + n * 2048); } \
        else { _Pragma("unroll") for (int n = 0; n < 2; ++n) _Pragma("unroll") for (int k = 0; k < 2; ++k) dst[n][k] = *(const LAS bf16x8*)(lds + G_SB(b, h) + boff + n * 2048 + k * 1024); } } while (0)
#define G_MMA(ai, bj, At, Bt) do { __builtin_amdgcn_s_setprio(1); _Pragma("unroll") for (int m = 0; m < 4; ++m) _Pragma("unroll") for (int n = 0; n < 2; ++n) { \
        if constexpr (FP8) acc[ai][bj][m][n] = __builtin_amdgcn_mfma_scale_f32_16x16x128_f8f6f4(Bt##8[n], At##8[m], acc[ai][bj][m][n], 0, 0, 0, 0, 0, 0); \
        else { _Pragma("unroll") for (int k = 0; k < 2; ++k) acc[ai][bj][m][n] = __builtin_amdgcn_mfma_f32_16x16x32_bf16(Bt[n][k], At[m][k], acc[ai][bj][m][n], 0, 0, 0); } } \
        __builtin_amdgcn_s_setprio(0); } while (0)
#define G_WAIT_V(n) asm volatile("s_waitcnt vmcnt(" #n ")" ::: "memory")
#define G_WAIT_L(n) asm volatile("s_waitcnt lgkmcnt(" #n ")" ::: "memory")
#define G_WAIT_V8F() do { if (fresh) { if (Epi::HOST && hprev) asm volatile("s_waitcnt vmcnt(%0)" :: "n"(8 + Epi::NST + 8) : "memory"); else asm volatile("s_waitcnt vmcnt(%0)" :: "n"(8 + Epi::NST) : "memory"); } \
        else asm volatile("s_waitcnt vmcnt(8)" ::: "memory"); } while (0)
#define G_BAR __builtin_amdgcn_s_barrier()
#define G_SCHED __builtin_amdgcn_sched_barrier(0)
#define G_ROWS(u, v00, v01, v10, v11) do { const int rb_ = (u).pm * BM; const unsigned kb_ = (unsigned)KB; int r0_, c0_, r1_, c1_; { const int tz_ = fresh_v(tid); stage_rc(tz_ * 16, r0_, c0_); stage_rc(tz_ * 16 + 8192, r1_, c1_); } \
        if (A.sel) { v00 = (unsigned)A.sel[rb_ + r0_] * kb_ + (unsigned)c0_ * 2u; v01 = (unsigned)A.sel[rb_ + r1_] * kb_ + (unsigned)c1_ * 2u; \
        v10 = (unsigned)A.sel[rb_ + HALF + r0_] * kb_ + (unsigned)c0_ * 2u; v11 = (unsigned)A.sel[rb_ + HALF + r1_] * kb_ + (unsigned)c1_ * 2u; } \
        else { v00 = (unsigned)(rb_ + r0_) * kb_ + (unsigned)c0_ * 2u; v01 = (unsigned)(rb_ + r1_) * kb_ + (unsigned)c1_ * 2u; \
        v10 = (unsigned)(rb_ + HALF + r0_) * kb_ + (unsigned)c0_ * 2u; v11 = (unsigned)(rb_ + HALF + r1_) * kb_ + (unsigned)c1_ * 2u; } \
        asm volatile("" : "+v"(v00), "+v"(v01), "+v"(v10), "+v"(v11)); } while (0)
#define G_BOFF(u) ((unsigned)((u).pm >> B.eshift) * (unsigned)B.estride + (unsigned)(u).pn * tstep)
    Unit cur, nxt; int ui = 0; bool fresh = false, hprev = false;
    if (!S.next(0, cur)) return;
    f32x4 acc[2][2][4][2];
#pragma unroll
    for (int a = 0; a < 2; ++a)
#pragma unroll
        for (int b = 0; b < 2; ++b)
#pragma unroll
            for (int m = 0; m < 4; ++m)
#pragma unroll
                for (int n = 0; n < 2; ++n) acc[a][b][m][n] = (f32x4){0.f, 0.f, 0.f, 0.f};
    bf16x8 At[4][2], B0[2][2], B1[2][2]; v8i32 At8[4], B08[2], B18[2];
    unsigned vC00 = 0, vC01 = 0, vC10 = 0, vC11 = 0;
    LAS u32x4* const gslot = (LAS u32x4*)(lds + GOFF_OFF) + tid;
    LAS float* const rstab = (LAS float*)(lds + GOFF_OFF + 8192);
    int rspar = 0;
    if constexpr (Epi::NEED_RS) { if (tid < BM) rstab[tid] = A.rss[cur.pm * BM + tid]; }
    unsigned cA = (unsigned)cur.pm * tstep;
    unsigned cB = G_BOFF(cur);
    if constexpr (GATHER) { G_ROWS(cur, vC00, vC01, vC10, vC11); }
    G_STB(G_SB(0, 0), cB); G_STB(G_SB(0, 1), cB + hstep); G_STA(G_SA(0, 0), cA, 0u, vC00, vC01); G_STA(G_SA(0, 1), cA + hstep, 0u, vC10, vC11);
    if (wr == 1) G_BAR;
    G_WAIT_V(2); G_BAR;
    G_STB(G_SB(1, 0), cB + kstep); G_STA(G_SA(1, 0), cA + kstep, kstep, vC00, vC01); G_STB(G_SB(1, 1), cB + hstep + kstep);
    G_WAIT_V(6); G_BAR;
    for (;;) {
        const bool has_next = S.next(ui + 1, nxt);
        const unsigned nA = has_next ? (unsigned)nxt.pm * tstep : cA;
        const unsigned nB = has_next ? G_BOFF(nxt) : cB;
        if constexpr (GATHER) {
            unsigned n00 = vC00, n01 = vC01, n10 = vC10, n11 = vC11;
            if (has_next && nxt.pm != cur.pm) { G_ROWS(nxt, n00, n01, n10, n11);
                if constexpr (Epi::NEED_RS) { if (tid < BM) rstab[(rspar ^ 1) * BM + tid] = A.rss[nxt.pm * BM + tid]; } }
            *gslot = (u32x4){n00, n01, n10, n11};
        }
        if (GPROBE == 1 && ui > 0) gp_acc += __builtin_amdgcn_s_memrealtime() - gp_t;
#pragma unroll 1
        for (int t = 0; t < nt; t += 2) {
            if (GPROBE == 2 && ui > 0 && t == 0) gp_t = __builtin_amdgcn_s_memrealtime();
            if (GPROBE == 2 && ui > 0 && t == 2) gp_acc += __builtin_amdgcn_s_memrealtime() - gp_t;
            if (GPROBE == 3 && t == 2) gp_t = __builtin_amdgcn_s_memrealtime();
            const bool last = (t == nt - 2);
            const unsigned a1 = cA + (unsigned)(t + 1) * kstep;
            const unsigned g1 = (unsigned)(t + 1) * kstep;
            const unsigned a2 = last ? nA : cA + (unsigned)(t + 2) * kstep; const unsigned b2 = last ? nB : cB + (unsigned)(t + 2) * kstep;
            const unsigned g2 = last ? 0u : (unsigned)(t + 2) * kstep;
            const unsigned a3 = a2 + kstep; const unsigned b3 = b2 + kstep; const unsigned g3 = g2 + kstep;
            G_LDB(B0, 0, 0); G_LDB(B1, 0, 1); G_SCHED; G_LDA(At, 0, 0); if (!fresh) G_STA(G_SA(1, 1), a1 + hstep, g1, vC10, vC11);
            if constexpr (GATHER) { if (last) { const u32x4 nv = *gslot; vC00 = nv.x; vC01 = nv.y; vC10 = nv.z; vC11 = nv.w; } }
            G_WAIT_V8F(); G_WAIT_L(0); G_BAR; G_MMA(0, 0, At, B0); G_MMA(0, 1, At, B1); G_BAR; G_SCHED;
            G_LDA(At, 0, 1); G_STB(G_SB(0, 0), b2); G_STB(G_SB(0, 1), b2 + hstep); G_STA(G_SA(0, 0), a2, g2, vC00, vC01);
            G_WAIT_V8F(); G_WAIT_L(0); G_BAR; G_MMA(1, 0, At, B0); G_MMA(1, 1, At, B1); G_BAR; G_SCHED;
            G_LDB(B0, 1, 0); G_LDB(B1, 1, 1); G_SCHED; G_LDA(At, 1, 0); G_STA(G_SA(0, 1), a2 + hstep, g2, vC10, vC11);
            G_WAIT_V8F(); fresh = false; G_WAIT_L(0); G_BAR; G_MMA(0, 0, At, B0); G_MMA(0, 1, At, B1); G_BAR; G_SCHED;
            G_LDA(At, 1, 1); G_STB(G_SB(1, 0), b3); G_STB(G_SB(1, 1), b3 + hstep); G_STA(G_SA(1, 0), a3, g3, vC00, vC01);
            G_WAIT_V(8); G_WAIT_L(0); G_BAR; G_MMA(1, 0, At, B0); G_MMA(1, 1, At, B1); G_BAR; G_SCHED;
        }
        if (GPROBE == 3) gp_acc += __builtin_amdgcn_s_memrealtime() - gp_t;
        if (GPROBE == 1) gp_t = __builtin_amdgcn_s_memrealtime();
        G_STA(G_SA(1, 1), nA + kstep + hstep, kstep, vC10, vC11);
        if (wr == 0) G_BAR;
        f32x4 cvr[8]; bool hnow = false;
        if constexpr (Epi::HOST) { hnow = ui < E.hostn; if (hnow) { const CvDesc cd = cv_desc(E.ws, 1, E.cvg0 + E.cvstep * ui); cv_load(cvr, cd, lane); } }
        if constexpr (Epi::NEED_RS) E(acc, cur, wr, wc, fr, fq, rstab + rspar * BM); else E(acc, cur, wr, wc, fr, fq);
        if constexpr (Epi::HOST) { if (hnow) { const CvDesc cd = cv_desc(E.ws, 1, E.cvg0 + E.cvstep * ui); cv_store(cvr, cd, lane); } }
        if (!has_next) break;
        if constexpr (Epi::NEED_RS) { if (nxt.pm != cur.pm) rspar ^= 1; }
#pragma unroll
        for (int a = 0; a < 2; ++a)
#pragma unroll
            for (int b = 0; b < 2; ++b)
#pragma unroll
                for (int m = 0; m < 4; ++m)
#pragma unroll
                    for (int n = 0; n < 2; ++n) acc[a][b][m][n] = (f32x4){0.f, 0.f, 0.f, 0.f};
        cur = nxt; cA = nA; cB = nB; ++ui; fresh = true; hprev = hnow;
        if (wr == 1) G_BAR;
    }
    G_WAIT_V(0);
    G_BAR;
#undef G_SA
#undef G_SB
#undef G_LDS2
#undef G_STB
#undef G_STA
#undef G_LDA
#undef G_LDB
#undef G_MMA
#undef G_RD8
#undef G_WAIT_V
#undef G_WAIT_L
#undef G_WAIT_V8F
#undef G_BAR
#undef G_SCHED
#undef G_ROWS
#undef G_BOFF
}

struct EpiQKV {
    static constexpr bool NEED_RS = false; static constexpr bool PERM = true; static constexpr bool HOST = false; static constexpr int NST = 16;
    bf16_t* O; const float* rope;
    __device__ __forceinline__ void operator()(const f32x4 (&acc)[2][2][4][2], const Unit& u, int wr, int wc, int fr, int fq) const {
        const int row0 = u.pm * BM + wr * 64 + fr, col0 = u.pn * BM + wc * 32 + 8 * sig2(fq);
        const bool do_rope = u.pn < 4;
        const float sc = (u.pn < 2 || (u.pn >= 6 && u.pn < 8)) ? QSCALE : 1.0f;
        const int i0 = (wc & 1) * 16 + 4 * sig2(fq);
        f32x4 cs[2][4][2];
#pragma unroll
        for (int ai = 0; ai < 2; ++ai)
#pragma unroll
            for (int m = 0; m < 4; ++m) { cs[ai][m][0] = (f32x4){1.f, 0.f, 1.f, 0.f}; cs[ai][m][1] = cs[ai][m][0];
                if (do_rope) { const float* rp = rope + ((size_t)((row0 + ai * HALF + m * 16) & (T - 1)) * 32 + i0) * 2; cs[ai][m][0] = *(const f32x4*)rp; cs[ai][m][1] = *(const f32x4*)(rp + 4); } }
#pragma unroll
        for (int ai = 0; ai < 2; ++ai)
#pragma unroll
            for (int m = 0; m < 4; ++m) {
                const int row = row0 + ai * HALF + m * 16;
                const int bb = row >> 13, tt = row & (T - 1);
                const f32x4 cs0 = cs[ai][m][0], cs1 = cs[ai][m][1];
#pragma unroll
                for (int bj = 0; bj < 2; ++bj) {
                    f32x4 v0 = acc[ai][bj][m][0], v1 = acc[ai][bj][m][1];
                    if (do_rope) {
                        const f32x4 a = v0, b = v1;
                        v0[0] = a[0] * cs0[0] - a[1] * cs0[1]; v0[1] = a[1] * cs0[0] + a[0] * cs0[1];
                        v0[2] = a[2] * cs0[2] - a[3] * cs0[3]; v0[3] = a[3] * cs0[2] + a[2] * cs0[3];
                        v1[0] = b[0] * cs1[0] - b[1] * cs1[1]; v1[1] = b[1] * cs1[0] + b[0] * cs1[1];
                        v1[2] = b[2] * cs1[2] - b[3] * cs1[3]; v1[3] = b[3] * cs1[2] + b[2] * cs1[3];
                    }
                    v0 = v0 * sc; v1 = v1 * sc;
                    u32x4 w; w.x = cvt_pk_bf16(v0[0], v0[1]); w.y = cvt_pk_bf16(v0[2], v0[3]); w.z = cvt_pk_bf16(v1[0], v1[1]); w.w = cvt_pk_bf16(v1[2], v1[3]);
                    const int cc = col0 + bj * HALF;
                    *(u32x4*)(O + ((((size_t)((cc >> 9) * BATCH + bb) * 8 + ((cc >> 6) & 7)) * T + tt) << 6) + (cc & 63)) = w;
                }
            }
    }
};
struct EpiBf16Out {
    static constexpr bool NEED_RS = false; static constexpr bool PERM = true; static constexpr bool HOST = false; static constexpr int NST = 16;
    bf16_t* O;
    __device__ __forceinline__ void operator()(const f32x4 (&acc)[2][2][4][2], const Unit& u, int wr, int wc, int fr, int fq) const {
        const int row0 = u.pm * BM + wr * 64 + fr, col0 = u.pn * BM + wc * 32 + 8 * sig2(fq);
#pragma unroll
        for (int ai = 0; ai < 2; ++ai)
#pragma unroll
            for (int m = 0; m < 4; ++m) { bf16_t* rowp = O + (size_t)(row0 + ai * HALF + m * 16) * D + col0;
#pragma unroll
                for (int bj = 0; bj < 2; ++bj) { const f32x4 v0 = acc[ai][bj][m][0], v1 = acc[ai][bj][m][1];
                    u32x4 w; w.x = cvt_pk_bf16(v0[0], v0[1]); w.y = cvt_pk_bf16(v0[2], v0[3]); w.z = cvt_pk_bf16(v1[0], v1[1]); w.w = cvt_pk_bf16(v1[2], v1[3]);
                    *(u32x4*)(rowp + bj * HALF) = w; } }
    }
};
struct EpiResid {
    static constexpr bool NEED_RS = false; static constexpr bool PERM = false; static constexpr bool HOST = false; static constexpr int NST = 0;
    const float* resid; float* out;
    __device__ __forceinline__ void operator()(const f32x4 (&acc)[2][2][4][2], const Unit& u, int wr, int wc, int fr, int fq) const {
        const int row0 = u.pm * BM + wr * 64 + fr, col0 = u.pn * BM + wc * 32 + 4 * fq;
#pragma unroll
        for (int ai = 0; ai < 2; ++ai)
#pragma unroll
            for (int m = 0; m < 4; ++m) { const size_t off = (size_t)(row0 + ai * HALF + m * 16) * D + col0;
#pragma unroll
                for (int bj = 0; bj < 2; ++bj)
#pragma unroll
                    for (int n = 0; n < 2; ++n) { const f32x4 r = *(const f32x4*)(resid + off + bj * HALF + n * 16); *(f32x4*)(out + off + bj * HALF + n * 16) = r + acc[ai][bj][m][n]; }
                if (m & 1) asm volatile("" ::: "memory"); }
    }
};
struct EpiSwiGLU {
    static constexpr bool NEED_RS = true; static constexpr bool PERM = true; static constexpr bool HOST = true; static constexpr int NST = 4;
    unsigned char* O; unsigned char* ws; int hostn, cvg0, cvstep;
    __device__ __forceinline__ void operator()(const f32x4 (&acc)[2][2][4][2], const Unit& u, int wr, int wc, int fr, int fq, const LAS float* rst) const {
        const int hi = fq >> 1;
        const int row0 = u.pm * BM + wr * 64 + fr + 16 * hi, col0 = u.pn * HALF + wc * 32 + 8 * sig2(fq) - 8 * hi;
#pragma unroll
        for (int ai = 0; ai < 2; ++ai)
#pragma unroll
            for (int mp = 0; mp < 2; ++mp) {
                u32x2 w[2];
#pragma unroll
                for (int mm = 0; mm < 2; ++mm) { const int m = 2 * mp + mm;
                    const float rs = rst[ai * HALF + wr * 64 + m * 16 + fr], ce = rs * (-LOG2E * WINV), q = (WSCALE * WSCALE) * __builtin_amdgcn_rcpf(rs * rs);
                    float r[8];
                    const f32x2 ce2 = (f32x2){ce, ce}, q2 = (f32x2){q, q};
#pragma unroll
                    for (int n = 0; n < 2; ++n)
#pragma unroll
                        for (int jp = 0; jp < 2; ++jp) {
                            const f32x2 G2 = (f32x2){acc[ai][0][m][n][2 * jp], acc[ai][0][m][n][2 * jp + 1]}, U2 = (f32x2){acc[ai][1][m][n][2 * jp], acc[ai][1][m][n][2 * jp + 1]};
                            const f32x2 x2 = G2 * ce2;
                            const f32x2 e2 = (f32x2){__builtin_amdgcn_exp2f(x2[0]), __builtin_amdgcn_exp2f(x2[1])};
                            const f32x2 d2 = __builtin_elementwise_fma(e2, q2, q2);
                            const f32x2 r2 = (f32x2){__builtin_amdgcn_rcpf(d2[0]), __builtin_amdgcn_rcpf(d2[1])};
                            const f32x2 o2 = (G2 * U2) * r2;
                            r[n * 4 + 2 * jp] = o2[0]; r[n * 4 + 2 * jp + 1] = o2[1]; }
                    w[mm].x = pk4_fp8(r[0], r[1], r[2], r[3]); w[mm].y = pk4_fp8(r[4], r[5], r[6], r[7]); }
                const auto sx = __builtin_amdgcn_permlane32_swap(w[0].x, w[1].x, false, false), sy = __builtin_amdgcn_permlane32_swap(w[0].y, w[1].y, false, false);
                u32x4 v; v.x = sx[0]; v.y = sy[0]; v.z = sx[1]; v.w = sy[1];
                *(u32x4*)(O + (size_t)(row0 + ai * HALF + mp * 32) * FF + col0) = v;
            }
    }
};
struct EpiDown {
    static constexpr bool NEED_RS = false; static constexpr bool PERM = true; static constexpr bool HOST = false; static constexpr int NST = 8;
    unsigned char* O; const float* gatev;
    __device__ __forceinline__ void operator()(const f32x4 (&acc)[2][2][4][2], const Unit& u, int wr, int wc, int fr, int fq) const {
        const int hi = fq >> 1;
        const int row0 = u.pm * BM + wr * 64 + fr + 16 * hi, col0 = u.pn * BM + wc * 32 + 8 * sig2(fq) - 8 * hi;
        const float gv = WINV * YSCALE;
#pragma unroll
        for (int ai = 0; ai < 2; ++ai)
#pragma unroll
            for (int mp = 0; mp < 2; ++mp) {
                unsigned char* rowp = O + (size_t)(row0 + ai * HALF + mp * 32) * D + col0;
#pragma unroll
                for (int bj = 0; bj < 2; ++bj) {
                    u32x2 w[2];
#pragma unroll
                    for (int mm = 0; mm < 2; ++mm) { const f32x4 v0 = acc[ai][bj][2 * mp + mm][0] * gv, v1 = acc[ai][bj][2 * mp + mm][1] * gv;
                        w[mm].x = pk4_fp8(v0[0], v0[1], v0[2], v0[3]); w[mm].y = pk4_fp8(v1[0], v1[1], v1[2], v1[3]); }
                    const auto sx = __builtin_amdgcn_permlane32_swap(w[0].x, w[1].x, false, false), sy = __builtin_amdgcn_permlane32_swap(w[0].y, w[1].y, false, false);
                    u32x4 v; v.x = sx[0]; v.y = sy[0]; v.z = sx[1]; v.w = sy[1];
                    *(u32x4*)(rowp + bj * HALF) = v; }
            }
    }
};
}

struct Frame {
    LAS unsigned char* lds;
    int tid, lane, wave, vcu, G;
    float* out; unsigned char* ws;
};
template <int MODE> __device__ __forceinline__ int dest_row(int n, int aux) {
    if (MODE == 1) return n < 1024 ? ((n & ~63) + 2 * (n & 31) + ((n >> 5) & 1)) : n;
    if (MODE == 2) return (n >> 7) * 256 + aux * 128 + (n & 127);
    return n;
}
template <int MODE> __device__ __forceinline__ void conv_item(const float* W, int K, int N, bf16_t* WT, int aux, LAS float* scr, int item, int lane) {
    const int nblk = N / 32, kb = item / nblk, nb = item - kb * nblk, k0 = 64 * kb, n0 = 32 * nb;
    f32x4 v[8];
#pragma unroll
    for (int it = 0; it < 8; ++it) { const int kk = 8 * it + (lane >> 3); v[it] = *(const f32x4*)(W + (size_t)(k0 + kk) * N + n0 + 4 * (lane & 7)); }
#pragma unroll
    for (int it = 0; it < 8; ++it) { const int kk = 8 * it + (lane >> 3); LAS float* s = scr + kk * 33 + 4 * (lane & 7); s[0] = v[it][0]; s[1] = v[it][1]; s[2] = v[it][2]; s[3] = v[it][3]; }
    LDS_WAIT(); asm volatile("" ::: "memory");
    const int c = lane & 7;
#pragma unroll
    for (int j = 0; j < 4; ++j) { const int n = (lane >> 3) + 8 * j; const LAS float* s = scr + (8 * c) * 33 + n;
        u32x4 o; o.x = cvt_pk_bf16(s[0 * 33], s[1 * 33]); o.y = cvt_pk_bf16(s[2 * 33], s[3 * 33]); o.z = cvt_pk_bf16(s[4 * 33], s[5 * 33]); o.w = cvt_pk_bf16(s[6 * 33], s[7 * 33]);
        *(u32x4*)(WT + (size_t)dest_row<MODE>(n0 + n, aux) * K + k0 + 8 * c) = o; }
    LDS_WAIT(); asm volatile("" ::: "memory");
}
template <int MODE> __device__ __forceinline__ void conv_item8(const float* W, int K, int N, unsigned char* WT, int aux, LAS float* scr, int item, int lane) {
    const int nblk = N / 32, kb = item / nblk, nb = item - kb * nblk, k0 = 64 * kb, n0 = 32 * nb;
    f32x4 v[8];
#pragma unroll
    for (int it = 0; it < 8; ++it) { const int kk = 8 * it + (lane >> 3); v[it] = *(const f32x4*)(W + (size_t)(k0 + kk) * N + n0 + 4 * (lane & 7)); }
#pragma unroll
    for (int it = 0; it < 8; ++it) { const int kk = 8 * it + (lane >> 3); LAS float* s = scr + kk * 33 + 4 * (lane & 7); s[0] = v[it][0]; s[1] = v[it][1]; s[2] = v[it][2]; s[3] = v[it][3]; }
    LDS_WAIT(); asm volatile("" ::: "memory");
    const int c = lane & 3;
#pragma unroll
    for (int j = 0; j < 2; ++j) { const int n = (lane >> 2) + 16 * j; const LAS float* s = scr + (16 * c) * 33 + n;
        u32x4 o;
        o.x = pk4_fp8(s[0 * 33] * WSCALE, s[1 * 33] * WSCALE, s[2 * 33] * WSCALE, s[3 * 33] * WSCALE); o.y = pk4_fp8(s[4 * 33] * WSCALE, s[5 * 33] * WSCALE, s[6 * 33] * WSCALE, s[7 * 33] * WSCALE);
        o.z = pk4_fp8(s[8 * 33] * WSCALE, s[9 * 33] * WSCALE, s[10 * 33] * WSCALE, s[11 * 33] * WSCALE); o.w = pk4_fp8(s[12 * 33] * WSCALE, s[13 * 33] * WSCALE, s[14 * 33] * WSCALE, s[15 * 33] * WSCALE);
        *(u32x4*)(WT + (size_t)dest_row<MODE>(n0 + n, aux) * K + k0 + 16 * c) = o; }
    LDS_WAIT(); asm volatile("" ::: "memory");
}
__device__ __forceinline__ void conv_weights(Frame& F0, int l, bool experts) {
    Frame F = F0; F.tid = fresh_v(F0.tid); F.lane = F.tid & 63; F.wave = fresh_s(F0.wave);
    LAS float* scr = (LAS float*)(F.lds + F.wave * 16384);
    const int gw = F.vcu * NWAVES + F.wave, NGW = F.G * NWAVES;
    constexpr int I_IN = (D / 64) * (NQKV / 32), I_OUT = (D / 64) * (D / 32), I_GE = (D / 64) * (FF / 32), I_DE = (FF / 64) * (D / 32);
    constexpr int NITEMS = I_IN + I_OUT + NE * (2 * I_GE + I_DE);
    CArgs* ka = kargs();
    const float* w_in = ka->in[2] + (size_t)l * D * NQKV; const float* w_out = ka->in[6] + (size_t)l * D * D;
    const float* w_gate = ka->in[9] + (size_t)l * NE * D * FF; const float* w_up = ka->in[10] + (size_t)l * NE * D * FF; const float* w_down = ka->in[11] + (size_t)l * NE * FF * D;
    bf16_t* WIN = (bf16_t*)(F.ws + WS_WIN); bf16_t* WOUT = (bf16_t*)(F.ws + WS_WOUT); unsigned char* WGU = F.ws + WS_WGU + (size_t)l * WGU_BYTES; unsigned char* WD = F.ws + WS_WD + (size_t)l * WD_BYTES;
    const int nit = experts ? NITEMS : I_IN + I_OUT;
    for (int it = gw; it < nit; it += NGW) {
        int r = it;
        if (r < I_IN) { conv_item<1>(w_in, D, NQKV, WIN, 0, scr, r, F.lane); continue; } r -= I_IN;
        if (r < I_OUT) { conv_item<0>(w_out, D, D, WOUT, 0, scr, r, F.lane); continue; } r -= I_OUT;
        if (r < NE * I_GE) { const int e = r / I_GE; conv_item8<2>(w_gate + (size_t)e * D * FF, D, FF, WGU + (size_t)e * 2 * FF * D, 0, scr, r - e * I_GE, F.lane); continue; } r -= NE * I_GE;
        if (r < NE * I_GE) { const int e = r / I_GE; conv_item8<2>(w_up + (size_t)e * D * FF, D, FF, WGU + (size_t)e * 2 * FF * D, 1, scr, r - e * I_GE, F.lane); continue; } r -= NE * I_GE;
        { const int e = r / I_DE; conv_item8<0>(w_down + (size_t)e * FF * D, FF, D, WD + (size_t)e * D * FF, 0, scr, r - e * I_DE, F.lane); }
    }
}
__device__ const double INVF[32] = {
    1.0, 0.7498942093324559, 0.5623413251903491, 0.4216965034285822, 0.31622776601683794, 0.23713737056616552, 0.1778279410038923, 0.1333521432163324,
    0.1, 0.07498942093324558, 0.05623413251903491, 0.042169650342858224, 0.03162277660168379, 0.023713737056616554, 0.01778279410038923, 0.01333521432163324,
    0.01, 0.007498942093324558, 0.005623413251903491, 0.004216965034285823, 0.0031622776601683794, 0.0023713737056616554, 0.0017782794100389228, 0.001333521432163324,
    0.001, 0.0007498942093324559, 0.0005623413251903491, 0.00042169650342858224, 0.00031622776601683794, 0.00023713737056616554, 0.00017782794100389227, 0.0001333521432163324};
__device__ __forceinline__ void rope_table(Frame& F0) {
    Frame F = F0; F.tid = fresh_v(F0.tid); F.lane = F.tid & 63; F.wave = fresh_s(F0.wave);
    float* tab = (float*)(F.ws + WS_ROPE);
    for (int idx = F.vcu * NTHREADS + F.tid; idx < T * 32; idx += F.G * NTHREADS) {
        const int t = idx >> 5, i = idx & 31;
        const double ang = (double)t * INVF[i];
        const double n = __builtin_rint(ang * 0.15915494309189535);
        double r = __builtin_fma(-n, 6.283185307179586, ang); r = __builtin_fma(-n, 2.4492935982947064e-16, r);
        const double x = r * 0.25, x2 = x * x;
        double s = -1.0 / 1307674368000.0; s = s * x2 + 1.0 / 6227020800.0; s = s * x2 - 1.0 / 39916800.0; s = s * x2 + 1.0 / 362880.0; s = s * x2 - 1.0 / 5040.0; s = s * x2 + 1.0 / 120.0; s = s * x2 - 1.0 / 6.0; s = s * x2 + 1.0; s = s * x;
        double c = 1.0 / 20922789888000.0; c = c * x2 - 1.0 / 87178291200.0; c = c * x2 + 1.0 / 479001600.0; c = c * x2 - 1.0 / 3628800.0; c = c * x2 + 1.0 / 40320.0; c = c * x2 - 1.0 / 720.0; c = c * x2 + 1.0 / 24.0; c = c * x2 - 0.5; c = c * x2 + 1.0;
        const double s2 = 2.0 * s * c, c2 = 1.0 - 2.0 * s * s; const double s4 = 2.0 * s2 * c2, c4 = 1.0 - 2.0 * s2 * s2;
        *(f32x2*)(tab + (size_t)idx * 2) = (f32x2){(float)c4, (float)s4};
    }
}
__device__ __forceinline__ void store_bf16_row(bf16_t* orow, const f32x4 (&v)[4], int lane) {
    u32x2* o8 = (u32x2*)orow + lane;
#pragma unroll
    for (int j = 0; j < 4; ++j) { u32x2 w; w.x = cvt_pk_bf16(v[j][0], v[j][1]); w.y = cvt_pk_bf16(v[j][2], v[j][3]); o8[64 * j] = w; }
}
__device__ __forceinline__ float row_rstd(const f32x4 (&v)[4]) {
    float s = 0.f;
#pragma unroll
    for (int j = 0; j < 4; ++j) s += (v[j][0] * v[j][0] + v[j][1] * v[j][1]) + (v[j][2] * v[j][2] + v[j][3] * v[j][3]);
    return 1.0f / sqrtf(wave_sum(s) * (1.0f / D) + EPS);
}
__device__ __forceinline__ void norm1_phase(Frame& F0, const float* x, const float* gain) {
    Frame F = F0; F.tid = fresh_v(F0.tid); F.lane = F.tid & 63; F.wave = fresh_s(F0.wave);
    bf16_t* H = (bf16_t*)(F.ws + WS_H);
    const int gw = F.vcu * NWAVES + F.wave, NGW = F.G * NWAVES;
    f32x4 g[4];
#pragma unroll
    for (int j = 0; j < 4; ++j) g[j] = *((const f32x4*)gain + 64 * j + F.lane);
#pragma unroll 1
    for (int m = gw; m < M; m += NGW) {
        const f32x4* xr = (const f32x4*)(x + (size_t)m * D) + F.lane; f32x4 v[4];
#pragma unroll
        for (int j = 0; j < 4; ++j) v[j] = xr[64 * j];
        const float rstd = row_rstd(v);
#pragma unroll
        for (int j = 0; j < 4; ++j) v[j] = v[j] * rstd * g[j];
        store_bf16_row(H + (size_t)m * D, v, F.lane);
    }
}
constexpr int N2_WHI = 0, N2_WLO = 32768, N2_GAIN = 65536;
template <bool XBF>
__device__ __forceinline__ void norm2_router_phase(Frame& F0, const void* xin, bf16_t* x1, const float* gain, const float* wr) {
    Frame F = F0; F.tid = fresh_v(F0.tid); F.lane = F.tid & 63; F.wave = fresh_s(F0.wave);
    unsigned char* H8 = F.ws + WS_H; float* AFF = (float*)(F.ws + WS_AFF); const bf16_t* Aat = (const bf16_t*)(F.ws + WS_PARTA); float* RSTD = (float*)(F.ws + WS_RSTD);
    for (int idx = F.tid; idx < D * NE; idx += NTHREADS) { const int d = idx >> 4, e = idx & 15; const float w = wr[idx];
        const unsigned hi = cvt_pk_bf16(w, 0.f) & 0xffffu; const float rem = w - __uint_as_float(hi << 16); const unsigned lo = cvt_pk_bf16(rem, 0.f) & 0xffffu;
        const int o = ((((d >> 5) * 4 + ((d >> 3) & 3)) * 16 + e) * 8 + (d & 7)) * 2;
        *(LAS bf16_t*)(F.lds + N2_WHI + o) = (bf16_t)hi; *(LAS bf16_t*)(F.lds + N2_WLO + o) = (bf16_t)lo; }
    for (int idx = F.tid; idx < D; idx += NTHREADS) ((LAS float*)(F.lds + N2_GAIN))[idx] = gain[idx];
    __syncthreads();
    const int lane = F.lane, i = lane & 15, g = lane >> 4;
    const int gw = F.vcu * NWAVES + F.wave, NGW = F.G * NWAVES;
#pragma unroll 1
    for (int tile = gw; tile < M / 16; tile += NGW) {
        const int row = tile * 16 + i;
        const f32x4* xr = (const f32x4*)((const float*)xin + (size_t)row * D + 8 * g); const u32x4* xrb = (const u32x4*)((const bf16_t*)xin + (size_t)row * D + 8 * g);
        u32x4* xo = (u32x4*)(x1 + (size_t)row * D + 8 * g);
        const u32x4* ar = (const u32x4*)(Aat + (size_t)row * D + 8 * g); u32x2* ho = (u32x2*)(H8 + (size_t)row * D + 8 * g);
        f32x4 acc = (f32x4){0.f, 0.f, 0.f, 0.f}; float ssq = 0.f;
#pragma unroll 1
        for (int kq = 0; kq < 8; ++kq) {
            f32x4 xa[4], xb[4]; u32x4 aw[4], xw[4];
#pragma unroll
            for (int s = 0; s < 4; ++s) { const int ks = 4 * kq + s; if (XBF) xw[s] = xrb[4 * ks]; else { xa[s] = xr[8 * ks]; xb[s] = xr[8 * ks + 1]; } aw[s] = ar[4 * ks]; }
#pragma unroll
            for (int s = 0; s < 4; ++s) { const int ks = 4 * kq + s;
                f32x4 va, vb;
                if (XBF) { va = (f32x4){bf_lo(xw[s].x), bf_hi(xw[s].x), bf_lo(xw[s].y), bf_hi(xw[s].y)}; vb = (f32x4){bf_lo(xw[s].z), bf_hi(xw[s].z), bf_lo(xw[s].w), bf_hi(xw[s].w)}; } else { va = xa[s]; vb = xb[s]; }
                va[0] += bf_lo(aw[s].x); va[1] += bf_hi(aw[s].x); va[2] += bf_lo(aw[s].y); va[3] += bf_hi(aw[s].y);
                vb[0] += bf_lo(aw[s].z); vb[1] += bf_hi(aw[s].z); vb[2] += bf_lo(aw[s].w); vb[3] += bf_hi(aw[s].w);
                { u32x4 xw1; xw1.x = cvt_pk_bf16(va[0], va[1]); xw1.y = cvt_pk_bf16(va[2], va[3]); xw1.z = cvt_pk_bf16(vb[0], vb[1]); xw1.w = cvt_pk_bf16(vb[2], vb[3]); xo[4 * ks] = xw1; }
                ssq += (va[0] * va[0] + va[1] * va[1]) + (va[2] * va[2] + va[3] * va[3]) + (vb[0] * vb[0] + vb[1] * vb[1]) + (vb[2] * vb[2] + vb[3] * vb[3]);
                const f32x4 ga = *(const LAS f32x4*)(F.lds + N2_GAIN + (32 * ks + 8 * g) * 4), gb = *(const LAS f32x4*)(F.lds + N2_GAIN + (32 * ks + 8 * g + 4) * 4);
                va = va * ga; vb = vb * gb;
                u32x2 h8; h8.x = pk4_fp8(va[0], va[1], va[2], va[3]); h8.y = pk4_fp8(vb[0], vb[1], vb[2], vb[3]); ho[4 * ks] = h8;
                u32x4 hi; hi.x = cvt_pk_bf16(va[0], va[1]); hi.y = cvt_pk_bf16(va[2], va[3]); hi.z = cvt_pk_bf16(vb[0], vb[1]); hi.w = cvt_pk_bf16(vb[2], vb[3]);
                u32x4 lo; lo.x = cvt_pk_bf16(va[0] - bf_lo(hi.x), va[1] - bf_hi(hi.x)); lo.y = cvt_pk_bf16(va[2] - bf_lo(hi.y), va[3] - bf_hi(hi.y));
                lo.z = cvt_pk_bf16(vb[0] - bf_lo(hi.z), vb[1] - bf_hi(hi.z)); lo.w = cvt_pk_bf16(vb[2] - bf_lo(hi.w), vb[3] - bf_hi(hi.w));
                const bf16x8 whi = *(const LAS bf16x8*)(F.lds + N2_WHI + (ks * 64 + lane) * 16), wlo = *(const LAS bf16x8*)(F.lds + N2_WLO + (ks * 64 + lane) * 16);
                const bf16x8 thi = __builtin_bit_cast(bf16x8, hi), tlo = __builtin_bit_cast(bf16x8, lo);
                acc = __builtin_amdgcn_mfma_f32_16x16x32_bf16(whi, thi, acc, 0, 0, 0);
                acc = __builtin_amdgcn_mfma_f32_16x16x32_bf16(wlo, thi, acc, 0, 0, 0);
                acc = __builtin_amdgcn_mfma_f32_16x16x32_bf16(whi, tlo, acc, 0, 0, 0);
            }
        }
        ssq += __shfl_xor(ssq, 16); ssq += __shfl_xor(ssq, 32);
        const float rstd = 1.0f / sqrtf(ssq * (1.0f / D) + EPS);
        if (g == 0) RSTD[row] = rstd;
        f32x4 lg = acc * rstd;
        float mx = fmaxf(fmaxf(lg[0], lg[1]), fmaxf(lg[2], lg[3])); mx = fmaxf(mx, __shfl_xor(mx, 16)); mx = fmaxf(mx, __shfl_xor(mx, 32));
        f32x4 ex; ex[0] = __expf(lg[0] - mx); ex[1] = __expf(lg[1] - mx); ex[2] = __expf(lg[2] - mx); ex[3] = __expf(lg[3] - mx);
        float sum = (ex[0] + ex[1]) + (ex[2] + ex[3]); sum += __shfl_xor(sum, 16); sum += __shfl_xor(sum, 32);
        const float inv = 1.0f / sum;
        float* ap = AFF + ((size_t)(row >> 13) * NE + 4 * g) * T + (row & (T - 1));
#pragma unroll
        for (int r = 0; r < 4; ++r) ap[(size_t)r * T] = ex[r] * inv;
    }
    __syncthreads();
}
__device__ __forceinline__ void topk_phase(Frame& F0) {
    Frame F = F0; F.tid = fresh_v(F0.tid); F.lane = F.tid & 63; F.wave = fresh_s(F0.wave);
    const float* AFF = (const float*)(F.ws + WS_AFF); int* INV = (int*)(F.ws + WS_INV); int* SEL = (int*)(F.ws + WS_SEL); float* GATEV = (float*)(F.ws + WS_GATEV);
    const float* RSTD = (const float*)(F.ws + WS_RSTD); float* RSS = (float*)(F.ws + WS_RSS);
    LAS unsigned* hist = (LAS unsigned*)F.lds;
    LAS unsigned* suf = hist + 256;
    LAS unsigned* ctl = hist + 768;
    LAS unsigned* wtot = hist + 800;
    for (int task = F.vcu; task < BATCH * NE; task += F.G) {
        const int b = task >> 4, e = task & 15;
        const unsigned* src = (const unsigned*)(AFF + (size_t)task * T) + F.tid * 16;
        unsigned v[16];
#pragma unroll
        for (int q = 0; q < 4; ++q) { const u32x4 w = *((const u32x4*)src + q); v[4 * q] = w.x; v[4 * q + 1] = w.y; v[4 * q + 2] = w.z; v[4 * q + 3] = w.w; }
        unsigned prefix = 0, remaining = CAP;
#pragma unroll 1
        for (int pass = 0; pass < 4; ++pass) {
            const int shift = 24 - 8 * pass;
            if (F.tid < 256) hist[F.tid] = 0u;
            __syncthreads();
#pragma unroll
            for (int j = 0; j < 16; ++j) { const bool match = (pass == 0) || ((v[j] >> (shift + 8)) == prefix); if (match) atomicAdd((unsigned*)&hist[(v[j] >> shift) & 255u], 1u); }
            __syncthreads();
            if (F.tid < 256) suf[F.tid] = hist[F.tid];
            if (F.tid == 0) suf[256] = 0u;
            __syncthreads();
#pragma unroll 1
            for (int o = 1; o < 256; o <<= 1) { unsigned a = 0u; if (F.tid < 256) { a = suf[F.tid]; if (F.tid + o < 256) a += suf[F.tid + o]; } __syncthreads(); if (F.tid < 256) suf[F.tid] = a; __syncthreads(); }
            if (F.tid < 256) { const unsigned sd = suf[F.tid], sn = suf[F.tid + 1]; if (sd >= remaining && sn < remaining) { ctl[0] = (unsigned)F.tid; ctl[1] = remaining - sn; } }
            __syncthreads();
            prefix = (prefix << 8) | ctl[0]; remaining = ctl[1];
            __syncthreads();
        }
        const unsigned thr = prefix, need_eq = remaining, n_gt = CAP - remaining;
        unsigned cnt = 0u;
#pragma unroll
        for (int j = 0; j < 16; ++j) cnt += (v[j] > thr ? 1u : 0u) + (v[j] == thr ? 0x10000u : 0u);
        unsigned inc = cnt;
#pragma unroll
        for (int o = 1; o < 64; o <<= 1) { const unsigned t = __shfl_up(inc, o); if (F.lane >= o) inc += t; }
        if (F.lane == 63) wtot[F.wave] = inc;
        __syncthreads();
        unsigned base = 0u;
#pragma unroll
        for (int w = 0; w < NWAVES; ++w) base += (w < F.wave) ? wtot[w] : 0u;
        unsigned run = base + inc - cnt;
        unsigned rg = run & 0xffffu, re = run >> 16;
        const int tbase = F.tid * 16;
#pragma unroll
        for (int j = 0; j < 16; ++j) {
            const int t = tbase + j; int slot = -1;
            if (v[j] > thr) { slot = (int)rg; ++rg; }
            else if (v[j] == thr) { if (re < need_eq) slot = (int)(n_gt + re); ++re; }
            const int gt = b * T + t;
            INV[(size_t)gt * NE + e] = slot >= 0 ? b * CAP + slot : -1;
            if (slot >= 0) { const int sr = e * (BATCH * CAP) + b * CAP + slot; SEL[sr] = gt; GATEV[sr] = __uint_as_float(v[j]); RSS[sr] = RSTD[gt]; }
        }
        __syncthreads();
    }
}
template <bool FINAL>
__device__ __forceinline__ void combine_phase(Frame& F0, float* x  , const float* gain) {
    Frame F = F0; F.tid = fresh_v(F0.tid); F.lane = F.tid & 63; F.wave = fresh_s(F0.wave);
    const int* INV = (const int*)(F.ws + WS_INV); const unsigned char* YE = F.ws + WS_YE; bf16_t* H = (bf16_t*)(F.ws + WS_H); const float* GATEV = (const float*)(F.ws + WS_GATEV);
    const int gw = F.vcu * NWAVES + F.wave, NGW = F.G * NWAVES;
    f32x4 g[4];
#pragma unroll
    for (int j = 0; j < 4; ++j) g[j] = *((const f32x4*)gain + 64 * j + F.lane);
#pragma unroll 1
    for (int m = gw; m < M; m += NGW) {
        f32x4* xr = (f32x4*)(x + (size_t)m * D) + F.lane; f32x4 v[4];
        { const u32x2* x1r = (const u32x2*)((const bf16_t*)(F.ws + WS_MIX) + (size_t)m * D) + F.lane;
#pragma unroll
          for (int j = 0; j < 4; ++j) { const u32x2 w = x1r[64 * j]; v[j] = (f32x4){bf_lo(w.x), bf_hi(w.x), bf_lo(w.y), bf_hi(w.y)}; } }
        const int myinv = INV[(size_t)m * NE + (F.lane & 15)];
        unsigned long long mask = __ballot(myinv >= 0) & 0xffffull;
        while (mask) {
            const int e = __builtin_ctzll(mask); mask &= mask - 1;
            const int slot = __builtin_amdgcn_readlane(myinv, e);
            const float gvv = __hip_atomic_load(GATEV + (size_t)e * (BATCH * CAP) + slot, __ATOMIC_RELAXED, __HIP_MEMORY_SCOPE_AGENT) * (1.0f / YSCALE);
            const int* yr = (const int*)(YE + ((size_t)e * (BATCH * CAP) + slot) * D) + F.lane;
#pragma unroll
            for (int j = 0; j < 4; ++j) { const int w = yr[64 * j]; const f32x2 a = __builtin_amdgcn_cvt_pk_f32_fp8(w, false), c = __builtin_amdgcn_cvt_pk_f32_fp8(w, true);
                v[j][0] += gvv * a.x; v[j][1] += gvv * a.y; v[j][2] += gvv * c.x; v[j][3] += gvv * c.y; }
        }
        const float rstd = row_rstd(v);
        if (FINAL) {
#pragma unroll
            for (int j = 0; j < 4; ++j) xr[64 * j] = v[j] * rstd * g[j];
        } else {
            store_bf16_row((bf16_t*)x + (size_t)m * D, v, F.lane);
#pragma unroll
            for (int j = 0; j < 4; ++j) v[j] = v[j] * rstd * g[j];
            store_bf16_row(H + (size_t)m * D, v, F.lane);
        }
    }
}

constexpr int ATT_VROW = 160;
constexpr int ATT_VBYTES = 32 * ATT_VROW;
constexpr int ATT_SSQ_OFF = NWAVES * ATT_VBYTES;
constexpr int ATT_BIAS_OFF = ATT_SSQ_OFF + 2 * 8 * 256 * 4;
constexpr int ATT_BIAS_PADF = 32, ATT_BIAS_TAILF = 64;
typedef short v4i16_t __attribute__((ext_vector_type(4)));
__device__ __forceinline__ s16x4 vtr(const LAS unsigned char* p) { return __builtin_bit_cast(s16x4, __builtin_amdgcn_ds_read_tr16_b64_v4i16((LAS v4i16_t*)p)); }

template <bool NA>
__device__ __forceinline__ void attn_task(const bf16_t* __restrict__ qkv, bf16_t* __restrict__ mix, LAS unsigned char* lds, int lane, int wave,
                                          int b, int h, int mblk, int r, int grow, int cb) {
    const int i = lane & 15, g = lane >> 4;
    constexpr size_t TENS = (size_t)BATCH * 8 * T * 64;
    const bf16_t* qbase = qkv + (size_t)(NA ? 3 : 0) * TENS + ((size_t)(b * 8 + h) * T << 6) + 8 * g;
    const bf16_t* kbase = qbase + TENS;
    const int tl = NA ? ((grow & 3) * 64 + 16 * cb + i) : (16 * i + r);
    const int tq = 256 * mblk + tl;
    const bf16x8 Q0 = *(const bf16x8*)(qbase + ((size_t)tq << 6)), Q1 = *(const bf16x8*)(qbase + ((size_t)tq << 6) + 32);
    const int qrow = grow, qcol = 16 * cb + i;
    const int rs = min(max(qrow - 4, 0), 120), cs = min(max(qcol - 8, 0), 48), kc0 = min(max(16 * cb - 8, 0), 32);
    const LAS float* biasp = (const LAS float*)(lds + ATT_BIAS_OFF) + ATT_BIAS_PADF + ((h * 15 + (rs - qrow + 7)) * 31 + (kc0 - qcol + 15 + 4 * g));
    constexpr int NSTEP = NA ? 9 : 24;
    LAS unsigned char* vst = lds + wave * ATT_VBYTES + i * ATT_VROW + 16 * g;
    const LAS unsigned char* vrd = lds + wave * ATT_VBYTES + (4 * g + (i >> 2)) * ATT_VROW + (i & 3) * 8;
    bf16x8 K0[2][2], V0[2][2], K1[2][2], V1[2][2], K2[2][2], V2[2][2];
#define ATT_SEG(sidx, sl, sh, rp, Lm1, basepos) \
    if ((sidx) < 5) { sl = (sidx); sh = 4; rp = r; Lm1 = 511; basepos = 16 * mblk - 64; } \
    else if ((sidx) < 11) { sl = (sidx) - 5; sh = 2; rp = r & 3; Lm1 = 2047; basepos = 64 * mblk - 64; } \
    else { sl = (sidx) - 11; sh = 0; rp = 0; Lm1 = 8191; basepos = 256 * mblk - 64; }
#define ATT_LOAD(KB, VB, sidx) do { int sl_, sh_, rp_, Lm1_, bp_; if (!NA) { ATT_SEG(sidx, sl_, sh_, rp_, Lm1_, bp_) } \
        _Pragma("unroll") for (int T_ = 0; T_ < 2; ++T_) { int tok_; \
            if (NA) tok_ = min(rs + (sidx), 127) * 64 + kc0 + 16 * T_ + i; \
            else { const int pos_ = bp_ + 32 * sl_ + 16 * T_ + i; tok_ = (min(max(pos_, 0), Lm1_) << sh_) + rp_; } \
            const bf16_t* p_ = kbase + ((size_t)tok_ << 6); \
            KB[T_][0] = *(const bf16x8*)p_; KB[T_][1] = *(const bf16x8*)(p_ + 32); VB[T_][0] = *(const bf16x8*)(p_ + TENS); VB[T_][1] = *(const bf16x8*)(p_ + TENS + 32); } } while (0)
    f32x4 O[4];
#pragma unroll
    for (int n = 0; n < 4; ++n) O[n] = (f32x4){0.f, 0.f, 0.f, 0.f};
    float mrun = -1e30f, lrun = 0.f;
#define ATT_STEP(KB, VB, s) do { \
        _Pragma("unroll") for (int T_ = 0; T_ < 2; ++T_) { *(LAS bf16x8*)(vst + T_ * 16 * ATT_VROW) = VB[T_][0]; *(LAS bf16x8*)(vst + T_ * 16 * ATT_VROW + 64) = VB[T_][1]; } \
        f32x4 sc[2]; \
        _Pragma("unroll") for (int T_ = 0; T_ < 2; ++T_) { sc[T_] = __builtin_amdgcn_mfma_f32_16x16x32_bf16(KB[T_][0], Q0, (f32x4){0.f, 0.f, 0.f, 0.f}, 0, 0, 0); \
            sc[T_] = __builtin_amdgcn_mfma_f32_16x16x32_bf16(KB[T_][1], Q1, sc[T_], 0, 0, 0); } \
        ATT_LOAD(KB, VB, min((s) + 3, NSTEP - 1)); \
        int lo, span, x0; \
        if (NA) { lo = ((s) < 8) ? cs - kc0 - 4 * g : (1 << 20); span = 15; x0 = 0; } \
        else { int sl_, sh_, rp_, Lm1_, bp_; ATT_SEG(s, sl_, sh_, rp_, Lm1_, bp_) (void)rp_; \
            const int pq = tq >> sh_; \
            lo = max(pq - 64, 0) - bp_ - 4 * g; span = (min(pq + 64, Lm1_) - bp_ - 4 * g) - lo; x0 = 32 * sl_; } \
        float mloc = -INFINITY; \
        _Pragma("unroll") for (int T_ = 0; T_ < 2; ++T_) \
            _Pragma("unroll") for (int q = 0; q < 4; ++q) { const bool valid = (unsigned)(x0 + 16 * T_ + q - lo) <= (unsigned)span; \
                float v = sc[T_][q]; if (NA) v += biasp[(s) * 31 + 16 * T_ + q]; \
                v = valid ? v : -INFINITY; sc[T_][q] = v; mloc = fmaxf(mloc, v); } \
        mloc = fmaxf(mloc, __shfl_xor(mloc, 16)); mloc = fmaxf(mloc, __shfl_xor(mloc, 32)); \
        const float mnew = fmaxf(mrun, mloc), alpha = __builtin_amdgcn_exp2f(mrun - mnew); mrun = mnew; \
        float psum = 0.f; \
        _Pragma("unroll") for (int T_ = 0; T_ < 2; ++T_) \
            _Pragma("unroll") for (int q = 0; q < 4; ++q) { const float p = __builtin_amdgcn_exp2f(sc[T_][q] - mnew); sc[T_][q] = p; psum += p; } \
        lrun = lrun * alpha + psum; \
        _Pragma("unroll") for (int n = 0; n < 4; ++n) O[n] = O[n] * alpha; \
        u32x4 pw; pw.x = cvt_pk_bf16(sc[0][0], sc[0][1]); pw.y = cvt_pk_bf16(sc[0][2], sc[0][3]); pw.z = cvt_pk_bf16(sc[1][0], sc[1][1]); pw.w = cvt_pk_bf16(sc[1][2], sc[1][3]); \
        const bf16x8 Pf = __builtin_bit_cast(bf16x8, pw); \
        _Pragma("unroll") for (int n = 0; n < 4; ++n) { const s16x4 a = vtr(vrd + n * 32), c = vtr(vrd + 16 * ATT_VROW + n * 32); \
            const bf16x8 Vf = (bf16x8){a[0], a[1], a[2], a[3], c[0], c[1], c[2], c[3]}; \
            O[n] = __builtin_amdgcn_mfma_f32_16x16x32_bf16(Vf, Pf, O[n], 0, 0, 0); } \
    } while (0)
    ATT_LOAD(K0, V0, 0); ATT_LOAD(K1, V1, 1); ATT_LOAD(K2, V2, 2);
#pragma unroll 1
    for (int s = 0; s < NSTEP; s += 3) {
        ATT_STEP(K0, V0, s);
        ATT_STEP(K1, V1, s + 1);
        ATT_STEP(K2, V2, s + 2);
    }
#undef ATT_STEP
#undef ATT_LOAD
#undef ATT_SEG
    float lt = lrun; lt += __shfl_xor(lt, 16); lt += __shfl_xor(lt, 32);
    const float inv = 1.0f / lt;
    float ssq = 0.f;
    bf16_t* op = mix + ((size_t)b * T + tq) * D + (NA ? 512 : 0) + h * 64 + 4 * g;
#pragma unroll
    for (int n = 0; n < 4; ++n) { const f32x4 o = O[n] * inv; ssq += (o[0] * o[0] + o[1] * o[1]) + (o[2] * o[2] + o[3] * o[3]);
        u32x2 w; w.x = cvt_pk_bf16(o[0], o[1]); w.y = cvt_pk_bf16(o[2], o[3]); *(u32x2*)(op + 16 * n) = w; }
    (void)ssq; (void)tl;
}

constexpr int NA_BIAS_OFF = MISC_OFF + 64;
constexpr int DU_NK = 256, DU_KB = DU_NK * 128, DU_BUF = 2 * DU_KB;
struct DUnit { int sh, res, Lm1, P0, type; };
__device__ __forceinline__ DUnit du_decode(int q, int u) {
    DUnit d;
    if (u < 16) { d.type = 0; d.sh = 4; d.res = 4 * q + (u >> 2); d.Lm1 = 511; d.P0 = 128 * (u & 3); }
    else if (u < 32) { d.type = 1; d.sh = 2; d.res = q; d.Lm1 = 2047; d.P0 = 128 * (u - 16); }
    else { d.type = 2; d.sh = 0; d.res = 0; d.Lm1 = 8191; d.P0 = 128 * (16 * q + (u - 32)); }
    return d;
}
__device__ __forceinline__ void attn_units_phase(Frame& F0, int l) {
    Frame F = F0; F.tid = fresh_v(F0.tid); F.lane = F.tid & 63; F.wave = fresh_s(F0.wave);
    constexpr size_t TENS = (size_t)BATCH * 8 * T * 64;
    const bf16_t* qkv = (const bf16_t*)(F.ws + WS_QKV); bf16_t* mix = (bf16_t*)(F.ws + WS_MIX);
    bf16_t* partA = (bf16_t*)(F.ws + WS_PARTA); bf16_t* partB = (bf16_t*)(F.ws + WS_PARTB); float* lsep = (float*)(F.ws + WS_LSEP);
    const int lane = F.lane, w = F.wave, i = lane & 15, g = lane >> 4;
    for (int c = F.vcu; c < 256; c += F.G) {
        const int bh = c >> 2, q = c & 3, b = bh >> 3, h = bh & 7;
        const bf16_t* qb = qkv + ((size_t)(b * 8 + h) * T << 6);
        const bf16_t* kb = qb + TENS;
        const __amdgpu_buffer_rsrc_t rKV = __builtin_amdgcn_make_buffer_rsrc((void*)kb, 0, 0xffffffff, 0x00020000);
        const int fK = (i >> 1) & 7;
        const int kof0 = i * 128 + ((g ^ fK) << 4), kof1 = i * 128 + (((4 + g) ^ fK) << 4);
        const int fV = ((2 * g + (i >> 3)) & 3) << 1;
        int vof[4];
#pragma unroll
        for (int n = 0; n < 4; ++n) vof[n] = (4 * g + (i >> 2)) * 128 + (((2 * n + ((i & 3) >> 1)) ^ fV) << 4) + (i & 1) * 8;
#define DU_ISSUE(u_, bufb_) do { const DUnit d_ = du_decode(q, (u_)); \
        _Pragma("unroll") for (int k_ = 0; k_ < 4; ++k_) { const int row_ = 32 * w + 8 * k_ + (lane >> 3); \
            const int pos_ = min(max(d_.P0 - 64 + row_, 0), d_.Lm1); const size_t tok_ = (size_t)((pos_ << d_.sh) + d_.res); \
            const int cK_ = (lane & 7) ^ ((row_ >> 1) & 7), cV_ = (lane & 7) ^ (((row_ >> 1) & 3) << 1); \
            __builtin_amdgcn_raw_ptr_buffer_load_lds(rKV, (LAS unsigned*)(F.lds + (bufb_) + (32 * w + 8 * k_) * 128), 16, (unsigned)(tok_ << 7) + (unsigned)(cK_ * 16), 0, 0, 0); \
            __builtin_amdgcn_raw_ptr_buffer_load_lds(rKV, (LAS unsigned*)(F.lds + (bufb_) + DU_KB + (32 * w + 8 * k_) * 128), 16, (unsigned)(tok_ << 7) + (unsigned)(cV_ * 16), (unsigned)(TENS * 2), 0, 0); } } while (0)
#define DU_QLOAD(u_, Qa, Qb) do { const DUnit d_ = du_decode(q, (u_)); const size_t tq_ = (size_t)(((d_.P0 + 16 * w + i) << d_.sh) + d_.res); \
        Qa = *(const bf16x8*)(qb + (tq_ << 6) + 8 * g); Qb = *(const bf16x8*)(qb + (tq_ << 6) + 8 * g + 32); } while (0)
        bf16x8 Qn0, Qn1;
        __syncthreads();
        DU_ISSUE(0, 0); DU_QLOAD(0, Qn0, Qn1);
#pragma unroll 1
        for (int u = 0; u < 48; ++u) {
            const bf16x8 Q0 = Qn0, Q1 = Qn1;
            if (u == 0) VM_WAIT(); else asm volatile("s_waitcnt vmcnt(5)" ::: "memory");
            asm volatile("" ::: "memory"); __builtin_amdgcn_s_barrier(); asm volatile("" ::: "memory");
            const int bufb = (u & 1) * DU_BUF;
            if (u + 1 < 48) { DU_ISSUE(u + 1, DU_BUF - bufb); DU_QLOAD(u + 1, Qn0, Qn1); }
            const DUnit d = du_decode(q, u);
            const LAS unsigned char* Kb = F.lds + bufb; const LAS unsigned char* Vb = Kb + DU_KB;
            const int lo = max(i, 64 - d.P0 - 16 * w) - 4 * g, span = min(i + 128, d.Lm1 + 64 - d.P0 - 16 * w) - 4 * g - lo;
            f32x4 sc[9];
#pragma unroll
            for (int t_ = 0; t_ < 9; ++t_) { const int rb = 16 * w + 16 * t_;
                const bf16x8 k0 = *(const LAS bf16x8*)(Kb + rb * 128 + kof0), k1 = *(const LAS bf16x8*)(Kb + rb * 128 + kof1);
                sc[t_] = __builtin_amdgcn_mfma_f32_16x16x32_bf16(k0, Q0, (f32x4){0.f, 0.f, 0.f, 0.f}, 0, 0, 0);
                sc[t_] = __builtin_amdgcn_mfma_f32_16x16x32_bf16(k1, Q1, sc[t_], 0, 0, 0); }
            float mrow = -INFINITY;
#pragma unroll
            for (int t_ = 0; t_ < 9; ++t_)
#pragma unroll
                for (int r_ = 0; r_ < 4; ++r_) { const bool valid = (unsigned)(16 * t_ + r_ - lo) <= (unsigned)span;
                    const float v = valid ? sc[t_][r_] : -INFINITY; sc[t_][r_] = v; mrow = fmaxf(mrow, v); }
            mrow = fmaxf(mrow, __shfl_xor(mrow, 16)); mrow = fmaxf(mrow, __shfl_xor(mrow, 32));
            float lt = 0.f;
#pragma unroll
            for (int t_ = 0; t_ < 9; ++t_)
#pragma unroll
                for (int r_ = 0; r_ < 4; ++r_) { const float p = __builtin_amdgcn_exp2f(sc[t_][r_] - mrow); sc[t_][r_] = p; lt += p; }
            f32x4 O[4];
#pragma unroll
            for (int n = 0; n < 4; ++n) O[n] = (f32x4){0.f, 0.f, 0.f, 0.f};
            unsigned vad[4];
#pragma unroll
            for (int n = 0; n < 4; ++n) vad[n] = (unsigned)(__SIZE_TYPE__)(Vb + (16 * w) * 128 + vof[n]);
            s16x4 va[2][4], vc[2][4];
#define DU_VTR(dst, ad, off) asm volatile("ds_read_b64_tr_b16 %0, %1 offset:%2" : "=v"(dst) : "v"(ad), "n"(off))
#define DU_VISSUE(s_) do { _Pragma("unroll") for (int n = 0; n < 4; ++n) { DU_VTR(va[(s_) & 1][n], vad[n], (s_) * 4096); DU_VTR(vc[(s_) & 1][n], vad[n], ((s_) < 4 ? (s_) * 4096 + 2048 : (s_) * 4096)); } } while (0)
            __builtin_amdgcn_sched_barrier(0);
            DU_VISSUE(0);
#pragma unroll
            for (int s = 0; s < 5; ++s) {
                u32x4 pw; pw.x = cvt_pk_bf16(sc[2 * s][0], sc[2 * s][1]); pw.y = cvt_pk_bf16(sc[2 * s][2], sc[2 * s][3]);
                if (s < 4) { pw.z = cvt_pk_bf16(sc[2 * s + 1][0], sc[2 * s + 1][1]); pw.w = cvt_pk_bf16(sc[2 * s + 1][2], sc[2 * s + 1][3]); } else { pw.z = 0u; pw.w = 0u; }
                const bf16x8 Pf = __builtin_bit_cast(bf16x8, pw);
                if (s < 4) { DU_VISSUE(s + 1);
                    asm volatile("s_waitcnt lgkmcnt(8)" : "+v"(va[s & 1][0]), "+v"(va[s & 1][1]), "+v"(va[s & 1][2]), "+v"(va[s & 1][3]), "+v"(vc[s & 1][0]), "+v"(vc[s & 1][1]), "+v"(vc[s & 1][2]), "+v"(vc[s & 1][3])); }
                else asm volatile("s_waitcnt lgkmcnt(0)" : "+v"(va[s & 1][0]), "+v"(va[s & 1][1]), "+v"(va[s & 1][2]), "+v"(va[s & 1][3]), "+v"(vc[s & 1][0]), "+v"(vc[s & 1][1]), "+v"(vc[s & 1][2]), "+v"(vc[s & 1][3]));
#pragma unroll
                for (int n = 0; n < 4; ++n) { const s16x4 a = va[s & 1][n], cc = vc[s & 1][n];
                    const bf16x8 Vf = (bf16x8){a[0], a[1], a[2], a[3], cc[0], cc[1], cc[2], cc[3]};
                    O[n] = __builtin_amdgcn_mfma_f32_16x16x32_bf16(Vf, Pf, O[n], 0, 0, 0); }
                __builtin_amdgcn_sched_barrier(0);
            }
#undef DU_VTR
#undef DU_VISSUE
            lt += __shfl_xor(lt, 16); lt += __shfl_xor(lt, 32);
            const float inv = 1.0f / lt; const float mrun = mrow;
            const size_t tokq = (size_t)b * T + (size_t)(((d.P0 + 16 * w + i) << d.sh) + d.res);
            bf16_t* op = (d.type == 0 ? partA + tokq * 512 : d.type == 1 ? partB + tokq * 512 : mix + tokq * D) + h * 64 + 4 * g;
#pragma unroll
            for (int n = 0; n < 4; ++n) { const f32x4 o = O[n] * inv; u32x2 ww; ww.x = cvt_pk_bf16(o[0], o[1]); ww.y = cvt_pk_bf16(o[2], o[3]); *(u32x2*)(op + 16 * n) = ww; }
            if (g == 0) lsep[((size_t)d.type * M + tokq) * 8 + h] = mrun + __builtin_amdgcn_logf(lt);
        }
#undef DU_ISSUE
#undef DU_QLOAD
    }
    __syncthreads();
    { CArgs* ka = kargs(); const float* rpb = ka->in[5] + (size_t)l * 8 * 15 * 31; LAS float* bias = (LAS float*)(F.lds + NA_BIAS_OFF);
      for (int idx = F.tid; idx < ATT_BIAS_PADF + 8 * 15 * 31 + ATT_BIAS_TAILF; idx += NTHREADS) { const int j = idx - ATT_BIAS_PADF; bias[idx] = (j >= 0 && j < 8 * 15 * 31) ? rpb[j] * LOG2E : 0.f; } }
    for (int c = F.vcu; c < 256; c += F.G) {
        const int b = c >> 5, h = (c >> 2) & 7, cb = c & 3, kc0 = min(max(16 * cb - 8, 0), 32);
        const bf16_t* qb = qkv + 3 * TENS + ((size_t)(b * 8 + h) * T << 6);
        const bf16_t* kb = qb + TENS;
        const int fK = (i >> 1) & 7, kof0 = i * 128 + ((g ^ fK) << 4), kof1 = i * 128 + (((4 + g) ^ fK) << 4);
        const int fV = ((2 * g + (i >> 3)) & 3) << 1;
        int vof[4];
#pragma unroll
        for (int n = 0; n < 4; ++n) vof[n] = (4 * g + (i >> 2)) * 128 + (((2 * n + ((i & 3) >> 1)) ^ fV) << 4) + (i & 1) * 8;
        const int pkk = (F.tid >> 3) & 31, pc = F.tid & 7, pr = F.tid >> 8;
        u32x4 st[8];
#define NA_FETCH(row0_, nrow_) do { _Pragma("unroll") for (int k_ = 0; k_ < 8; ++k_) { const int ro_ = 2 * (k_ & 3) + pr; const int kr_ = min((row0_) + ro_, 127); \
            st[k_] = *(const u32x4*)(kb + (size_t)(k_ >> 2) * TENS + ((size_t)(kr_ * 64 + kc0 + pkk) << 6) + pc * 8); } } while (0)
#define NA_STORE(row0_, nrow_) do { _Pragma("unroll") for (int k_ = 0; k_ < 8; ++k_) { const int ro_ = 2 * (k_ & 3) + pr; if (ro_ < (nrow_)) { const int R_ = (((row0_) + ro_) & 15) * 32 + pkk; \
            const int f_ = (k_ >> 2) ? (((R_ >> 1) & 3) << 1) : ((R_ >> 1) & 7); \
            *(LAS u32x4*)(F.lds + (k_ >> 2) * 65536 + R_ * 128 + ((pc ^ f_) << 4)) = st[k_]; } } } while (0)
        __syncthreads();
        NA_FETCH(0, 8); NA_STORE(0, 8); NA_FETCH(8, 3); NA_STORE(8, 3);
        bf16x8 Qn0, Qn1;
        { const size_t tq0 = (size_t)(w * 64 + 16 * cb + i); Qn0 = *(const bf16x8*)(qb + (tq0 << 6) + 8 * g); Qn1 = *(const bf16x8*)(qb + (tq0 << 6) + 8 * g + 32); }
        __syncthreads();
#pragma unroll 1
        for (int j = 0; j < 16; ++j) {
            const int hi_cur = min(8 * j + 10, 127), hi_nxt = min(8 * j + 18, 127), nnew = (j < 15) ? hi_nxt - hi_cur : 0;
            if (nnew > 0) NA_FETCH(hi_cur + 1, nnew);
            const int qrow = 8 * j + w, qcol = 16 * cb + i, rs = min(max(qrow - 4, 0), 120), cs = min(max(qcol - 8, 0), 48);
            const size_t tq = (size_t)(qrow * 64 + qcol);
            const bf16x8 Q0 = Qn0, Q1 = Qn1;
            { const int qn = min(8 * (j + 1) + w, 127); const size_t tqn = (size_t)(qn * 64 + qcol); Qn0 = *(const bf16x8*)(qb + (tqn << 6) + 8 * g); Qn1 = *(const bf16x8*)(qb + (tqn << 6) + 8 * g + 32); }
            const LAS float* biasp = (const LAS float*)(F.lds + NA_BIAS_OFF) + ATT_BIAS_PADF + ((h * 15 + (rs - qrow + 7)) * 31 + (kc0 - qcol + 15 + 4 * g));
            const int lo = cs - kc0 - 4 * g;
            f32x4 sc[16];
#pragma unroll
            for (int s = 0; s < 8; ++s) { const int R0 = ((rs + s) & 15) * 32;
#pragma unroll
                for (int T_ = 0; T_ < 2; ++T_) { const bf16x8 k0 = *(const LAS bf16x8*)(F.lds + (R0 + 16 * T_) * 128 + kof0), k1 = *(const LAS bf16x8*)(F.lds + (R0 + 16 * T_) * 128 + kof1);
                    sc[2 * s + T_] = __builtin_amdgcn_mfma_f32_16x16x32_bf16(k0, Q0, (f32x4){0.f, 0.f, 0.f, 0.f}, 0, 0, 0);
                    sc[2 * s + T_] = __builtin_amdgcn_mfma_f32_16x16x32_bf16(k1, Q1, sc[2 * s + T_], 0, 0, 0); } }
            bool first[4]; int boff[4];
#pragma unroll
            for (int r_ = 0; r_ < 4; ++r_) { first[r_] = r_ >= lo; boff[r_] = first[r_] ? r_ : 16 + r_; }
            float w[8][4]; float mrow = -INFINITY;
#pragma unroll
            for (int s = 0; s < 8; ++s)
#pragma unroll
                for (int r_ = 0; r_ < 4; ++r_) { const float v = (first[r_] ? sc[2 * s][r_] : sc[2 * s + 1][r_]) + biasp[s * 31 + boff[r_]]; w[s][r_] = v; mrow = fmaxf(mrow, v); }
            mrow = fmaxf(mrow, __shfl_xor(mrow, 16)); mrow = fmaxf(mrow, __shfl_xor(mrow, 32));
            float lt = 0.f;
#pragma unroll
            for (int s = 0; s < 8; ++s)
#pragma unroll
                for (int r_ = 0; r_ < 4; ++r_) { const float p = __builtin_amdgcn_exp2f(w[s][r_] - mrow); lt += p; sc[2 * s][r_] = first[r_] ? p : 0.f; sc[2 * s + 1][r_] = first[r_] ? 0.f : p; }
            f32x4 O[4];
#pragma unroll
            for (int n = 0; n < 4; ++n) O[n] = (f32x4){0.f, 0.f, 0.f, 0.f};
#pragma unroll
            for (int s = 0; s < 8; ++s) { const int R0 = ((rs + s) & 15) * 32;
                u32x4 pw; pw.x = cvt_pk_bf16(sc[2 * s][0], sc[2 * s][1]); pw.y = cvt_pk_bf16(sc[2 * s][2], sc[2 * s][3]); pw.z = cvt_pk_bf16(sc[2 * s + 1][0], sc[2 * s + 1][1]); pw.w = cvt_pk_bf16(sc[2 * s + 1][2], sc[2 * s + 1][3]);
                const bf16x8 Pf = __builtin_bit_cast(bf16x8, pw);
#pragma unroll
                for (int n = 0; n < 4; ++n) { const s16x4 a = vtr(F.lds + 65536 + R0 * 128 + vof[n]), cc = vtr(F.lds + 65536 + (R0 + 16) * 128 + vof[n]);
                    const bf16x8 Vf = (bf16x8){a[0], a[1], a[2], a[3], cc[0], cc[1], cc[2], cc[3]};
                    O[n] = __builtin_amdgcn_mfma_f32_16x16x32_bf16(Vf, Pf, O[n], 0, 0, 0); }
            }
            lt += __shfl_xor(lt, 16); lt += __shfl_xor(lt, 32);
            const float inv = 1.0f / lt;
            bf16_t* op = mix + ((size_t)b * T + tq) * D + 512 + h * 64 + 4 * g;
#pragma unroll
            for (int n = 0; n < 4; ++n) { const f32x4 o = O[n] * inv; u32x2 ww; ww.x = cvt_pk_bf16(o[0], o[1]); ww.y = cvt_pk_bf16(o[2], o[3]); *(u32x2*)(op + 16 * n) = ww; }
            __syncthreads();
            if (nnew > 0) NA_STORE(hi_cur + 1, nnew);
            __syncthreads();
        }
#undef NA_FETCH
#undef NA_STORE
    }
}
__device__ __forceinline__ void attn_merge_phase(Frame& F0, int l) {
    Frame F = F0; F.tid = fresh_v(F0.tid); F.lane = F.tid & 63; F.wave = fresh_s(F0.wave);
    bf16_t* mix = (bf16_t*)(F.ws + WS_MIX); const bf16_t* partA = (const bf16_t*)(F.ws + WS_PARTA); const bf16_t* partB = (const bf16_t*)(F.ws + WS_PARTB); const float* lsep = (const float*)(F.ws + WS_LSEP);
    CArgs* ka = kargs();
    const float* gd = ka->in[3] + (size_t)l * 512; const float* gn = ka->in[4] + (size_t)l * 512;
    const int lane = F.lane; const bool dil = lane < 32;
    f32x4 gg[4];
    { const float* gp = dil ? gd + 16 * lane : gn + 16 * (lane - 32);
#pragma unroll
      for (int j = 0; j < 4; ++j) gg[j] = *(const f32x4*)(gp + 4 * j); }
    const int gw = F.vcu * NWAVES + F.wave, NGW = F.G * NWAVES;
#pragma unroll 1
    for (int m = gw; m < M; m += NGW) {
        u32x4* p = (u32x4*)(mix + (size_t)m * D + 16 * lane);
        const u32x4 c0 = p[0], c1 = p[1];
        const int l5 = lane & 31;
        const u32x4 a0 = *(const u32x4*)(partA + (size_t)m * 512 + 16 * l5), a1 = *(const u32x4*)(partA + (size_t)m * 512 + 16 * l5 + 8);
        const u32x4 b0 = *(const u32x4*)(partB + (size_t)m * 512 + 16 * l5), b1 = *(const u32x4*)(partB + (size_t)m * 512 + 16 * l5 + 8);
        const int hh = l5 >> 2;
        const float la = lsep[((size_t)0 * M + m) * 8 + hh], lb = lsep[((size_t)1 * M + m) * 8 + hh], lc = lsep[((size_t)2 * M + m) * 8 + hh];
        const float mx = fmaxf(fmaxf(la, lb), lc);
        float wa = __builtin_amdgcn_exp2f(la - mx), wb = __builtin_amdgcn_exp2f(lb - mx), wc = __builtin_amdgcn_exp2f(lc - mx);
        const float wi = 1.0f / (wa + wb + wc); wa *= wi; wb *= wi; wc *= wi;
        if (!dil) { wa = 0.f; wb = 0.f; wc = 1.f; }
        const unsigned cw[8] = {c0.x, c0.y, c0.z, c0.w, c1.x, c1.y, c1.z, c1.w}, aw[8] = {a0.x, a0.y, a0.z, a0.w, a1.x, a1.y, a1.z, a1.w}, bw[8] = {b0.x, b0.y, b0.z, b0.w, b1.x, b1.y, b1.z, b1.w};
        float o[16]; float ssq = 0.f;
#pragma unroll
        for (int k = 0; k < 8; ++k) { o[2 * k] = wa * bf_lo(aw[k]) + wb * bf_lo(bw[k]) + wc * bf_lo(cw[k]); o[2 * k + 1] = wa * bf_hi(aw[k]) + wb * bf_hi(bw[k]) + wc * bf_hi(cw[k]);
            ssq += o[2 * k] * o[2 * k] + o[2 * k + 1] * o[2 * k + 1]; }
#pragma unroll
        for (int of = 1; of < 32; of <<= 1) ssq += __shfl_xor(ssq, of);
        const float rstd = 1.0f / sqrtf(ssq * (1.0f / 512.0f) + EPS);
        unsigned ow[8];
#pragma unroll
        for (int k = 0; k < 8; ++k) ow[k] = cvt_pk_bf16(o[2 * k] * rstd * gg[k >> 1][(k & 1) * 2], o[2 * k + 1] * rstd * gg[k >> 1][(k & 1) * 2 + 1]);
        p[0] = (u32x4){ow[0], ow[1], ow[2], ow[3]}; p[1] = (u32x4){ow[4], ow[5], ow[6], ow[7]};
    }
}

__global__ void __launch_bounds__(NTHREADS, 2) mk_fwd(Args args) {
    extern __shared__ __attribute__((aligned(16))) unsigned char lds_raw[];
    Frame F;
    F.lds = (LAS unsigned char*)lds_raw;
    F.tid = threadIdx.x; F.lane = F.tid & 63; F.wave = __builtin_amdgcn_readfirstlane(F.tid >> 6);
    F.G = gridDim.x; { const int bx = blockIdx.x; F.vcu = (F.G % 8 == 0) ? (bx % 8) * (F.G / 8) + bx / 8 : bx; }
    F.out = args.out; F.ws = args.ws;
    volatile LAS unsigned* MISC = (volatile LAS unsigned*)(F.lds + MISC_OFF);
    if (F.tid < 16) MISC[F.tid] = 0u;
    __syncthreads();
    XcdBarrier bar; bar.bar = (unsigned*)(F.ws + WS_CTL) + CW_BAR; bar.x = 0; bar.st = nullptr;
    if (MK_N_LAUNCHES == 1) bar = xcd_barrier_post((unsigned*)(F.ws + WS_CTL) + CW_BAR, MISC + 8);
    const int lo = args.ph_lo, hi = args.ph_hi;
#define IN(k) (lo <= (k) && (k) < hi)
#ifdef PROBE_PHASE
    unsigned long long pr_last = __builtin_amdgcn_s_memrealtime(), pr_acc = 0ull;
#define SEAM(k) do { if (IN(k) && IN((k) + 1)) xcd_barrier(bar); { const unsigned long long now_ = __builtin_amdgcn_s_memrealtime(); const int ty_ = (k) == 0 ? 0 : 1 + ((k) - 1) % 9; if (ty_ == PROBE_PHASE) pr_acc += now_ - pr_last; pr_last = now_; } } while (0)
#else
#define SEAM(k) do { if (IN(k) && IN((k) + 1)) xcd_barrier(bar); } while (0)
#endif
#ifndef GPH
#define GPH 0
#endif
#ifndef GPROBE_AMP
#define GPROBE_AMP 1
#endif
    unsigned long long gp_acc = 0ull, gp_dummy = 0ull; (void)gp_dummy;
    bf16_t* H = (bf16_t*)(F.ws + WS_H); bf16_t* QKV = (bf16_t*)(F.ws + WS_QKV); bf16_t* MIX = (bf16_t*)(F.ws + WS_MIX);
    bf16_t* ACT = (bf16_t*)(F.ws + WS_ACT); bf16_t* YE = (bf16_t*)(F.ws + WS_YE);

    if (IN(0)) {
#if PM & 1
        conv_weights(F, 0, true);
#endif
#if PM & 2
        rope_table(F);
#endif
#if PM & 4
        norm1_phase(F, KIN(0), KIN(1));
#endif
    }
    SEAM(0);
#pragma unroll 1
    for (int l = 0; l < 2; ++l) {
        const int pb = 1 + 9 * l;
#if PM & 8
        if (IN(pb + 0)) {
            gm::StaticOrder S; S.init(M, NQKV, F.G, (int)blockIdx.x);
            gm::ASrc A{(const char*)H, nullptr, D, nullptr}; gm::BSrc B{(const char*)(F.ws + WS_WIN), 31, 0};
            gm::EpiQKV E{QKV, (const float*)(F.ws + WS_ROPE)};
            gm::gemm_phase<gm::EpiQKV, false, false>(F.lds, A, B, S, E, GPH == 1 ? gp_acc : gp_dummy);
        }
#endif
        SEAM(pb + 0);
#if PM & 16
        if (IN(pb + 1)) attn_units_phase(F, l);
#endif
        SEAM(pb + 1);
#if PM & 16
        if (IN(pb + 2)) attn_merge_phase(F, l);
#endif
        SEAM(pb + 2);
#if PM & 32
        if (IN(pb + 3)) {
            gm::StaticOrder S; S.init(M, D, F.G, (int)blockIdx.x);
            gm::ASrc A{(const char*)MIX, nullptr, D, nullptr}; gm::BSrc B{(const char*)(F.ws + WS_WOUT), 31, 0};
            gm::EpiBf16Out E{(bf16_t*)(F.ws + WS_PARTA)};
            gm::gemm_phase<gm::EpiBf16Out, false, false>(F.lds, A, B, S, E, GPH == 2 ? gp_acc : gp_dummy);
        }
#endif
        SEAM(pb + 3);
#if PM & 64
        if (IN(pb + 4)) { if (l == 0) norm2_router_phase<false>(F, (const void*)KIN(0), MIX, KIN(7), KIN(8)); else norm2_router_phase<true>(F, (const void*)F.out, MIX, KIN(7) + D, KIN(8) + (size_t)D * NE); }
#endif
        SEAM(pb + 4);
#if PM & 128
        if (IN(pb + 5)) topk_phase(F);
#endif
        SEAM(pb + 5);
#if PM & 256
        if (IN(pb + 6)) {
            gm::StaticOrder S; S.init(MS, 2 * FF, F.G, (int)blockIdx.x);
            gm::ASrc A{(const char*)H, (const int*)(F.ws + WS_SEL), D, (const float*)(F.ws + WS_RSS)}; gm::BSrc B{(const char*)(F.ws + WS_WGU + (size_t)l * WGU_BYTES), 5, (size_t)2 * FF * D};
            const int cvstep = F.G * NWAVES, cvn = (CV_ITEMS + cvstep - 1) / cvstep, nun = ((MS / 256) * (2 * FF / 256)) / F.G;
            gm::EpiSwiGLU E{(unsigned char*)ACT, F.ws, (l == 0 && cvn <= nun) ? cvn : 0, F.vcu * NWAVES + F.wave, cvstep};
            gm::gemm_phase<gm::EpiSwiGLU, true, true>(F.lds, A, B, S, E, GPH == 3 ? gp_acc : gp_dummy);
        }
#endif
        SEAM(pb + 6);
#if PM & 512
        if (IN(pb + 7)) {
            gm::StaticOrder S; S.init(MS, D, F.G, (int)blockIdx.x);
            gm::ASrc A{(const char*)ACT, nullptr, FF, nullptr}; gm::BSrc B{(const char*)(F.ws + WS_WD + (size_t)l * WD_BYTES), 5, (size_t)D * FF};
            gm::EpiDown E{(unsigned char*)YE, (const float*)(F.ws + WS_GATEV)};
            gm::gemm_phase<gm::EpiDown, true, true>(F.lds, A, B, S, E, GPH == 4 ? gp_acc : gp_dummy);
        }
#endif
        SEAM(pb + 7);
#if PM & 1024
        if (IN(pb + 8)) {
            if (l == 0) { const int cvstep = F.G * NWAVES, cvn = (CV_ITEMS + cvstep - 1) / cvstep, nun = ((MS / 256) * (2 * FF / 256)) / F.G;
                conv_weights(F, 1, !(cvn <= nun)); combine_phase<false>(F, F.out, KIN(1) + D); }
            else combine_phase<true>(F, F.out, KIN(12));
        }
#endif
        if (l == 0) SEAM(pb + 8);
    }
#if GPROBE
    { const unsigned long long t0_ = __builtin_amdgcn_s_memrealtime(); while (__builtin_amdgcn_s_memrealtime() - t0_ < gp_acc * GPROBE_AMP) __builtin_amdgcn_s_sleep(8); }
#endif
#ifdef PROBE_PHASE
    { const unsigned long long now_ = __builtin_amdgcn_s_memrealtime(); if (PROBE_PHASE == 9) pr_acc += now_ - pr_last;
      const unsigned long long t0_ = __builtin_amdgcn_s_memrealtime(); while (__builtin_amdgcn_s_memrealtime() - t0_ < pr_acc * PROBE_AMP) __builtin_amdgcn_s_sleep(8); }
#endif
#undef IN
#undef SEAM
}

extern "C" void kernel_launch(void* const* d_in, const int* in_sizes, int n_in, void* d_out, int out_size, void* d_ws, size_t ws_size, hipStream_t stream) {
    static int grid = 0;
    if (grid == 0) {
        if (n_in != 13 || in_sizes[0] != M * D || out_size != M * D || ws_size < WS_END) {
            fprintf(stderr, "kernel_launch: unexpected problem (n_in %d, in0 %d, out %d, ws %zu < %zu); nothing launched\n", n_in, n_in > 0 ? in_sizes[0] : -1, out_size, ws_size, (size_t)WS_END); grid = -1; return; }
        int dev = 0, cus = 0, per_cu = 0;
        if (hipGetDevice(&dev) != hipSuccess || hipDeviceGetAttribute(&cus, hipDeviceAttributeMultiprocessorCount, dev) != hipSuccess) { grid = -1; return; }
        if (hipFuncSetAttribute((const void*)mk_fwd, hipFuncAttributeMaxDynamicSharedMemorySize, LDS_BYTES) != hipSuccess) { fprintf(stderr, "kernel_launch: hipFuncSetAttribute failed\n"); grid = -1; return; }
        if (hipOccupancyMaxActiveBlocksPerMultiprocessor(&per_cu, (const void*)mk_fwd, NTHREADS, LDS_BYTES) != hipSuccess || per_cu < 1) {
            fprintf(stderr, "kernel_launch: occupancy query reports %d workgroups per CU; nothing launched\n", per_cu); (void)hipGetLastError(); grid = -1; return; }
        grid = cus;
    }
    if (grid < 0) return;
    (void)hipMemsetAsync((char*)d_ws + WS_CTL, 0, CTL_BYTES, stream);
    Args a{};
    for (int i = 0; i < 13; ++i) a.in[i] = (const float*)d_in[i];
    a.out = (float*)d_out; a.ws = (unsigned char*)d_ws;
    if (MK_N_LAUNCHES == 1) {
        a.ph_lo = 0; a.ph_hi = NPH; a.li = 0;
        hipLaunchKernelGGL(mk_fwd, dim3(grid), dim3(NTHREADS), LDS_BYTES, stream, a);
    } else {
        for (int p = 0; p < NPH; ++p) { a.ph_lo = p; a.ph_hi = p + 1; a.li = p; hipLaunchKernelGGL(mk_fwd, dim3(grid), dim3(NTHREADS), LDS_BYTES, stream, a); }
    }
    const hipError_t le = hipPeekAtLastError();
    if (le != hipSuccess) fprintf(stderr, "kernel_launch: launch failed: %s\n", hipGetErrorName(le));
}
```

```cpp
#include <hip/hip_runtime.h>
#include <cstdio>
#include <cstdint>

#ifndef PM
#define PM 0xffff
#endif
#ifndef MK_N_LAUNCHES
#define MK_N_LAUNCHES 1
#endif

#define GAS __attribute__((address_space(1)))
#define LAS __attribute__((address_space(3)))
typedef unsigned short bf16_t;
typedef short bf16x8 __attribute__((ext_vector_type(8)));
typedef short s16x4 __attribute__((ext_vector_type(4)));
typedef float f32x4 __attribute__((ext_vector_type(4)));
typedef float f32x2 __attribute__((ext_vector_type(2)));
typedef unsigned u32x4 __attribute__((ext_vector_type(4)));
typedef unsigned u32x2 __attribute__((ext_vector_type(2)));
typedef int i32x4 __attribute__((ext_vector_type(4)));
typedef int v8i32 __attribute__((ext_vector_type(8)));
typedef GAS unsigned gu32;

constexpr int D = 1024, BATCH = 8, T = 8192, M = BATCH * T, NQKV = 3072, NE = 16, FF = 2816, CAP = 1024, MS = NE * BATCH * CAP;
constexpr int NWAVES = 8, NTHREADS = 512;
constexpr float EPS = 1e-6f;
constexpr float LOG2E = 1.4426950408889634f;
constexpr float QSCALE = 0.125f * LOG2E;
constexpr int NPH = 19;

constexpr size_t MiB = 1u << 20;
constexpr size_t WS_CTL = 0, CTL_BYTES = 1 * MiB;
constexpr size_t WS_ROPE = 2 * MiB;
constexpr size_t WS_AFF = 4 * MiB;
constexpr size_t WS_INV = 8 * MiB;
constexpr size_t WS_SEL = 12 * MiB;
constexpr size_t WS_GATEV = 12 * MiB + 512 * 1024;
constexpr size_t WS_RSTD = 13 * MiB;
constexpr size_t WS_RSS = 13 * MiB + 512 * 1024;
constexpr size_t WS_WIN = 16 * MiB;
constexpr size_t WS_WOUT = 22 * MiB;
constexpr size_t WS_WGU = 24 * MiB;
constexpr size_t WS_WD = 200 * MiB;
constexpr size_t WGU_BYTES = 88 * MiB, WD_BYTES = 44 * MiB;
constexpr size_t WS_H = 288 * MiB;
constexpr size_t WS_ACT = 416 * MiB;
constexpr size_t WS_QKV = 416 * MiB;
constexpr size_t WS_MIX = 800 * MiB;
constexpr size_t WS_YE = 1120 * MiB;
constexpr size_t WS_END = 1376 * MiB;
constexpr size_t WS_PARTA = 928 * MiB, WS_PARTB = 992 * MiB, WS_LSEP = 1056 * MiB;
constexpr int CW_BAR = 4096;

constexpr int RING_BYTES = 131072;
constexpr int MISC_OFF = RING_BYTES;
constexpr int GOFF_OFF = MISC_OFF + 64;
constexpr int LDS_BYTES = 147456;

#define LDS_WAIT() asm volatile("s_waitcnt lgkmcnt(0)" ::: "memory")
#define VM_WAIT() asm volatile("s_waitcnt vmcnt(0)" ::: "memory")
__device__ __forceinline__ unsigned cvt_pk_bf16(float lo, float hi) { unsigned r; asm volatile("v_cvt_pk_bf16_f32 %0, %1, %2" : "=v"(r) : "v"(lo), "v"(hi)); return r; }
constexpr float YSCALE = 8.0f;
constexpr float WSCALE = 32.0f, WINV = 1.0f / 32.0f;
__device__ __forceinline__ unsigned pk4_fp8(float a, float b, float c, float d) { int w = __builtin_amdgcn_cvt_pk_fp8_f32(a, b, 0, false); w = __builtin_amdgcn_cvt_pk_fp8_f32(c, d, w, true); return (unsigned)w; }
__device__ __forceinline__ float bf_lo(unsigned w) { return __uint_as_float(w << 16); }
__device__ __forceinline__ float bf_hi(unsigned w) { return __uint_as_float(w & 0xffff0000u); }
__device__ __forceinline__ int fresh_v(int v) { asm volatile("" : "+v"(v)); return v; }
__device__ __forceinline__ int fresh_s(int v) { asm volatile("" : "+s"(v)); return v; }
__device__ __forceinline__ float wave_sum(float v) {
#pragma unroll
    for (int o = 1; o < 64; o <<= 1) v += __shfl_xor(v, o);
    return v;
}

#define XB_TMO      128
#define XB_XCNT(j)  (256  + 64 * (j))
#define XB_XSUB(j)  (1280 + 64 * (j))
#define XB_XGEN(j)  (2304 + 64 * (j))
#define XB_TOP      3328
#define XB_TOPGEN   3392
#define XCD_BAR_WORDS 3456
#define XB_SPIN_CAP (1u << 18)
__device__ __forceinline__ unsigned xb_ld(unsigned* p)              { return __hip_atomic_load(p, __ATOMIC_RELAXED, __HIP_MEMORY_SCOPE_AGENT); }
__device__ __forceinline__ unsigned xb_add(unsigned* p, unsigned v) { return __hip_atomic_fetch_add(p, v, __ATOMIC_RELAXED, __HIP_MEMORY_SCOPE_AGENT); }
__device__ __forceinline__ unsigned xb_xcc_id() { return (unsigned)__builtin_amdgcn_s_getreg((3 << 11) | 20) & 0xFu; }
#define XB_SPIN(cond, bar) do { unsigned _sp = 0; while (cond) { __builtin_amdgcn_s_sleep(1); \
    if ((++_sp & 255u) == 0u) { if (xb_ld(&(bar)[XB_TMO])) break; if (_sp > XB_SPIN_CAP) { atomicAdd(&(bar)[XB_TMO], 1u); break; } } } } while (0)
struct XcdBarrier { unsigned* bar; unsigned x; volatile LAS unsigned* st; };
__device__ __forceinline__ XcdBarrier xcd_barrier_post(unsigned* bar, volatile LAS unsigned* st) {
    XcdBarrier b; b.bar = bar; b.x = xb_xcc_id(); b.st = st;
    if (threadIdx.x == 0) (void)xb_add(&bar[XB_XCNT(b.x)], 1u);
    return b;
}
__device__ __forceinline__ void xcd_barrier_complete(unsigned* bar, unsigned x, unsigned& nloc, unsigned& nx) {
    const unsigned G = gridDim.x * gridDim.y * gridDim.z;
    unsigned sum, cnt, mine, sp = 0u;
    for (;;) {
        sum = 0u; cnt = 0u; mine = 0u;
#pragma unroll
        for (unsigned j = 0; j < 16; ++j) { const unsigned c = xb_ld(&bar[XB_XCNT(j)]); sum += c; cnt += (c > 0u) ? 1u : 0u; mine = (j == x) ? c : mine; }
        if (sum == G) break;
        __builtin_amdgcn_s_sleep(1);
        if ((++sp & 255u) == 0u) { if (xb_ld(&bar[XB_TMO])) break; if (sp > XB_SPIN_CAP) { atomicAdd(&bar[XB_TMO], 1u); break; } }
    }
    nloc = mine > 0u ? mine : 1u; nx = cnt > 0u ? cnt : 1u;
}
__device__ __forceinline__ void xcd_barrier(const XcdBarrier& b) {
    asm volatile("s_waitcnt vmcnt(0)" ::: "memory");
    __syncthreads();
    if (threadIdx.x == 0) {
        unsigned* bar = b.bar;
        __builtin_amdgcn_s_waitcnt(0);
        unsigned nloc = b.st[0], nx = b.st[1];
        if (nloc == 0u) { xcd_barrier_complete(bar, b.x, nloc, nx); b.st[0] = nloc; b.st[1] = nx; }
        const unsigned old = xb_add(&bar[XB_XSUB(b.x)], 1u);
        const unsigned gen = old / nloc;
        if (old + 1u == (gen + 1u) * nloc) {
            __builtin_amdgcn_fence(__ATOMIC_RELEASE, "agent");
            asm volatile("s_waitcnt vmcnt(0)" ::: "memory");
            const unsigned og = xb_add(&bar[XB_TOP], 1u);
            const unsigned tg = og / nx;
            if (og + 1u == (tg + 1u) * nx) xb_add(&bar[XB_TOPGEN], 1u);
            else XB_SPIN(xb_ld(&bar[XB_TOPGEN]) == tg, bar);
            __builtin_amdgcn_fence(__ATOMIC_ACQUIRE, "agent");
            xb_add(&bar[XB_XGEN(b.x)], 1u);
            asm volatile("s_waitcnt vmcnt(0)" ::: "memory");
        } else {
            XB_SPIN(xb_ld(&bar[XB_XGEN(b.x)]) == gen, bar);
            __builtin_amdgcn_fence(__ATOMIC_ACQUIRE, "agent");
            asm volatile("s_waitcnt vmcnt(0)" ::: "memory");
        }
    }
    __syncthreads();
}

struct Args { const float* in[13]; float* out; unsigned char* ws; int ph_lo, ph_hi, li, pad; };
typedef __attribute__((address_space(4))) const Args CArgs;
__device__ __forceinline__ CArgs* kargs() { CArgs* p = (CArgs*)__builtin_amdgcn_kernarg_segment_ptr(); asm volatile("" : "+s"(p)); return p; }
#define KIN(k) (kargs()->in[k])

constexpr int CV_IGE = (D / 64) * (FF / 32), CV_IDE = (FF / 64) * (D / 32);
constexpr int CV_ITEMS = NE * (2 * CV_IGE + CV_IDE);
struct CvDesc { const float* W; unsigned char* WT; int N, K, rowb; };
__device__ __forceinline__ CvDesc cv_desc(unsigned char* ws, int l, int g) {
    CArgs* ka = kargs(); CvDesc d; int r = g < CV_ITEMS ? g : CV_ITEMS - 1;
    if (r < 2 * NE * CV_IGE) { const int aux = r >= NE * CV_IGE ? 1 : 0; r -= aux * NE * CV_IGE; const int e = r / CV_IGE, it = r - e * CV_IGE, kb = it / (FF / 32), nb = it - kb * (FF / 32), n0 = 32 * nb;
        d.W = (aux ? ka->in[10] : ka->in[9]) + (size_t)l * NE * D * FF + (size_t)e * D * FF + (size_t)(64 * kb) * FF + n0; d.N = FF; d.K = D;
        d.WT = ws + WS_WGU + (size_t)l * WGU_BYTES + (size_t)e * 2 * FF * D + 64 * kb; d.rowb = (n0 >> 7) * 256 + aux * 128 + (n0 & 127); }
    else { r -= 2 * NE * CV_IGE; const int e = r / CV_IDE, it = r - e * CV_IDE, kb = it >> 5, nb = it & 31;
        d.W = ka->in[11] + (size_t)l * NE * FF * D + (size_t)e * FF * D + (size_t)(64 * kb) * D + 32 * nb; d.N = D; d.K = FF;
        d.WT = ws + WS_WD + (size_t)l * WD_BYTES + (size_t)e * D * FF + 64 * kb; d.rowb = 32 * nb; }
    return d;
}
__device__ __forceinline__ void cv_load(f32x4 (&cv)[8], const CvDesc& d, int lane) {
    const float* p = d.W + (size_t)(4 * (lane >> 3)) * d.N + 4 * (lane & 7);
#pragma unroll
    for (int tt = 0; tt < 2; ++tt)
#pragma unroll
        for (int kk = 0; kk < 4; ++kk) cv[4 * tt + kk] = *(const f32x4*)(p + (size_t)(32 * tt + kk) * d.N);
}
__device__ __forceinline__ void cv_store(const f32x4 (&cv)[8], const CvDesc& d, int lane) {
    unsigned char* q = d.WT + (size_t)(d.rowb + 4 * (lane & 7)) * d.K + 4 * (lane >> 3);
#pragma unroll
    for (int tt = 0; tt < 2; ++tt)
#pragma unroll
        for (int j = 0; j < 4; ++j)
            *(unsigned*)(q + (size_t)j * d.K + 32 * tt) = pk4_fp8(cv[4 * tt][j] * WSCALE, cv[4 * tt + 1][j] * WSCALE, cv[4 * tt + 2][j] * WSCALE, cv[4 * tt + 3][j] * WSCALE);
}
template <bool B> struct BoolC { static constexpr bool value = B; };
namespace gm {
constexpr int BM = 256, BK = 64, HALF = 128, HTB = HALF * BK * 2, STAGE_BYTES = 8 * HTB, NXCD = 8, WGM = 8;
__host__ __device__ __forceinline__ int lds_byte(int r, int c) { const int st = (r >> 4) * 2 + (c >> 5), rr = r & 15, cc = c & 31, ob = rr * 64 + cc * 2; return st * 1024 + (ob ^ (((ob >> 9) & 1) << 5)); }
__host__ __device__ __forceinline__ void stage_rc(int b, int& R, int& C) { const int st = b / 1024, sb = b % 1024, swz = sb ^ (((sb >> 9) & 1) << 5); R = (st >> 1) * 16 + swz / 64; C = (st & 1) * 32 + (swz % 64) / 2; }
__host__ __device__ __forceinline__ int sig2(int x) { return ((x & 1) << 1) | (x >> 1); }
__host__ __device__ __forceinline__ int perm32(int rho) { const int n = rho >> 4, i = rho & 15; return 8 * sig2(i >> 2) + 4 * n + (i & 3); }
struct Unit { int pm, pn; };
struct StaticOrder {
    int nM, nN, nwg, G, c;
    __device__ void init(int Mr, int N, int G_, int c_) { nM = Mr / BM; nN = N / BM; nwg = nM * nN; G = G_; c = c_; }
    __device__ bool next(int i, Unit& u) const {
        const long L = (long)i * G + c; if (L >= nwg) return false;
        int wgid = (int)L; { const int q = nwg / NXCD, r = nwg % NXCD, xcd = wgid % NXCD, off = wgid / NXCD; wgid = (xcd < r ? xcd * (q + 1) : r * (q + 1) + (xcd - r) * q) + off; }
        const int nig = WGM * nN, gid = wgid / nig, fm = gid * WGM, gsz = (nM - fm) < WGM ? (nM - fm) : WGM;
        u.pm = fm + ((wgid % nig) % gsz); u.pn = (wgid % nig) / gsz; return true;
    }
};
struct ASrc { const char* base; const int* sel; int K; const float* rss; };
struct BSrc { const char* base; int eshift; size_t estride; };

template <class Epi, bool GATHER, bool FP8>
#ifndef GPROBE
#define GPROBE 0
#endif
__device__ __forceinline__ void gemm_phase(LAS unsigned char* lds, const ASrc A, const BSrc B, const StaticOrder& S, const Epi& E, unsigned long long& gp_acc) {
    unsigned long long gp_t = 0ull; (void)gp_t; (void)gp_acc;
    const int tid = fresh_v(threadIdx.x), wid = __builtin_amdgcn_readfirstlane(tid >> 6), lane = tid & 63, wr = wid >> 2, wc = wid & 3, fr = lane & 15, fq = lane >> 4;
    const int K = A.K, KB = FP8 ? K : 2 * K, nt = KB / (BK * 2);
    unsigned voffA0, voffA1, voffB0, voffB1;
    { int R0, R1, C0, C1; stage_rc(tid * 16, R0, C0); stage_rc(tid * 16 + 8192, R1, C1);
      const int Rb0 = Epi::PERM ? ((R0 & ~31) + perm32(R0 & 31)) : R0, Rb1 = Epi::PERM ? ((R1 & ~31) + perm32(R1 & 31)) : R1;
      voffA0 = (unsigned)(R0 * KB + C0 * 2); voffA1 = (unsigned)(R1 * KB + C1 * 2); voffB0 = (unsigned)(Rb0 * KB + C0 * 2); voffB1 = (unsigned)(Rb1 * KB + C1 * 2); }
    const unsigned kstep = (unsigned)(BK * 2);
    const unsigned hstep = (unsigned)HALF * (unsigned)KB;
    const unsigned tstep = 2u * hstep;
    const unsigned ldsw = (unsigned)wid * 1024u;
    const int aoff = lds_byte(wr * 64 + fr, fq * 8), boff = lds_byte(wc * 32 + fr, fq * 8);
    const __amdgpu_buffer_rsrc_t rA = __builtin_amdgcn_make_buffer_rsrc((void*)A.base, 0, 0xffffffff, 0x00020000);
    const __amdgpu_buffer_rsrc_t rB = __builtin_amdgcn_make_buffer_rsrc((void*)B.base, 0, 0xffffffff, 0x00020000);
#define G_SA(b, h) (((b) * 2 + (h)) * HTB)
#define G_SB(b, h) ((4 + (b) * 2 + (h)) * HTB)
#define G_LDS2(bufoff, rs, so, o0, o1) do { \
        __builtin_amdgcn_raw_ptr_buffer_load_lds(rs, (LAS unsigned*)(lds + (bufoff) + ldsw), 16, (o0), (so), 0, 0); \
        __builtin_amdgcn_raw_ptr_buffer_load_lds(rs, (LAS unsigned*)(lds + (bufoff) + ldsw + 8192), 16, (o1), (so), 0, 0); } while (0)
#define G_STB(bufoff, so) G_LDS2(bufoff, rB, so, voffB0, voffB1)
#define G_STA(bufoff, DSO, GSO, g0, g1) do { if constexpr (GATHER) { G_LDS2(bufoff, rA, GSO, g0, g1); } else { G_LDS2(bufoff, rA, DSO, voffA0, voffA1); } } while (0)
#define G_RD8(p) __builtin_shufflevector(*(const LAS i32x4*)(p), *(const LAS i32x4*)((p) + 1024), 0, 1, 2, 3, 4, 5, 6, 7)
#define G_LDA(dst, b, h) do { if constexpr (FP8) { _Pragma("unroll") for (int m = 0; m < 4; ++m) dst##8[m] = G_RD8(lds + G_SA(b, h) + aoff + m * 2048); } \
        else { _Pragma("unroll") for (int m = 0; m < 4; ++m) _Pragma("unroll") for (int k = 0; k < 2; ++k) dst[m][k] = *(const LAS bf16x8*)(lds + G_SA(b, h) + aoff + m * 2048 + k * 1024); } } while (0)
#define G_LDB(dst, b, h) do { if constexpr (FP8) { _Pragma("unroll") for (int n = 0; n < 2; ++n) dst##8[n] = G_RD8(lds + G_SB(b, h) + boff + n * 2048); } \
        else { _Pragma("unroll") for (int n = 0; n < 2; ++n) _Pragma("unroll") for (int k = 0; k < 2; ++k) dst[n][k] = *(const LAS bf16x8*)(lds + G_SB(b, h) + boff + n * 2048 + k * 1024); } } while (0)
#define G_MMA(ai, bj, At, Bt) do { __builtin_amdgcn_s_setprio(1); _Pragma("unroll") for (int m = 0; m < 4; ++m) _Pragma("unroll") for (int n = 0; n < 2; ++n) { \
        if constexpr (FP8) acc[ai][bj][m][n] = __builtin_amdgcn_mfma_scale_f32_16x16x128_f8f6f4(Bt##8[n], At##8[m], acc[ai][bj][m][n], 0, 0, 0, 0, 0, 0); \
        else { _Pragma("unroll") for (int k = 0; k < 2; ++k) acc[ai][bj][m][n] = __builtin_amdgcn_mfma_f32_16x16x32_bf16(Bt[n][k], At[m][k], acc[ai][bj][m][n], 0, 0, 0); } } \
        __builtin_amdgcn_s_setprio(0); } while (0)
#define G_WAIT_V(n) asm volatile("s_waitcnt vmcnt(" #n ")" ::: "memory")
#define G_WAIT_L(n) asm volatile("s_waitcnt lgkmcnt(" #n ")" ::: "memory")
#define G_WAIT_V8F() do { if (fresh) { if (Epi::HOST && hprev) asm volatile("s_waitcnt vmcnt(%0)" :: "n"(8 + Epi::NST + 8) : "memory"); else asm volatile("s_waitcnt vmcnt(%0)" :: "n"(8 + Epi::NST) : "memory"); } \
        else asm volatile("s_waitcnt vmcnt(8)" ::: "memory"); } while (0)
#define G_BAR __builtin_amdgcn_s_barrier()
#define G_SCHED __builtin_amdgcn_sched_barrier(0)
#define G_ROWS(u, v00, v01, v10, v11) do { const int rb_ = (u).pm * BM; const unsigned kb_ = (unsigned)KB; int r0_, c0_, r1_, c1_; { const int tz_ = fresh_v(tid); stage_rc(tz_ * 16, r0_, c0_); stage_rc(tz_ * 16 + 8192, r1_, c1_); } \
        if (A.sel) { v00 = (unsigned)A.sel[rb_ + r0_] * kb_ + (unsigned)c0_ * 2u; v01 = (unsigned)A.sel[rb_ + r1_] * kb_ + (unsigned)c1_ * 2u; \
        v10 = (unsigned)A.sel[rb_ + HALF + r0_] * kb_ + (unsigned)c0_ * 2u; v11 = (unsigned)A.sel[rb_ + HALF + r1_] * kb_ + (unsigned)c1_ * 2u; } \
        else { v00 = (unsigned)(rb_ + r0_) * kb_ + (unsigned)c0_ * 2u; v01 = (unsigned)(rb_ + r1_) * kb_ + (unsigned)c1_ * 2u; \
        v10 = (unsigned)(rb_ + HALF + r0_) * kb_ + (unsigned)c0_ * 2u; v11 = (unsigned)(rb_ + HALF + r1_) * kb_ + (unsigned)c1_ * 2u; } \
        asm volatile("" : "+v"(v00), "+v"(v01), "+v"(v10), "+v"(v11)); } while (0)
#define G_BOFF(u) ((unsigned)((u).pm >> B.eshift) * (unsigned)B.estride + (unsigned)(u).pn * tstep)
    Unit cur, nxt; int ui = 0; bool fresh = false, hprev = false;
    if (!S.next(0, cur)) return;
    f32x4 acc[2][2][4][2];
#pragma unroll
    for (int a = 0; a < 2; ++a)
#pragma unroll
        for (int b = 0; b < 2; ++b)
#pragma unroll
            for (int m = 0; m < 4; ++m)
#pragma unroll
                for (int n = 0; n < 2; ++n) acc[a][b][m][n] = (f32x4){0.f, 0.f, 0.f, 0.f};
    bf16x8 At[4][2], B0[2][2], B1[2][2]; v8i32 At8[4], B08[2], B18[2];
    unsigned vC00 = 0, vC01 = 0, vC10 = 0, vC11 = 0;
    LAS u32x4* const gslot = (LAS u32x4*)(lds + GOFF_OFF) + tid;
    LAS float* const rstab = (LAS float*)(lds + GOFF_OFF + 8192);
    int rspar = 0;
    if constexpr (Epi::NEED_RS) { if (tid < BM) rstab[tid] = A.rss[cur.pm * BM + tid]; }
    unsigned cA = (unsigned)cur.pm * tstep;
    unsigned cB = G_BOFF(cur);
    if constexpr (GATHER) { G_ROWS(cur, vC00, vC01, vC10, vC11); }
    G_STB(G_SB(0, 0), cB); G_STB(G_SB(0, 1), cB + hstep); G_STA(G_SA(0, 0), cA, 0u, vC00, vC01); G_STA(G_SA(0, 1), cA + hstep, 0u, vC10, vC11);
    if (wr == 1) G_BAR;
    G_WAIT_V(2); G_BAR;
    G_STB(G_SB(1, 0), cB + kstep); G_STA(G_SA(1, 0), cA + kstep, kstep, vC00, vC01); G_STB(G_SB(1, 1), cB + hstep + kstep);
    G_WAIT_V(6); G_BAR;
    for (;;) {
        const bool has_next = S.next(ui + 1, nxt);
        const unsigned nA = has_next ? (unsigned)nxt.pm * tstep : cA;
        const unsigned nB = has_next ? G_BOFF(nxt) : cB;
        if constexpr (GATHER) {
            unsigned n00 = vC00, n01 = vC01, n10 = vC10, n11 = vC11;
            if (has_next && nxt.pm != cur.pm) { G_ROWS(nxt, n00, n01, n10, n11);
                if constexpr (Epi::NEED_RS) { if (tid < BM) rstab[(rspar ^ 1) * BM + tid] = A.rss[nxt.pm * BM + tid]; } }
            *gslot = (u32x4){n00, n01, n10, n11};
        }
        if (GPROBE == 1 && ui > 0) gp_acc += __builtin_amdgcn_s_memrealtime() - gp_t;
#pragma unroll 1
        for (int t = 0; t < nt; t += 2) {
            if (GPROBE == 2 && ui > 0 && t == 0) gp_t = __builtin_amdgcn_s_memrealtime();
            if (GPROBE == 2 && ui > 0 && t == 2) gp_acc += __builtin_amdgcn_s_memrealtime() - gp_t;
            if (GPROBE == 3 && t == 2) gp_t = __builtin_amdgcn_s_memrealtime();
            const bool last = (t == nt - 2);
            const unsigned a1 = cA + (unsigned)(t + 1) * kstep;
            const unsigned g1 = (unsigned)(t + 1) * kstep;
            const unsigned a2 = last ? nA : cA + (unsigned)(t + 2) * kstep; const unsigned b2 = last ? nB : cB + (unsigned)(t + 2) * kstep;
            const unsigned g2 = last ? 0u : (unsigned)(t + 2) * kstep;
            const unsigned a3 = a2 + kstep; const unsigned b3 = b2 + kstep; const unsigned g3 = g2 + kstep;
            G_LDB(B0, 0, 0); G_LDB(B1, 0, 1); G_SCHED; G_LDA(At, 0, 0); if (!fresh) G_STA(G_SA(1, 1), a1 + hstep, g1, vC10, vC11);
            if constexpr (GATHER) { if (last) { const u32x4 nv = *gslot; vC00 = nv.x; vC01 = nv.y; vC10 = nv.z; vC11 = nv.w; } }
            G_WAIT_V8F(); G_WAIT_L(0); G_BAR; G_MMA(0, 0, At, B0); G_MMA(0, 1, At, B1); G_BAR; G_SCHED;
            G_LDA(At, 0, 1); G_STB(G_SB(0, 0), b2); G_STB(G_SB(0, 1), b2 + hstep); G_STA(G_SA(0, 0), a2, g2, vC00, vC01);
            G_WAIT_V8F(); G_WAIT_L(0); G_BAR; G_MMA(1, 0, At, B0); G_MMA(1, 1, At, B1); G_BAR; G_SCHED;
            G_LDB(B0, 1, 0); G_LDB(B1, 1, 1); G_SCHED; G_LDA(At, 1, 0); G_STA(G_SA(0, 1), a2 + hstep, g2, vC10, vC11);
            G_WAIT_V8F(); fresh = false; G_WAIT_L(0); G_BAR; G_MMA(0, 0, At, B0); G_MMA(0, 1, At, B1); G_BAR; G_SCHED;
            G_LDA(At, 1, 1); G_STB(G_SB(1, 0), b3); G_STB(G_SB(1, 1), b3 + hstep); G_STA(G_SA(1, 0), a3, g3, vC00, vC01);
            G_WAIT_V(8); G_WAIT_L(0); G_BAR; G_MMA(1, 0, At, B0); G_MMA(1, 1, At, B1); G_BAR; G_SCHED;
        }
        if (GPROBE == 3) gp_acc += __builtin_amdgcn_s_memrealtime() - gp_t;
        if (GPROBE == 1) gp_t = __builtin_amdgcn_s_memrealtime();
        G_STA(G_SA(1, 1), nA + kstep + hstep, kstep, vC10, vC11);
        if (wr == 0) G_BAR;
        f32x4 cvr[8]; bool hnow = false;
        int hl_ = 0, hj_ = 0;
        if constexpr (Epi::HOST) { hl_ = ui < E.hostn ? 1 : 0; hj_ = ui < E.hostn ? ui : ui - E.hostn + E.hostj0; }
        if constexpr (Epi::HOST) { hnow = ui < E.hostn + E.hostn0; if (hnow) { const CvDesc cd = cv_desc(E.ws, hl_, E.cvg0 + E.cvstep * hj_); cv_load(cvr, cd, lane); } }
        if constexpr (Epi::NEED_RS) E(acc, cur, wr, wc, fr, fq, rstab + rspar * BM); else E(acc, cur, wr, wc, fr, fq);
        if constexpr (Epi::HOST) { if (hnow) { const CvDesc cd = cv_desc(E.ws, hl_, E.cvg0 + E.cvstep * hj_); cv_store(cvr, cd, lane); } }
        if (!has_next) break;
        if constexpr (Epi::NEED_RS) { if (nxt.pm != cur.pm) rspar ^= 1; }
#pragma unroll
        for (int a = 0; a < 2; ++a)
#pragma unroll
            for (int b = 0; b < 2; ++b)
#pragma unroll
                for (int m = 0; m < 4; ++m)
#pragma unroll
                    for (int n = 0; n < 2; ++n) acc[a][b][m][n] = (f32x4){0.f, 0.f, 0.f, 0.f};
        cur = nxt; cA = nA; cB = nB; ++ui; fresh = true; hprev = hnow;
        if (wr == 1) G_BAR;
    }
    G_WAIT_V(0);
    G_BAR;
#undef G_SA
#undef G_SB
#undef G_LDS2
#undef G_STB
#undef G_STA
#undef G_LDA
#undef G_LDB
#undef G_MMA
#undef G_RD8
#undef G_WAIT_V
#undef G_WAIT_L
#undef G_WAIT_V8F
#undef G_BAR
#undef G_SCHED
#undef G_ROWS
#undef G_BOFF
}

struct EpiQKV {
    static constexpr bool NEED_RS = false; static constexpr bool PERM = true; static constexpr bool HOST = false; static constexpr int NST = 16;
    bf16_t* O; const float* rope;
    __device__ __forceinline__ void operator()(const f32x4 (&acc)[2][2][4][2], const Unit& u, int wr, int wc, int fr, int fq) const {
        const int row0 = u.pm * BM + wr * 64 + fr, col0 = u.pn * BM + wc * 32 + 8 * sig2(fq);
        const bool do_rope = u.pn < 4;
        const float sc = (u.pn < 2 || (u.pn >= 6 && u.pn < 8)) ? QSCALE : 1.0f;
        const int i0 = (wc & 1) * 16 + 4 * sig2(fq);
        f32x4 cs[2][4][2];
#pragma unroll
        for (int ai = 0; ai < 2; ++ai)
#pragma unroll
            for (int m = 0; m < 4; ++m) { cs[ai][m][0] = (f32x4){1.f, 0.f, 1.f, 0.f}; cs[ai][m][1] = cs[ai][m][0];
                if (do_rope) { const float* rp = rope + ((size_t)((row0 + ai * HALF + m * 16) & (T - 1)) * 32 + i0) * 2; cs[ai][m][0] = *(const f32x4*)rp; cs[ai][m][1] = *(const f32x4*)(rp + 4); } }
#pragma unroll
        for (int ai = 0; ai < 2; ++ai)
#pragma unroll
            for (int m = 0; m < 4; ++m) {
                const int row = row0 + ai * HALF + m * 16;
                const int bb = row >> 13, tt = row & (T - 1);
                const f32x4 cs0 = cs[ai][m][0], cs1 = cs[ai][m][1];
#pragma unroll
                for (int bj = 0; bj < 2; ++bj) {
                    f32x4 v0 = acc[ai][bj][m][0], v1 = acc[ai][bj][m][1];
                    if (do_rope) {
                        const f32x4 a = v0, b = v1;
                        v0[0] = a[0] * cs0[0] - a[1] * cs0[1]; v0[1] = a[1] * cs0[0] + a[0] * cs0[1];
                        v0[2] = a[2] * cs0[2] - a[3] * cs0[3]; v0[3] = a[3] * cs0[2] + a[2] * cs0[3];
                        v1[0] = b[0] * cs1[0] - b[1] * cs1[1]; v1[1] = b[1] * cs1[0] + b[0] * cs1[1];
                        v1[2] = b[2] * cs1[2] - b[3] * cs1[3]; v1[3] = b[3] * cs1[2] + b[2] * cs1[3];
                    }
                    v0 = v0 * sc; v1 = v1 * sc;
                    u32x4 w; w.x = cvt_pk_bf16(v0[0], v0[1]); w.y = cvt_pk_bf16(v0[2], v0[3]); w.z = cvt_pk_bf16(v1[0], v1[1]); w.w = cvt_pk_bf16(v1[2], v1[3]);
                    const int cc = col0 + bj * HALF;
                    *(u32x4*)(O + ((((size_t)((cc >> 9) * BATCH + bb) * 8 + ((cc >> 6) & 7)) * T + tt) << 6) + (cc & 63)) = w;
                }
            }
    }
};
struct EpiBf16Out {
    static constexpr bool NEED_RS = false; static constexpr bool PERM = true; static constexpr bool HOST = false; static constexpr int NST = 16;
    bf16_t* O;
    __device__ __forceinline__ void operator()(const f32x4 (&acc)[2][2][4][2], const Unit& u, int wr, int wc, int fr, int fq) const {
        const int row0 = u.pm * BM + wr * 64 + fr, col0 = u.pn * BM + wc * 32 + 8 * sig2(fq);
#pragma unroll
        for (int ai = 0; ai < 2; ++ai)
#pragma unroll
            for (int m = 0; m < 4; ++m) { bf16_t* rowp = O + (size_t)(row0 + ai * HALF + m * 16) * D + col0;
#pragma unroll
                for (int bj = 0; bj < 2; ++bj) { const f32x4 v0 = acc[ai][bj][m][0], v1 = acc[ai][bj][m][1];
                    u32x4 w; w.x = cvt_pk_bf16(v0[0], v0[1]); w.y = cvt_pk_bf16(v0[2], v0[3]); w.z = cvt_pk_bf16(v1[0], v1[1]); w.w = cvt_pk_bf16(v1[2], v1[3]);
                    *(u32x4*)(rowp + bj * HALF) = w; } }
    }
};
struct EpiResid {
    static constexpr bool NEED_RS = false; static constexpr bool PERM = false; static constexpr bool HOST = false; static constexpr int NST = 0;
    const float* resid; float* out;
    __device__ __forceinline__ void operator()(const f32x4 (&acc)[2][2][4][2], const Unit& u, int wr, int wc, int fr, int fq) const {
        const int row0 = u.pm * BM + wr * 64 + fr, col0 = u.pn * BM + wc * 32 + 4 * fq;
#pragma unroll
        for (int ai = 0; ai < 2; ++ai)
#pragma unroll
            for (int m = 0; m < 4; ++m) { const size_t off = (size_t)(row0 + ai * HALF + m * 16) * D + col0;
#pragma unroll
                for (int bj = 0; bj < 2; ++bj)
#pragma unroll
                    for (int n = 0; n < 2; ++n) { const f32x4 r = *(const f32x4*)(resid + off + bj * HALF + n * 16); *(f32x4*)(out + off + bj * HALF + n * 16) = r + acc[ai][bj][m][n]; }
                if (m & 1) asm volatile("" ::: "memory"); }
    }
};
struct EpiSwiGLU {
    static constexpr bool NEED_RS = true; static constexpr bool PERM = true; static constexpr bool HOST = true; static constexpr int NST = 4;
    unsigned char* O; unsigned char* ws; int hostn, hostn0, hostj0, cvg0, cvstep;
    __device__ __forceinline__ void operator()(const f32x4 (&acc)[2][2][4][2], const Unit& u, int wr, int wc, int fr, int fq, const LAS float* rst) const {
        const int hi = fq >> 1;
        const int row0 = u.pm * BM + wr * 64 + fr + 16 * hi, col0 = u.pn * HALF + wc * 32 + 8 * sig2(fq) - 8 * hi;
#pragma unroll
        for (int ai = 0; ai < 2; ++ai)
#pragma unroll
            for (int mp = 0; mp < 2; ++mp) {
                u32x2 w[2];
#pragma unroll
                for (int mm = 0; mm < 2; ++mm) { const int m = 2 * mp + mm;
                    const float rs = rst[ai * HALF + wr * 64 + m * 16 + fr], ce = rs * (-LOG2E * WINV), q = (WSCALE * WSCALE) * __builtin_amdgcn_rcpf(rs * rs);
                    float r[8];
                    const f32x2 ce2 = (f32x2){ce, ce}, q2 = (f32x2){q, q};
#pragma unroll
                    for (int n = 0; n < 2; ++n)
#pragma unroll
                        for (int jp = 0; jp < 2; ++jp) {
                            const f32x2 G2 = (f32x2){acc[ai][0][m][n][2 * jp], acc[ai][0][m][n][2 * jp + 1]}, U2 = (f32x2){acc[ai][1][m][n][2 * jp], acc[ai][1][m][n][2 * jp + 1]};
                            const f32x2 x2 = G2 * ce2;
                            const f32x2 e2 = (f32x2){__builtin_amdgcn_exp2f(x2[0]), __builtin_amdgcn_exp2f(x2[1])};
                            const f32x2 d2 = __builtin_elementwise_fma(e2, q2, q2);
                            const f32x2 r2 = (f32x2){__builtin_amdgcn_rcpf(d2[0]), __builtin_amdgcn_rcpf(d2[1])};
                            const f32x2 o2 = (G2 * U2) * r2;
                            r[n * 4 + 2 * jp] = o2[0]; r[n * 4 + 2 * jp + 1] = o2[1]; }
                    w[mm].x = pk4_fp8(r[0], r[1], r[2], r[3]); w[mm].y = pk4_fp8(r[4], r[5], r[6], r[7]); }
                const auto sx = __builtin_amdgcn_permlane32_swap(w[0].x, w[1].x, false, false), sy = __builtin_amdgcn_permlane32_swap(w[0].y, w[1].y, false, false);
                u32x4 v; v.x = sx[0]; v.y = sy[0]; v.z = sx[1]; v.w = sy[1];
                *(u32x4*)(O + (size_t)(row0 + ai * HALF + mp * 32) * FF + col0) = v;
            }
    }
};
struct EpiDown {
    static constexpr bool NEED_RS = false; static constexpr bool PERM = true; static constexpr bool HOST = false; static constexpr int NST = 8;
    unsigned char* O; const float* gatev;
    __device__ __forceinline__ void operator()(const f32x4 (&acc)[2][2][4][2], const Unit& u, int wr, int wc, int fr, int fq) const {
        const int hi = fq >> 1;
        const int row0 = u.pm * BM + wr * 64 + fr + 16 * hi, col0 = u.pn * BM + wc * 32 + 8 * sig2(fq) - 8 * hi;
        const float gv = WINV * YSCALE;
#pragma unroll
        for (int ai = 0; ai < 2; ++ai)
#pragma unroll
            for (int mp = 0; mp < 2; ++mp) {
                unsigned char* rowp = O + (size_t)(row0 + ai * HALF + mp * 32) * D + col0;
#pragma unroll
                for (int bj = 0; bj < 2; ++bj) {
                    u32x2 w[2];
#pragma unroll
                    for (int mm = 0; mm < 2; ++mm) { const f32x4 v0 = acc[ai][bj][2 * mp + mm][0] * gv, v1 = acc[ai][bj][2 * mp + mm][1] * gv;
                        w[mm].x = pk4_fp8(v0[0], v0[1], v0[2], v0[3]); w[mm].y = pk4_fp8(v1[0], v1[1], v1[2], v1[3]); }
                    const auto sx = __builtin_amdgcn_permlane32_swap(w[0].x, w[1].x, false, false), sy = __builtin_amdgcn_permlane32_swap(w[0].y, w[1].y, false, false);
                    u32x4 v; v.x = sx[0]; v.y = sy[0]; v.z = sx[1]; v.w = sy[1];
                    *(u32x4*)(rowp + bj * HALF) = v; }
            }
    }
};
}

struct Frame {
    LAS unsigned char* lds;
    int tid, lane, wave, vcu, G;
    float* out; unsigned char* ws;
};
template <int MODE> __device__ __forceinline__ int dest_row(int n, int aux) {
    if (MODE == 1) return n < 1024 ? ((n & ~63) + 2 * (n & 31) + ((n >> 5) & 1)) : n;
    if (MODE == 2) return (n >> 7) * 256 + aux * 128 + (n & 127);
    return n;
}
template <int MODE> __device__ __forceinline__ void conv_item(const float* W, int K, int N, bf16_t* WT, int aux, LAS float* scr, int item, int lane) {
    const int nblk = N / 32, kb = item / nblk, nb = item - kb * nblk, k0 = 64 * kb, n0 = 32 * nb;
    f32x4 v[8];
#pragma unroll
    for (int it = 0; it < 8; ++it) { const int kk = 8 * it + (lane >> 3); v[it] = *(const f32x4*)(W + (size_t)(k0 + kk) * N + n0 + 4 * (lane & 7)); }
#pragma unroll
    for (int it = 0; it < 8; ++it) { const int kk = 8 * it + (lane >> 3); LAS float* s = scr + kk * 33 + 4 * (lane & 7); s[0] = v[it][0]; s[1] = v[it][1]; s[2] = v[it][2]; s[3] = v[it][3]; }
    LDS_WAIT(); asm volatile("" ::: "memory");
    const int c = lane & 7;
#pragma unroll
    for (int j = 0; j < 4; ++j) { const int n = (lane >> 3) + 8 * j; const LAS float* s = scr + (8 * c) * 33 + n;
        u32x4 o; o.x = cvt_pk_bf16(s[0 * 33], s[1 * 33]); o.y = cvt_pk_bf16(s[2 * 33], s[3 * 33]); o.z = cvt_pk_bf16(s[4 * 33], s[5 * 33]); o.w = cvt_pk_bf16(s[6 * 33], s[7 * 33]);
        *(u32x4*)(WT + (size_t)dest_row<MODE>(n0 + n, aux) * K + k0 + 8 * c) = o; }
    LDS_WAIT(); asm volatile("" ::: "memory");
}
template <int MODE> __device__ __forceinline__ void conv_item8(const float* W, int K, int N, unsigned char* WT, int aux, LAS float* scr, int item, int lane) {
    const int nblk = N / 32, kb = item / nblk, nb = item - kb * nblk, k0 = 64 * kb, n0 = 32 * nb;
    f32x4 v[8];
#pragma unroll
    for (int it = 0; it < 8; ++it) { const int kk = 8 * it + (lane >> 3); v[it] = *(const f32x4*)(W + (size_t)(k0 + kk) * N + n0 + 4 * (lane & 7)); }
#pragma unroll
    for (int it = 0; it < 8; ++it) { const int kk = 8 * it + (lane >> 3); LAS float* s = scr + kk * 33 + 4 * (lane & 7); s[0] = v[it][0]; s[1] = v[it][1]; s[2] = v[it][2]; s[3] = v[it][3]; }
    LDS_WAIT(); asm volatile("" ::: "memory");
    const int c = lane & 3;
#pragma unroll
    for (int j = 0; j < 2; ++j) { const int n = (lane >> 2) + 16 * j; const LAS float* s = scr + (16 * c) * 33 + n;
        u32x4 o;
        o.x = pk4_fp8(s[0 * 33] * WSCALE, s[1 * 33] * WSCALE, s[2 * 33] * WSCALE, s[3 * 33] * WSCALE); o.y = pk4_fp8(s[4 * 33] * WSCALE, s[5 * 33] * WSCALE, s[6 * 33] * WSCALE, s[7 * 33] * WSCALE);
        o.z = pk4_fp8(s[8 * 33] * WSCALE, s[9 * 33] * WSCALE, s[10 * 33] * WSCALE, s[11 * 33] * WSCALE); o.w = pk4_fp8(s[12 * 33] * WSCALE, s[13 * 33] * WSCALE, s[14 * 33] * WSCALE, s[15 * 33] * WSCALE);
        *(u32x4*)(WT + (size_t)dest_row<MODE>(n0 + n, aux) * K + k0 + 16 * c) = o; }
    LDS_WAIT(); asm volatile("" ::: "memory");
}
__device__ __forceinline__ void conv_weights(Frame& F0, int l, int experts) {
    Frame F = F0; F.tid = fresh_v(F0.tid); F.lane = F.tid & 63; F.wave = fresh_s(F0.wave);
    LAS float* scr = (LAS float*)(F.lds + F.wave * 16384);
    const int gw = F.vcu * NWAVES + F.wave, NGW = F.G * NWAVES;
    constexpr int I_IN = (D / 64) * (NQKV / 32), I_OUT = (D / 64) * (D / 32), I_GE = (D / 64) * (FF / 32), I_DE = (FF / 64) * (D / 32);
    constexpr int NITEMS = I_IN + I_OUT + NE * (2 * I_GE + I_DE);
    CArgs* ka = kargs();
    const float* w_in = ka->in[2] + (size_t)l * D * NQKV; const float* w_out = ka->in[6] + (size_t)l * D * D;
    const float* w_gate = ka->in[9] + (size_t)l * NE * D * FF; const float* w_up = ka->in[10] + (size_t)l * NE * D * FF; const float* w_down = ka->in[11] + (size_t)l * NE * FF * D;
    bf16_t* WIN = (bf16_t*)(F.ws + WS_WIN); bf16_t* WOUT = (bf16_t*)(F.ws + WS_WOUT); unsigned char* WGU = F.ws + WS_WGU + (size_t)l * WGU_BYTES; unsigned char* WD = F.ws + WS_WD + (size_t)l * WD_BYTES;
    const int nit = experts == 1 ? NITEMS : experts == 2 ? I_IN + I_OUT + 2 * NE * I_GE : I_IN + I_OUT;
    for (int it = gw; it < nit; it += NGW) {
        int r = it;
        if (r < I_IN) { conv_item<1>(w_in, D, NQKV, WIN, 0, scr, r, F.lane); continue; } r -= I_IN;
        if (r < I_OUT) { conv_item<0>(w_out, D, D, WOUT, 0, scr, r, F.lane); continue; } r -= I_OUT;
        if (r < NE * I_GE) { const int e = r / I_GE; conv_item8<2>(w_gate + (size_t)e * D * FF, D, FF, WGU + (size_t)e * 2 * FF * D, 0, scr, r - e * I_GE, F.lane); continue; } r -= NE * I_GE;
        if (r < NE * I_GE) { const int e = r / I_GE; conv_item8<2>(w_up + (size_t)e * D * FF, D, FF, WGU + (size_t)e * 2 * FF * D, 1, scr, r - e * I_GE, F.lane); continue; } r -= NE * I_GE;
        { const int e = r / I_DE; conv_item8<0>(w_down + (size_t)e * FF * D, FF, D, WD + (size_t)e * D * FF, 0, scr, r - e * I_DE, F.lane); }
    }
}
__device__ const double INVF[32] = {
    1.0, 0.7498942093324559, 0.5623413251903491, 0.4216965034285822, 0.31622776601683794, 0.23713737056616552, 0.1778279410038923, 0.1333521432163324,
    0.1, 0.07498942093324558, 0.05623413251903491, 0.042169650342858224, 0.03162277660168379, 0.023713737056616554, 0.01778279410038923, 0.01333521432163324,
    0.01, 0.007498942093324558, 0.005623413251903491, 0.004216965034285823, 0.0031622776601683794, 0.0023713737056616554, 0.0017782794100389228, 0.001333521432163324,
    0.001, 0.0007498942093324559, 0.0005623413251903491, 0.00042169650342858224, 0.00031622776601683794, 0.00023713737056616554, 0.00017782794100389227, 0.0001333521432163324};
__device__ __forceinline__ void rope_table(Frame& F0) {
    Frame F = F0; F.tid = fresh_v(F0.tid); F.lane = F.tid & 63; F.wave = fresh_s(F0.wave);
    float* tab = (float*)(F.ws + WS_ROPE);
    for (int idx = F.vcu * NTHREADS + F.tid; idx < T * 32; idx += F.G * NTHREADS) {
        const int t = idx >> 5, i = idx & 31;
        const double ang = (double)t * INVF[i];
        const double n = __builtin_rint(ang * 0.15915494309189535);
        double r = __builtin_fma(-n, 6.283185307179586, ang); r = __builtin_fma(-n, 2.4492935982947064e-16, r);
        const double x = r * 0.25, x2 = x * x;
        double s = -1.0 / 1307674368000.0; s = s * x2 + 1.0 / 6227020800.0; s = s * x2 - 1.0 / 39916800.0; s = s * x2 + 1.0 / 362880.0; s = s * x2 - 1.0 / 5040.0; s = s * x2 + 1.0 / 120.0; s = s * x2 - 1.0 / 6.0; s = s * x2 + 1.0; s = s * x;
        double c = 1.0 / 20922789888000.0; c = c * x2 - 1.0 / 87178291200.0; c = c * x2 + 1.0 / 479001600.0; c = c * x2 - 1.0 / 3628800.0; c = c * x2 + 1.0 / 40320.0; c = c * x2 - 1.0 / 720.0; c = c * x2 + 1.0 / 24.0; c = c * x2 - 0.5; c = c * x2 + 1.0;
        const double s2 = 2.0 * s * c, c2 = 1.0 - 2.0 * s * s; const double s4 = 2.0 * s2 * c2, c4 = 1.0 - 2.0 * s2 * s2;
        *(f32x2*)(tab + (size_t)idx * 2) = (f32x2){(float)c4, (float)s4};
    }
}
__device__ __forceinline__ void store_bf16_row(bf16_t* orow, const f32x4 (&v)[4], int lane) {
    u32x2* o8 = (u32x2*)orow + lane;
#pragma unroll
    for (int j = 0; j < 4; ++j) { u32x2 w; w.x = cvt_pk_bf16(v[j][0], v[j][1]); w.y = cvt_pk_bf16(v[j][2], v[j][3]); o8[64 * j] = w; }
}
__device__ __forceinline__ float row_rstd(const f32x4 (&v)[4]) {
    float s = 0.f;
#pragma unroll
    for (int j = 0; j < 4; ++j) s += (v[j][0] * v[j][0] + v[j][1] * v[j][1]) + (v[j][2] * v[j][2] + v[j][3] * v[j][3]);
    return 1.0f / sqrtf(wave_sum(s) * (1.0f / D) + EPS);
}
__device__ __forceinline__ void norm1_phase(Frame& F0, const float* x, const float* gain) {
    Frame F = F0; F.tid = fresh_v(F0.tid); F.lane = F.tid & 63; F.wave = fresh_s(F0.wave);
    bf16_t* H = (bf16_t*)(F.ws + WS_H);
    const int gw = F.vcu * NWAVES + F.wave, NGW = F.G * NWAVES;
    f32x4 g[4];
#pragma unroll
    for (int j = 0; j < 4; ++j) g[j] = *((const f32x4*)gain + 64 * j + F.lane);
#pragma unroll 1
    for (int m = gw; m < M; m += NGW) {
        const f32x4* xr = (const f32x4*)(x + (size_t)m * D) + F.lane; f32x4 v[4];
#pragma unroll
        for (int j = 0; j < 4; ++j) v[j] = xr[64 * j];
        const float rstd = row_rstd(v);
#pragma unroll
        for (int j = 0; j < 4; ++j) v[j] = v[j] * rstd * g[j];
        store_bf16_row(H + (size_t)m * D, v, F.lane);
    }
}
constexpr int N2_WHI = 0, N2_WLO = 32768, N2_GAIN = 65536;
template <bool XBF>
__device__ __forceinline__ void norm2_router_phase(Frame& F0, const void* xin, bf16_t* x1, const float* gain, const float* wr) {
    Frame F = F0; F.tid = fresh_v(F0.tid); F.lane = F.tid & 63; F.wave = fresh_s(F0.wave);
    unsigned char* H8 = F.ws + WS_H; float* AFF = (float*)(F.ws + WS_AFF); const bf16_t* Aat = (const bf16_t*)(F.ws + WS_PARTA); float* RSTD = (float*)(F.ws + WS_RSTD);
    for (int idx = F.tid; idx < D * NE; idx += NTHREADS) { const int d = idx >> 4, e = idx & 15; const float w = wr[idx];
        const unsigned hi = cvt_pk_bf16(w, 0.f) & 0xffffu; const float rem = w - __uint_as_float(hi << 16); const unsigned lo = cvt_pk_bf16(rem, 0.f) & 0xffffu;
        const int o = ((((d >> 5) * 4 + ((d >> 3) & 3)) * 16 + e) * 8 + (d & 7)) * 2;
        *(LAS bf16_t*)(F.lds + N2_WHI + o) = (bf16_t)hi; *(LAS bf16_t*)(F.lds + N2_WLO + o) = (bf16_t)lo; }
    for (int idx = F.tid; idx < D; idx += NTHREADS) ((LAS float*)(F.lds + N2_GAIN))[idx] = gain[idx];
    __syncthreads();
    const int lane = F.lane, i = lane & 15, g = lane >> 4;
    const int gw = F.vcu * NWAVES + F.wave, NGW = F.G * NWAVES;
#pragma unroll 1
    for (int tile = gw; tile < M / 16; tile += NGW) {
        const int row = tile * 16 + i;
        const f32x4* xr = (const f32x4*)((const float*)xin + (size_t)row * D + 8 * g); const u32x4* xrb = (const u32x4*)((const bf16_t*)xin + (size_t)row * D + 8 * g);
        u32x4* xo = (u32x4*)(x1 + (size_t)row * D + 8 * g);
        const u32x4* ar = (const u32x4*)(Aat + (size_t)row * D + 8 * g); u32x2* ho = (u32x2*)(H8 + (size_t)row * D + 8 * g);
        f32x4 acc = (f32x4){0.f, 0.f, 0.f, 0.f}; float ssq = 0.f;
#pragma unroll 1
        for (int kq = 0; kq < 8; ++kq) {
            f32x4 xa[4], xb[4]; u32x4 aw[4], xw[4];
#pragma unroll
            for (int s = 0; s < 4; ++s) { const int ks = 4 * kq + s; if (XBF) xw[s] = xrb[4 * ks]; else { xa[s] = xr[8 * ks]; xb[s] = xr[8 * ks + 1]; } aw[s] = ar[4 * ks]; }
#pragma unroll
            for (int s = 0; s < 4; ++s) { const int ks = 4 * kq + s;
                f32x4 va, vb;
                if (XBF) { va = (f32x4){bf_lo(xw[s].x), bf_hi(xw[s].x), bf_lo(xw[s].y), bf_hi(xw[s].y)}; vb = (f32x4){bf_lo(xw[s].z), bf_hi(xw[s].z), bf_lo(xw[s].w), bf_hi(xw[s].w)}; } else { va = xa[s]; vb = xb[s]; }
                va[0] += bf_lo(aw[s].x); va[1] += bf_hi(aw[s].x); va[2] += bf_lo(aw[s].y); va[3] += bf_hi(aw[s].y);
                vb[0] += bf_lo(aw[s].z); vb[1] += bf_hi(aw[s].z); vb[2] += bf_lo(aw[s].w); vb[3] += bf_hi(aw[s].w);
                { u32x4 xw1; xw1.x = cvt_pk_bf16(va[0], va[1]); xw1.y = cvt_pk_bf16(va[2], va[3]); xw1.z = cvt_pk_bf16(vb[0], vb[1]); xw1.w = cvt_pk_bf16(vb[2], vb[3]); xo[4 * ks] = xw1; }
                ssq += (va[0] * va[0] + va[1] * va[1]) + (va[2] * va[2] + va[3] * va[3]) + (vb[0] * vb[0] + vb[1] * vb[1]) + (vb[2] * vb[2] + vb[3] * vb[3]);
                const f32x4 ga = *(const LAS f32x4*)(F.lds + N2_GAIN + (32 * ks + 8 * g) * 4), gb = *(const LAS f32x4*)(F.lds + N2_GAIN + (32 * ks + 8 * g + 4) * 4);
                va = va * ga; vb = vb * gb;
                u32x2 h8; h8.x = pk4_fp8(va[0], va[1], va[2], va[3]); h8.y = pk4_fp8(vb[0], vb[1], vb[2], vb[3]); ho[4 * ks] = h8;
                u32x4 hi; hi.x = cvt_pk_bf16(va[0], va[1]); hi.y = cvt_pk_bf16(va[2], va[3]); hi.z = cvt_pk_bf16(vb[0], vb[1]); hi.w = cvt_pk_bf16(vb[2], vb[3]);
                u32x4 lo; lo.x = cvt_pk_bf16(va[0] - bf_lo(hi.x), va[1] - bf_hi(hi.x)); lo.y = cvt_pk_bf16(va[2] - bf_lo(hi.y), va[3] - bf_hi(hi.y));
                lo.z = cvt_pk_bf16(vb[0] - bf_lo(hi.z), vb[1] - bf_hi(hi.z)); lo.w = cvt_pk_bf16(vb[2] - bf_lo(hi.w), vb[3] - bf_hi(hi.w));
                const bf16x8 whi = *(const LAS bf16x8*)(F.lds + N2_WHI + (ks * 64 + lane) * 16), wlo = *(const LAS bf16x8*)(F.lds + N2_WLO + (ks * 64 + lane) * 16);
                const bf16x8 thi = __builtin_bit_cast(bf16x8, hi), tlo = __builtin_bit_cast(bf16x8, lo);
                acc = __builtin_amdgcn_mfma_f32_16x16x32_bf16(whi, thi, acc, 0, 0, 0);
                acc = __builtin_amdgcn_mfma_f32_16x16x32_bf16(wlo, thi, acc, 0, 0, 0);
                acc = __builtin_amdgcn_mfma_f32_16x16x32_bf16(whi, tlo, acc, 0, 0, 0);
            }
        }
        ssq += __shfl_xor(ssq, 16); ssq += __shfl_xor(ssq, 32);
        const float rstd = 1.0f / sqrtf(ssq * (1.0f / D) + EPS);
        if (g == 0) RSTD[row] = rstd;
        f32x4 lg = acc * rstd;
        float mx = fmaxf(fmaxf(lg[0], lg[1]), fmaxf(lg[2], lg[3])); mx = fmaxf(mx, __shfl_xor(mx, 16)); mx = fmaxf(mx, __shfl_xor(mx, 32));
        f32x4 ex; ex[0] = __expf(lg[0] - mx); ex[1] = __expf(lg[1] - mx); ex[2] = __expf(lg[2] - mx); ex[3] = __expf(lg[3] - mx);
        float sum = (ex[0] + ex[1]) + (ex[2] + ex[3]); sum += __shfl_xor(sum, 16); sum += __shfl_xor(sum, 32);
        const float inv = 1.0f / sum;
        float* ap = AFF + ((size_t)(row >> 13) * NE + 4 * g) * T + (row & (T - 1));
#pragma unroll
        for (int r = 0; r < 4; ++r) ap[(size_t)r * T] = ex[r] * inv;
    }
    __syncthreads();
}
__device__ __forceinline__ void topk_phase(Frame& F0) {
    Frame F = F0; F.tid = fresh_v(F0.tid); F.lane = F.tid & 63; F.wave = fresh_s(F0.wave);
    const float* AFF = (const float*)(F.ws + WS_AFF); int* INV = (int*)(F.ws + WS_INV); int* SEL = (int*)(F.ws + WS_SEL); float* GATEV = (float*)(F.ws + WS_GATEV);
    const float* RSTD = (const float*)(F.ws + WS_RSTD); float* RSS = (float*)(F.ws + WS_RSS);
    LAS unsigned* hist = (LAS unsigned*)F.lds;
    LAS unsigned* suf = hist + 256;
    LAS unsigned* ctl = hist + 768;
    LAS unsigned* wtot = hist + 800;
    for (int task = F.vcu; task < BATCH * NE; task += F.G) {
        const int b = task >> 4, e = task & 15;
        const unsigned* src = (const unsigned*)(AFF + (size_t)task * T) + F.tid * 16;
        unsigned v[16];
#pragma unroll
        for (int q = 0; q < 4; ++q) { const u32x4 w = *((const u32x4*)src + q); v[4 * q] = w.x; v[4 * q + 1] = w.y; v[4 * q + 2] = w.z; v[4 * q + 3] = w.w; }
        unsigned prefix = 0, remaining = CAP;
#pragma unroll 1
        for (int pass = 0; pass < 4; ++pass) {
            const int shift = 24 - 8 * pass;
            if (F.tid < 256) hist[F.tid] = 0u;
            __syncthreads();
#pragma unroll
            for (int j = 0; j < 16; ++j) { const bool match = (pass == 0) || ((v[j] >> (shift + 8)) == prefix); if (match) atomicAdd((unsigned*)&hist[(v[j] >> shift) & 255u], 1u); }
            __syncthreads();
            if (F.tid < 256) suf[F.tid] = hist[F.tid];
            if (F.tid == 0) suf[256] = 0u;
            __syncthreads();
#pragma unroll 1
            for (int o = 1; o < 256; o <<= 1) { unsigned a = 0u; if (F.tid < 256) { a = suf[F.tid]; if (F.tid + o < 256) a += suf[F.tid + o]; } __syncthreads(); if (F.tid < 256) suf[F.tid] = a; __syncthreads(); }
            if (F.tid < 256) { const unsigned sd = suf[F.tid], sn = suf[F.tid + 1]; if (sd >= remaining && sn < remaining) { ctl[0] = (unsigned)F.tid; ctl[1] = remaining - sn; } }
            __syncthreads();
            prefix = (prefix << 8) | ctl[0]; remaining = ctl[1];
            __syncthreads();
        }
        const unsigned thr = prefix, need_eq = remaining, n_gt = CAP - remaining;
        unsigned cnt = 0u;
#pragma unroll
        for (int j = 0; j < 16; ++j) cnt += (v[j] > thr ? 1u : 0u) + (v[j] == thr ? 0x10000u : 0u);
        unsigned inc = cnt;
#pragma unroll
        for (int o = 1; o < 64; o <<= 1) { const unsigned t = __shfl_up(inc, o); if (F.lane >= o) inc += t; }
        if (F.lane == 63) wtot[F.wave] = inc;
        __syncthreads();
        unsigned base = 0u;
#pragma unroll
        for (int w = 0; w < NWAVES; ++w) base += (w < F.wave) ? wtot[w] : 0u;
        unsigned run = base + inc - cnt;
        unsigned rg = run & 0xffffu, re = run >> 16;
        const int tbase = F.tid * 16;
#pragma unroll
        for (int j = 0; j < 16; ++j) {
            const int t = tbase + j; int slot = -1;
            if (v[j] > thr) { slot = (int)rg; ++rg; }
            else if (v[j] == thr) { if (re < need_eq) slot = (int)(n_gt + re); ++re; }
            const int gt = b * T + t;
            INV[(size_t)gt * NE + e] = slot >= 0 ? b * CAP + slot : -1;
            if (slot >= 0) { const int sr = e * (BATCH * CAP) + b * CAP + slot; SEL[sr] = gt; GATEV[sr] = __uint_as_float(v[j]); RSS[sr] = RSTD[gt]; }
        }
        __syncthreads();
    }
}
template <bool FINAL>
__device__ __forceinline__ void combine_phase(Frame& F0, float* x  , const float* gain) {
    Frame F = F0; F.tid = fresh_v(F0.tid); F.lane = F.tid & 63; F.wave = fresh_s(F0.wave);
    const int* INV = (const int*)(F.ws + WS_INV); const unsigned char* YE = F.ws + WS_YE; bf16_t* H = (bf16_t*)(F.ws + WS_H); const float* GATEV = (const float*)(F.ws + WS_GATEV);
    const int gw = F.vcu * NWAVES + F.wave, NGW = F.G * NWAVES;
    f32x4 g[4];
#pragma unroll
    for (int j = 0; j < 4; ++j) g[j] = *((const f32x4*)gain + 64 * j + F.lane);
#pragma unroll 1
    for (int m = gw; m < M; m += NGW) {
        f32x4* xr = (f32x4*)(x + (size_t)m * D) + F.lane; f32x4 v[4];
        { const u32x2* x1r = (const u32x2*)((const bf16_t*)(F.ws + WS_MIX) + (size_t)m * D) + F.lane;
#pragma unroll
          for (int j = 0; j < 4; ++j) { const u32x2 w = x1r[64 * j]; v[j] = (f32x4){bf_lo(w.x), bf_hi(w.x), bf_lo(w.y), bf_hi(w.y)}; } }
        const int myinv = INV[(size_t)m * NE + (F.lane & 15)];
        unsigned long long mask = __ballot(myinv >= 0) & 0xffffull;
        while (mask) {
            const int e = __builtin_ctzll(mask); mask &= mask - 1;
            const int slot = __builtin_amdgcn_readlane(myinv, e);
            const float gvv = __hip_atomic_load(GATEV + (size_t)e * (BATCH * CAP) + slot, __ATOMIC_RELAXED, __HIP_MEMORY_SCOPE_AGENT) * (1.0f / YSCALE);
            const int* yr = (const int*)(YE + ((size_t)e * (BATCH * CAP) + slot) * D) + F.lane;
#pragma unroll
            for (int j = 0; j < 4; ++j) { const int w = yr[64 * j]; const f32x2 a = __builtin_amdgcn_cvt_pk_f32_fp8(w, false), c = __builtin_amdgcn_cvt_pk_f32_fp8(w, true);
                v[j][0] += gvv * a.x; v[j][1] += gvv * a.y; v[j][2] += gvv * c.x; v[j][3] += gvv * c.y; }
        }
        const float rstd = row_rstd(v);
        if (FINAL) {
#pragma unroll
            for (int j = 0; j < 4; ++j) xr[64 * j] = v[j] * rstd * g[j];
        } else {
            store_bf16_row((bf16_t*)x + (size_t)m * D, v, F.lane);
#pragma unroll
            for (int j = 0; j < 4; ++j) v[j] = v[j] * rstd * g[j];
            store_bf16_row(H + (size_t)m * D, v, F.lane);
        }
    }
}

constexpr int ATT_VROW = 160;
constexpr int ATT_VBYTES = 32 * ATT_VROW;
constexpr int ATT_SSQ_OFF = NWAVES * ATT_VBYTES;
constexpr int ATT_BIAS_OFF = ATT_SSQ_OFF + 2 * 8 * 256 * 4;
constexpr int ATT_BIAS_PADF = 32, ATT_BIAS_TAILF = 64;
typedef short v4i16_t __attribute__((ext_vector_type(4)));
__device__ __forceinline__ s16x4 vtr(const LAS unsigned char* p) { return __builtin_bit_cast(s16x4, __builtin_amdgcn_ds_read_tr16_b64_v4i16((LAS v4i16_t*)p)); }

template <bool NA>
__device__ __forceinline__ void attn_task(const bf16_t* __restrict__ qkv, bf16_t* __restrict__ mix, LAS unsigned char* lds, int lane, int wave,
                                          int b, int h, int mblk, int r, int grow, int cb) {
    const int i = lane & 15, g = lane >> 4;
    constexpr size_t TENS = (size_t)BATCH * 8 * T * 64;
    const bf16_t* qbase = qkv + (size_t)(NA ? 3 : 0) * TENS + ((size_t)(b * 8 + h) * T << 6) + 8 * g;
    const bf16_t* kbase = qbase + TENS;
    const int tl = NA ? ((grow & 3) * 64 + 16 * cb + i) : (16 * i + r);
    const int tq = 256 * mblk + tl;
    const bf16x8 Q0 = *(const bf16x8*)(qbase + ((size_t)tq << 6)), Q1 = *(const bf16x8*)(qbase + ((size_t)tq << 6) + 32);
    const int qrow = grow, qcol = 16 * cb + i;
    const int rs = min(max(qrow - 4, 0), 120), cs = min(max(qcol - 8, 0), 48), kc0 = min(max(16 * cb - 8, 0), 32);
    const LAS float* biasp = (const LAS float*)(lds + ATT_BIAS_OFF) + ATT_BIAS_PADF + ((h * 15 + (rs - qrow + 7)) * 31 + (kc0 - qcol + 15 + 4 * g));
    constexpr int NSTEP = NA ? 9 : 24;
    LAS unsigned char* vst = lds + wave * ATT_VBYTES + i * ATT_VROW + 16 * g;
    const LAS unsigned char* vrd = lds + wave * ATT_VBYTES + (4 * g + (i >> 2)) * ATT_VROW + (i & 3) * 8;
    bf16x8 K0[2][2], V0[2][2], K1[2][2], V1[2][2], K2[2][2], V2[2][2];
#define ATT_SEG(sidx, sl, sh, rp, Lm1, basepos) \
    if ((sidx) < 5) { sl = (sidx); sh = 4; rp = r; Lm1 = 511; basepos = 16 * mblk - 64; } \
    else if ((sidx) < 11) { sl = (sidx) - 5; sh = 2; rp = r & 3; Lm1 = 2047; basepos = 64 * mblk - 64; } \
    else { sl = (sidx) - 11; sh = 0; rp = 0; Lm1 = 8191; basepos = 256 * mblk - 64; }
#define ATT_LOAD(KB, VB, sidx) do { int sl_, sh_, rp_, Lm1_, bp_; if (!NA) { ATT_SEG(sidx, sl_, sh_, rp_, Lm1_, bp_) } \
        _Pragma("unroll") for (int T_ = 0; T_ < 2; ++T_) { int tok_; \
            if (NA) tok_ = min(rs + (sidx), 127) * 64 + kc0 + 16 * T_ + i; \
            else { const int pos_ = bp_ + 32 * sl_ + 16 * T_ + i; tok_ = (min(max(pos_, 0), Lm1_) << sh_) + rp_; } \
            const bf16_t* p_ = kbase + ((size_t)tok_ << 6); \
            KB[T_][0] = *(const bf16x8*)p_; KB[T_][1] = *(const bf16x8*)(p_ + 32); VB[T_][0] = *(const bf16x8*)(p_ + TENS); VB[T_][1] = *(const bf16x8*)(p_ + TENS + 32); } } while (0)
    f32x4 O[4];
#pragma unroll
    for (int n = 0; n < 4; ++n) O[n] = (f32x4){0.f, 0.f, 0.f, 0.f};
    float mrun = -1e30f, lrun = 0.f;
#define ATT_STEP(KB, VB, s) do { \
        _Pragma("unroll") for (int T_ = 0; T_ < 2; ++T_) { *(LAS bf16x8*)(vst + T_ * 16 * ATT_VROW) = VB[T_][0]; *(LAS bf16x8*)(vst + T_ * 16 * ATT_VROW + 64) = VB[T_][1]; } \
        f32x4 sc[2]; \
        _Pragma("unroll") for (int T_ = 0; T_ < 2; ++T_) { sc[T_] = __builtin_amdgcn_mfma_f32_16x16x32_bf16(KB[T_][0], Q0, (f32x4){0.f, 0.f, 0.f, 0.f}, 0, 0, 0); \
            sc[T_] = __builtin_amdgcn_mfma_f32_16x16x32_bf16(KB[T_][1], Q1, sc[T_], 0, 0, 0); } \
        ATT_LOAD(KB, VB, min((s) + 3, NSTEP - 1)); \
        int lo, span, x0; \
        if (NA) { lo = ((s) < 8) ? cs - kc0 - 4 * g : (1 << 20); span = 15; x0 = 0; } \
        else { int sl_, sh_, rp_, Lm1_, bp_; ATT_SEG(s, sl_, sh_, rp_, Lm1_, bp_) (void)rp_; \
            const int pq = tq >> sh_; \
            lo = max(pq - 64, 0) - bp_ - 4 * g; span = (min(pq + 64, Lm1_) - bp_ - 4 * g) - lo; x0 = 32 * sl_; } \
        float mloc = -INFINITY; \
        _Pragma("unroll") for (int T_ = 0; T_ < 2; ++T_) \
            _Pragma("unroll") for (int q = 0; q < 4; ++q) { const bool valid = (unsigned)(x0 + 16 * T_ + q - lo) <= (unsigned)span; \
                float v = sc[T_][q]; if (NA) v += biasp[(s) * 31 + 16 * T_ + q]; \
                v = valid ? v : -INFINITY; sc[T_][q] = v; mloc = fmaxf(mloc, v); } \
        mloc = fmaxf(mloc, __shfl_xor(mloc, 16)); mloc = fmaxf(mloc, __shfl_xor(mloc, 32)); \
        const float mnew = fmaxf(mrun, mloc), alpha = __builtin_amdgcn_exp2f(mrun - mnew); mrun = mnew; \
        float psum = 0.f; \
        _Pragma("unroll") for (int T_ = 0; T_ < 2; ++T_) \
            _Pragma("unroll") for (int q = 0; q < 4; ++q) { const float p = __builtin_amdgcn_exp2f(sc[T_][q] - mnew); sc[T_][q] = p; psum += p; } \
        lrun = lrun * alpha + psum; \
        _Pragma("unroll") for (int n = 0; n < 4; ++n) O[n] = O[n] * alpha; \
        u32x4 pw; pw.x = cvt_pk_bf16(sc[0][0], sc[0][1]); pw.y = cvt_pk_bf16(sc[0][2], sc[0][3]); pw.z = cvt_pk_bf16(sc[1][0], sc[1][1]); pw.w = cvt_pk_bf16(sc[1][2], sc[1][3]); \
        const bf16x8 Pf = __builtin_bit_cast(bf16x8, pw); \
        _Pragma("unroll") for (int n = 0; n < 4; ++n) { const s16x4 a = vtr(vrd + n * 32), c = vtr(vrd + 16 * ATT_VROW + n * 32); \
            const bf16x8 Vf = (bf16x8){a[0], a[1], a[2], a[3], c[0], c[1], c[2], c[3]}; \
            O[n] = __builtin_amdgcn_mfma_f32_16x16x32_bf16(Vf, Pf, O[n], 0, 0, 0); } \
    } while (0)
    ATT_LOAD(K0, V0, 0); ATT_LOAD(K1, V1, 1); ATT_LOAD(K2, V2, 2);
#pragma unroll 1
    for (int s = 0; s < NSTEP; s += 3) {
        ATT_STEP(K0, V0, s);
        ATT_STEP(K1, V1, s + 1);
        ATT_STEP(K2, V2, s + 2);
    }
#undef ATT_STEP
#undef ATT_LOAD
#undef ATT_SEG
    float lt = lrun; lt += __shfl_xor(lt, 16); lt += __shfl_xor(lt, 32);
    const float inv = 1.0f / lt;
    float ssq = 0.f;
    bf16_t* op = mix + ((size_t)b * T + tq) * D + (NA ? 512 : 0) + h * 64 + 4 * g;
#pragma unroll
    for (int n = 0; n < 4; ++n) { const f32x4 o = O[n] * inv; ssq += (o[0] * o[0] + o[1] * o[1]) + (o[2] * o[2] + o[3] * o[3]);
        u32x2 w; w.x = cvt_pk_bf16(o[0], o[1]); w.y = cvt_pk_bf16(o[2], o[3]); *(u32x2*)(op + 16 * n) = w; }
    (void)ssq; (void)tl;
}

constexpr int NA_BIAS_OFF = MISC_OFF + 64;
constexpr int DU_NK = 256, DU_KB = DU_NK * 128, DU_BUF = 2 * DU_KB;
struct DUnit { int sh, res, Lm1, P0, type; };
__device__ __forceinline__ DUnit du_decode(int q, int u) {
    DUnit d;
    if (u < 16) { d.type = 0; d.sh = 4; d.res = 4 * q + (u >> 2); d.Lm1 = 511; d.P0 = 128 * (u & 3); }
    else if (u < 32) { d.type = 1; d.sh = 2; d.res = q; d.Lm1 = 2047; d.P0 = 128 * (u - 16); }
    else { d.type = 2; d.sh = 0; d.res = 0; d.Lm1 = 8191; d.P0 = 128 * (16 * q + (u - 32)); }
    return d;
}
__device__ __forceinline__ void attn_units_phase(Frame& F0, int l) {
    Frame F = F0; F.tid = fresh_v(F0.tid); F.lane = F.tid & 63; F.wave = fresh_s(F0.wave);
    constexpr size_t TENS = (size_t)BATCH * 8 * T * 64;
    const bf16_t* qkv = (const bf16_t*)(F.ws + WS_QKV); bf16_t* mix = (bf16_t*)(F.ws + WS_MIX);
    bf16_t* partA = (bf16_t*)(F.ws + WS_PARTA); bf16_t* partB = (bf16_t*)(F.ws + WS_PARTB); float* lsep = (float*)(F.ws + WS_LSEP);
    const int lane = F.lane, w = F.wave, i = lane & 15, g = lane >> 4;
    for (int c = F.vcu; c < 256; c += F.G) {
        const int bh = c >> 2, q = c & 3, b = bh >> 3, h = bh & 7;
        const bf16_t* qb = qkv + ((size_t)(b * 8 + h) * T << 6);
        const bf16_t* kb = qb + TENS;
        const __amdgpu_buffer_rsrc_t rKV = __builtin_amdgcn_make_buffer_rsrc((void*)kb, 0, 0xffffffff, 0x00020000);
        const int fK = (i >> 1) & 7;
        const int kof0 = i * 128 + ((g ^ fK) << 4), kof1 = i * 128 + (((4 + g) ^ fK) << 4);
        const int fV = ((2 * g + (i >> 3)) & 3) << 1;
        int vof[4];
#pragma unroll
        for (int n = 0; n < 4; ++n) vof[n] = (4 * g + (i >> 2)) * 128 + (((2 * n + ((i & 3) >> 1)) ^ fV) << 4) + (i & 1) * 8;
#define DU_ISSUE(u_, bufb_) do { const DUnit d_ = du_decode(q, (u_)); \
        _Pragma("unroll") for (int k_ = 0; k_ < 4; ++k_) { const int row_ = 32 * w + 8 * k_ + (lane >> 3); \
            const int pos_ = min(max(d_.P0 - 64 + row_, 0), d_.Lm1); const size_t tok_ = (size_t)((pos_ << d_.sh) + d_.res); \
            const int cK_ = (lane & 7) ^ ((row_ >> 1) & 7), cV_ = (lane & 7) ^ (((row_ >> 1) & 3) << 1); \
            __builtin_amdgcn_raw_ptr_buffer_load_lds(rKV, (LAS unsigned*)(F.lds + (bufb_) + (32 * w + 8 * k_) * 128), 16, (unsigned)(tok_ << 7) + (unsigned)(cK_ * 16), 0, 0, 0); \
            __builtin_amdgcn_raw_ptr_buffer_load_lds(rKV, (LAS unsigned*)(F.lds + (bufb_) + DU_KB + (32 * w + 8 * k_) * 128), 16, (unsigned)(tok_ << 7) + (unsigned)(cV_ * 16), (unsigned)(TENS * 2), 0, 0); } } while (0)
#define DU_QLOAD(u_, Qa, Qb) do { const DUnit d_ = du_decode(q, (u_)); const size_t tq_ = (size_t)(((d_.P0 + 16 * w + i) << d_.sh) + d_.res); \
        Qa = *(const bf16x8*)(qb + (tq_ << 6) + 8 * g); Qb = *(const bf16x8*)(qb + (tq_ << 6) + 8 * g + 32); } while (0)
        bf16x8 Qn0, Qn1;
        __syncthreads();
        DU_ISSUE(0, 0); DU_QLOAD(0, Qn0, Qn1);
#pragma unroll 1
        for (int u = 0; u < 48; ++u) {
            const bf16x8 Q0 = Qn0, Q1 = Qn1;
            if (u == 0) VM_WAIT(); else asm volatile("s_waitcnt vmcnt(5)" ::: "memory");
            asm volatile("" ::: "memory"); __builtin_amdgcn_s_barrier(); asm volatile("" ::: "memory");
            const int bufb = (u & 1) * DU_BUF;
            if (u + 1 < 48) { DU_ISSUE(u + 1, DU_BUF - bufb); DU_QLOAD(u + 1, Qn0, Qn1); }
            const DUnit d = du_decode(q, u);
            const LAS unsigned char* Kb = F.lds + bufb; const LAS unsigned char* Vb = Kb + DU_KB;
            const int lo = max(i, 64 - d.P0 - 16 * w) - 4 * g, span = min(i + 128, d.Lm1 + 64 - d.P0 - 16 * w) - 4 * g - lo;
            f32x4 sc[9];
#pragma unroll
            for (int t_ = 0; t_ < 9; ++t_) { const int rb = 16 * w + 16 * t_;
                const bf16x8 k0 = *(const LAS bf16x8*)(Kb + rb * 128 + kof0), k1 = *(const LAS bf16x8*)(Kb + rb * 128 + kof1);
                sc[t_] = __builtin_amdgcn_mfma_f32_16x16x32_bf16(k0, Q0, (f32x4){0.f, 0.f, 0.f, 0.f}, 0, 0, 0);
                sc[t_] = __builtin_amdgcn_mfma_f32_16x16x32_bf16(k1, Q1, sc[t_], 0, 0, 0); }
            float mrow = -INFINITY;
#pragma unroll
            for (int t_ = 0; t_ < 9; ++t_)
#pragma unroll
                for (int r_ = 0; r_ < 4; ++r_) { const bool valid = (unsigned)(16 * t_ + r_ - lo) <= (unsigned)span;
                    const float v = valid ? sc[t_][r_] : -INFINITY; sc[t_][r_] = v; mrow = fmaxf(mrow, v); }
            mrow = fmaxf(mrow, __shfl_xor(mrow, 16)); mrow = fmaxf(mrow, __shfl_xor(mrow, 32));
            float lt = 0.f;
#pragma unroll
            for (int t_ = 0; t_ < 9; ++t_)
#pragma unroll
                for (int r_ = 0; r_ < 4; ++r_) { const float p = __builtin_amdgcn_exp2f(sc[t_][r_] - mrow); sc[t_][r_] = p; lt += p; }
            f32x4 O[4];
#pragma unroll
            for (int n = 0; n < 4; ++n) O[n] = (f32x4){0.f, 0.f, 0.f, 0.f};
            unsigned vad[4];
#pragma unroll
            for (int n = 0; n < 4; ++n) vad[n] = (unsigned)(__SIZE_TYPE__)(Vb + (16 * w) * 128 + vof[n]);
            s16x4 va[2][4], vc[2][4];
#define DU_VTR(dst, ad, off) asm volatile("ds_read_b64_tr_b16 %0, %1 offset:%2" : "=v"(dst) : "v"(ad), "n"(off))
#define DU_VISSUE(s_) do { _Pragma("unroll") for (int n = 0; n < 4; ++n) { DU_VTR(va[(s_) & 1][n], vad[n], (s_) * 4096); DU_VTR(vc[(s_) & 1][n], vad[n], ((s_) < 4 ? (s_) * 4096 + 2048 : (s_) * 4096)); } } while (0)
            __builtin_amdgcn_sched_barrier(0);
            DU_VISSUE(0);
#pragma unroll
            for (int s = 0; s < 5; ++s) {
                u32x4 pw; pw.x = cvt_pk_bf16(sc[2 * s][0], sc[2 * s][1]); pw.y = cvt_pk_bf16(sc[2 * s][2], sc[2 * s][3]);
                if (s < 4) { pw.z = cvt_pk_bf16(sc[2 * s + 1][0], sc[2 * s + 1][1]); pw.w = cvt_pk_bf16(sc[2 * s + 1][2], sc[2 * s + 1][3]); } else { pw.z = 0u; pw.w = 0u; }
                const bf16x8 Pf = __builtin_bit_cast(bf16x8, pw);
                if (s < 4) { DU_VISSUE(s + 1);
                    asm volatile("s_waitcnt lgkmcnt(8)" : "+v"(va[s & 1][0]), "+v"(va[s & 1][1]), "+v"(va[s & 1][2]), "+v"(va[s & 1][3]), "+v"(vc[s & 1][0]), "+v"(vc[s & 1][1]), "+v"(vc[s & 1][2]), "+v"(vc[s & 1][3])); }
                else asm volatile("s_waitcnt lgkmcnt(0)" : "+v"(va[s & 1][0]), "+v"(va[s & 1][1]), "+v"(va[s & 1][2]), "+v"(va[s & 1][3]), "+v"(vc[s & 1][0]), "+v"(vc[s & 1][1]), "+v"(vc[s & 1][2]), "+v"(vc[s & 1][3]));
#pragma unroll
                for (int n = 0; n < 4; ++n) { const s16x4 a = va[s & 1][n], cc = vc[s & 1][n];
                    const bf16x8 Vf = (bf16x8){a[0], a[1], a[2], a[3], cc[0], cc[1], cc[2], cc[3]};
                    O[n] = __builtin_amdgcn_mfma_f32_16x16x32_bf16(Vf, Pf, O[n], 0, 0, 0); }
                __builtin_amdgcn_sched_barrier(0);
            }
#undef DU_VTR
#undef DU_VISSUE
            lt += __shfl_xor(lt, 16); lt += __shfl_xor(lt, 32);
            const float inv = 1.0f / lt; const float mrun = mrow;
            const size_t tokq = (size_t)b * T + (size_t)(((d.P0 + 16 * w + i) << d.sh) + d.res);
            bf16_t* op = (d.type == 0 ? partA + tokq * 512 : d.type == 1 ? partB + tokq * 512 : mix + tokq * D) + h * 64 + 4 * g;
#pragma unroll
            for (int n = 0; n < 4; ++n) { const f32x4 o = O[n] * inv; u32x2 ww; ww.x = cvt_pk_bf16(o[0], o[1]); ww.y = cvt_pk_bf16(o[2], o[3]); *(u32x2*)(op + 16 * n) = ww; }
            if (g == 0) lsep[((size_t)d.type * M + tokq) * 8 + h] = mrun + __builtin_amdgcn_logf(lt);
        }
#undef DU_ISSUE
#undef DU_QLOAD
    }
    __syncthreads();
    { CArgs* ka = kargs(); const float* rpb = ka->in[5] + (size_t)l * 8 * 15 * 31; LAS float* bias = (LAS float*)(F.lds + NA_BIAS_OFF);
      for (int idx = F.tid; idx < ATT_BIAS_PADF + 8 * 15 * 31 + ATT_BIAS_TAILF; idx += NTHREADS) { const int j = idx - ATT_BIAS_PADF; bias[idx] = (j >= 0 && j < 8 * 15 * 31) ? rpb[j] * LOG2E : 0.f; } }
    for (int c = F.vcu; c < 256; c += F.G) {
        const int b = c >> 5, h = (c >> 2) & 7, cb = c & 3, kc0 = min(max(16 * cb - 8, 0), 32);
        const bf16_t* qb = qkv + 3 * TENS + ((size_t)(b * 8 + h) * T << 6);
        const bf16_t* kb = qb + TENS;
        const int fK = (i >> 1) & 7, kof0 = i * 128 + ((g ^ fK) << 4), kof1 = i * 128 + (((4 + g) ^ fK) << 4);
        const int fV = ((2 * g + (i >> 3)) & 3) << 1;
        int vof[4];
#pragma unroll
        for (int n = 0; n < 4; ++n) vof[n] = (4 * g + (i >> 2)) * 128 + (((2 * n + ((i & 3) >> 1)) ^ fV) << 4) + (i & 1) * 8;
        const int pkk = (F.tid >> 3) & 31, pc = F.tid & 7, pr = F.tid >> 8;
        u32x4 st[8];
#define NA_FETCH(row0_, nrow_) do { _Pragma("unroll") for (int k_ = 0; k_ < 8; ++k_) { const int ro_ = 2 * (k_ & 3) + pr; const int kr_ = min((row0_) + ro_, 127); \
            st[k_] = *(const u32x4*)(kb + (size_t)(k_ >> 2) * TENS + ((size_t)(kr_ * 64 + kc0 + pkk) << 6) + pc * 8); } } while (0)
#define NA_STORE(row0_, nrow_) do { _Pragma("unroll") for (int k_ = 0; k_ < 8; ++k_) { const int ro_ = 2 * (k_ & 3) + pr; if (ro_ < (nrow_)) { const int R_ = (((row0_) + ro_) & 15) * 32 + pkk; \
            const int f_ = (k_ >> 2) ? (((R_ >> 1) & 3) << 1) : ((R_ >> 1) & 7); \
            *(LAS u32x4*)(F.lds + (k_ >> 2) * 65536 + R_ * 128 + ((pc ^ f_) << 4)) = st[k_]; } } } while (0)
        __syncthreads();
        NA_FETCH(0, 8); NA_STORE(0, 8); NA_FETCH(8, 3); NA_STORE(8, 3);
        bf16x8 Qn0, Qn1;
        { const size_t tq0 = (size_t)(w * 64 + 16 * cb + i); Qn0 = *(const bf16x8*)(qb + (tq0 << 6) + 8 * g); Qn1 = *(const bf16x8*)(qb + (tq0 << 6) + 8 * g + 32); }
        __syncthreads();
#pragma unroll 1
        for (int j = 0; j < 16; ++j) {
            const int hi_cur = min(8 * j + 10, 127), hi_nxt = min(8 * j + 18, 127), nnew = (j < 15) ? hi_nxt - hi_cur : 0;
            if (nnew > 0) NA_FETCH(hi_cur + 1, nnew);
            const int qrow = 8 * j + w, qcol = 16 * cb + i, rs = min(max(qrow - 4, 0), 120), cs = min(max(qcol - 8, 0), 48);
            const size_t tq = (size_t)(qrow * 64 + qcol);
            const bf16x8 Q0 = Qn0, Q1 = Qn1;
            { const int qn = min(8 * (j + 1) + w, 127); const size_t tqn = (size_t)(qn * 64 + qcol); Qn0 = *(const bf16x8*)(qb + (tqn << 6) + 8 * g); Qn1 = *(const bf16x8*)(qb + (tqn << 6) + 8 * g + 32); }
            const LAS float* biasp = (const LAS float*)(F.lds + NA_BIAS_OFF) + ATT_BIAS_PADF + ((h * 15 + (rs - qrow + 7)) * 31 + (kc0 - qcol + 15 + 4 * g));
            const int lo = cs - kc0 - 4 * g;
            f32x4 sc[16];
#pragma unroll
            for (int s = 0; s < 8; ++s) { const int R0 = ((rs + s) & 15) * 32;
#pragma unroll
                for (int T_ = 0; T_ < 2; ++T_) { const bf16x8 k0 = *(const LAS bf16x8*)(F.lds + (R0 + 16 * T_) * 128 + kof0), k1 = *(const LAS bf16x8*)(F.lds + (R0 + 16 * T_) * 128 + kof1);
                    sc[2 * s + T_] = __builtin_amdgcn_mfma_f32_16x16x32_bf16(k0, Q0, (f32x4){0.f, 0.f, 0.f, 0.f}, 0, 0, 0);
                    sc[2 * s + T_] = __builtin_amdgcn_mfma_f32_16x16x32_bf16(k1, Q1, sc[2 * s + T_], 0, 0, 0); } }
            bool first[4]; int boff[4];
#pragma unroll
            for (int r_ = 0; r_ < 4; ++r_) { first[r_] = r_ >= lo; boff[r_] = first[r_] ? r_ : 16 + r_; }
            float w[8][4]; float mrow = -INFINITY;
#pragma unroll
            for (int s = 0; s < 8; ++s)
#pragma unroll
                for (int r_ = 0; r_ < 4; ++r_) { const float v = (first[r_] ? sc[2 * s][r_] : sc[2 * s + 1][r_]) + biasp[s * 31 + boff[r_]]; w[s][r_] = v; mrow = fmaxf(mrow, v); }
            mrow = fmaxf(mrow, __shfl_xor(mrow, 16)); mrow = fmaxf(mrow, __shfl_xor(mrow, 32));
            float lt = 0.f;
#pragma unroll
            for (int s = 0; s < 8; ++s)
#pragma unroll
                for (int r_ = 0; r_ < 4; ++r_) { const float p = __builtin_amdgcn_exp2f(w[s][r_] - mrow); lt += p; sc[2 * s][r_] = first[r_] ? p : 0.f; sc[2 * s + 1][r_] = first[r_] ? 0.f : p; }
            f32x4 O[4];
#pragma unroll
            for (int n = 0; n < 4; ++n) O[n] = (f32x4){0.f, 0.f, 0.f, 0.f};
#pragma unroll
            for (int s = 0; s < 8; ++s) { const int R0 = ((rs + s) & 15) * 32;
                u32x4 pw; pw.x = cvt_pk_bf16(sc[2 * s][0], sc[2 * s][1]); pw.y = cvt_pk_bf16(sc[2 * s][2], sc[2 * s][3]); pw.z = cvt_pk_bf16(sc[2 * s + 1][0], sc[2 * s + 1][1]); pw.w = cvt_pk_bf16(sc[2 * s + 1][2], sc[2 * s + 1][3]);
                const bf16x8 Pf = __builtin_bit_cast(bf16x8, pw);
#pragma unroll
                for (int n = 0; n < 4; ++n) { const s16x4 a = vtr(F.lds + 65536 + R0 * 128 + vof[n]), cc = vtr(F.lds + 65536 + (R0 + 16) * 128 + vof[n]);
                    const bf16x8 Vf = (bf16x8){a[0], a[1], a[2], a[3], cc[0], cc[1], cc[2], cc[3]};
                    O[n] = __builtin_amdgcn_mfma_f32_16x16x32_bf16(Vf, Pf, O[n], 0, 0, 0); }
            }
            lt += __shfl_xor(lt, 16); lt += __shfl_xor(lt, 32);
            const float inv = 1.0f / lt;
            bf16_t* op = mix + ((size_t)b * T + tq) * D + 512 + h * 64 + 4 * g;
#pragma unroll
            for (int n = 0; n < 4; ++n) { const f32x4 o = O[n] * inv; u32x2 ww; ww.x = cvt_pk_bf16(o[0], o[1]); ww.y = cvt_pk_bf16(o[2], o[3]); *(u32x2*)(op + 16 * n) = ww; }
            __syncthreads();
            if (nnew > 0) NA_STORE(hi_cur + 1, nnew);
            __syncthreads();
        }
#undef NA_FETCH
#undef NA_STORE
    }
}
__device__ __forceinline__ void attn_merge_phase(Frame& F0, int l) {
    Frame F = F0; F.tid = fresh_v(F0.tid); F.lane = F.tid & 63; F.wave = fresh_s(F0.wave);
    bf16_t* mix = (bf16_t*)(F.ws + WS_MIX); const bf16_t* partA = (const bf16_t*)(F.ws + WS_PARTA); const bf16_t* partB = (const bf16_t*)(F.ws + WS_PARTB); const float* lsep = (const float*)(F.ws + WS_LSEP);
    CArgs* ka = kargs();
    const float* gd = ka->in[3] + (size_t)l * 512; const float* gn = ka->in[4] + (size_t)l * 512;
    const int lane = F.lane; const bool dil = lane < 32;
    f32x4 gg[4];
    { const float* gp = dil ? gd + 16 * lane : gn + 16 * (lane - 32);
#pragma unroll
      for (int j = 0; j < 4; ++j) gg[j] = *(const f32x4*)(gp + 4 * j); }
    const int gw = F.vcu * NWAVES + F.wave, NGW = F.G * NWAVES;
#pragma unroll 1
    for (int m = gw; m < M; m += NGW) {
        u32x4* p = (u32x4*)(mix + (size_t)m * D + 16 * lane);
        const u32x4 c0 = p[0], c1 = p[1];
        const int l5 = lane & 31;
        const u32x4 a0 = *(const u32x4*)(partA + (size_t)m * 512 + 16 * l5), a1 = *(const u32x4*)(partA + (size_t)m * 512 + 16 * l5 + 8);
        const u32x4 b0 = *(const u32x4*)(partB + (size_t)m * 512 + 16 * l5), b1 = *(const u32x4*)(partB + (size_t)m * 512 + 16 * l5 + 8);
        const int hh = l5 >> 2;
        const float la = lsep[((size_t)0 * M + m) * 8 + hh], lb = lsep[((size_t)1 * M + m) * 8 + hh], lc = lsep[((size_t)2 * M + m) * 8 + hh];
        const float mx = fmaxf(fmaxf(la, lb), lc);
        float wa = __builtin_amdgcn_exp2f(la - mx), wb = __builtin_amdgcn_exp2f(lb - mx), wc = __builtin_amdgcn_exp2f(lc - mx);
        const float wi = 1.0f / (wa + wb + wc); wa *= wi; wb *= wi; wc *= wi;
        if (!dil) { wa = 0.f; wb = 0.f; wc = 1.f; }
        const unsigned cw[8] = {c0.x, c0.y, c0.z, c0.w, c1.x, c1.y, c1.z, c1.w}, aw[8] = {a0.x, a0.y, a0.z, a0.w, a1.x, a1.y, a1.z, a1.w}, bw[8] = {b0.x, b0.y, b0.z, b0.w, b1.x, b1.y, b1.z, b1.w};
        float o[16]; float ssq = 0.f;
#pragma unroll
        for (int k = 0; k < 8; ++k) { o[2 * k] = wa * bf_lo(aw[k]) + wb * bf_lo(bw[k]) + wc * bf_lo(cw[k]); o[2 * k + 1] = wa * bf_hi(aw[k]) + wb * bf_hi(bw[k]) + wc * bf_hi(cw[k]);
            ssq += o[2 * k] * o[2 * k] + o[2 * k + 1] * o[2 * k + 1]; }
#pragma unroll
        for (int of = 1; of < 32; of <<= 1) ssq += __shfl_xor(ssq, of);
        const float rstd = 1.0f / sqrtf(ssq * (1.0f / 512.0f) + EPS);
        unsigned ow[8];
#pragma unroll
        for (int k = 0; k < 8; ++k) ow[k] = cvt_pk_bf16(o[2 * k] * rstd * gg[k >> 1][(k & 1) * 2], o[2 * k + 1] * rstd * gg[k >> 1][(k & 1) * 2 + 1]);
        p[0] = (u32x4){ow[0], ow[1], ow[2], ow[3]}; p[1] = (u32x4){ow[4], ow[5], ow[6], ow[7]};
    }
}

__global__ void __launch_bounds__(NTHREADS, 2) mk_fwd(Args args) {
    extern __shared__ __attribute__((aligned(16))) unsigned char lds_raw[];
    Frame F;
    F.lds = (LAS unsigned char*)lds_raw;
    F.tid = threadIdx.x; F.lane = F.tid & 63; F.wave = __builtin_amdgcn_readfirstlane(F.tid >> 6);
    F.G = gridDim.x; { const int bx = blockIdx.x; F.vcu = (F.G % 8 == 0) ? (bx % 8) * (F.G / 8) + bx / 8 : bx; }
    F.out = args.out; F.ws = args.ws;
    volatile LAS unsigned* MISC = (volatile LAS unsigned*)(F.lds + MISC_OFF);
    if (F.tid < 16) MISC[F.tid] = 0u;
    __syncthreads();
    XcdBarrier bar; bar.bar = (unsigned*)(F.ws + WS_CTL) + CW_BAR; bar.x = 0; bar.st = nullptr;
    if (MK_N_LAUNCHES == 1) bar = xcd_barrier_post((unsigned*)(F.ws + WS_CTL) + CW_BAR, MISC + 8);
    const int lo = args.ph_lo, hi = args.ph_hi;
    const bool hostdn = (F.G == 256);
#define IN(k) (lo <= (k) && (k) < hi)
#ifdef PROBE_PHASE
    unsigned long long pr_last = __builtin_amdgcn_s_memrealtime(), pr_acc = 0ull;
#define SEAM(k) do { if (IN(k) && IN((k) + 1)) xcd_barrier(bar); { const unsigned long long now_ = __builtin_amdgcn_s_memrealtime(); const int ty_ = (k) == 0 ? 0 : 1 + ((k) - 1) % 9; if (ty_ == PROBE_PHASE) pr_acc += now_ - pr_last; pr_last = now_; } } while (0)
#else
#define SEAM(k) do { if (IN(k) && IN((k) + 1)) xcd_barrier(bar); } while (0)
#endif
#ifndef GPH
#define GPH 0
#endif
#ifndef GPROBE_AMP
#define GPROBE_AMP 1
#endif
    unsigned long long gp_acc = 0ull, gp_dummy = 0ull; (void)gp_dummy;
    bf16_t* H = (bf16_t*)(F.ws + WS_H); bf16_t* QKV = (bf16_t*)(F.ws + WS_QKV); bf16_t* MIX = (bf16_t*)(F.ws + WS_MIX);
    bf16_t* ACT = (bf16_t*)(F.ws + WS_ACT); bf16_t* YE = (bf16_t*)(F.ws + WS_YE);

    if (IN(0)) {
#if PM & 1
        conv_weights(F, 0, hostdn ? 2 : 1);
#endif
#if PM & 2
        rope_table(F);
#endif
#if PM & 4
        norm1_phase(F, KIN(0), KIN(1));
#endif
    }
    SEAM(0);
#pragma unroll 1
    for (int l = 0; l < 2; ++l) {
        const int pb = 1 + 9 * l;
#if PM & 8
        if (IN(pb + 0)) {
            gm::StaticOrder S; S.init(M, NQKV, F.G, (int)blockIdx.x);
            gm::ASrc A{(const char*)H, nullptr, D, nullptr}; gm::BSrc B{(const char*)(F.ws + WS_WIN), 31, 0};
            gm::EpiQKV E{QKV, (const float*)(F.ws + WS_ROPE)};
            gm::gemm_phase<gm::EpiQKV, false, false>(F.lds, A, B, S, E, GPH == 1 ? gp_acc : gp_dummy);
        }
#endif
        SEAM(pb + 0);
#if PM & 16
        if (IN(pb + 1)) attn_units_phase(F, l);
#endif
        SEAM(pb + 1);
#if PM & 16
        if (IN(pb + 2)) attn_merge_phase(F, l);
#endif
        SEAM(pb + 2);
#if PM & 32
        if (IN(pb + 3)) {
            gm::StaticOrder S; S.init(M, D, F.G, (int)blockIdx.x);
            gm::ASrc A{(const char*)MIX, nullptr, D, nullptr}; gm::BSrc B{(const char*)(F.ws + WS_WOUT), 31, 0};
            gm::EpiBf16Out E{(bf16_t*)(F.ws + WS_PARTA)};
            gm::gemm_phase<gm::EpiBf16Out, false, false>(F.lds, A, B, S, E, GPH == 2 ? gp_acc : gp_dummy);
        }
#endif
        SEAM(pb + 3);
#if PM & 64
        if (IN(pb + 4)) { if (l == 0) norm2_router_phase<false>(F, (const void*)KIN(0), MIX, KIN(7), KIN(8)); else norm2_router_phase<true>(F, (const void*)F.out, MIX, KIN(7) + D, KIN(8) + (size_t)D * NE); }
#endif
        SEAM(pb + 4);
#if PM & 128
        if (IN(pb + 5)) topk_phase(F);
#endif
        SEAM(pb + 5);
#if PM & 256
        if (IN(pb + 6)) {
            gm::StaticOrder S; S.init(MS, 2 * FF, F.G, (int)blockIdx.x);
            gm::ASrc A{(const char*)H, (const int*)(F.ws + WS_SEL), D, (const float*)(F.ws + WS_RSS)}; gm::BSrc B{(const char*)(F.ws + WS_WGU + (size_t)l * WGU_BYTES), 5, (size_t)2 * FF * D};
            const int cvstep = F.G * NWAVES, cvn = (CV_ITEMS + cvstep - 1) / cvstep, nun = ((MS / 256) * (2 * FF / 256)) / F.G;
            const bool h1 = (l == 0 && cvn <= nun);
            gm::EpiSwiGLU E{(unsigned char*)ACT, F.ws, h1 ? cvn : 0, (l == 0 && hostdn) ? 11 : 0, 22, F.vcu * NWAVES + F.wave, cvstep};
            gm::gemm_phase<gm::EpiSwiGLU, true, true>(F.lds, A, B, S, E, GPH == 3 ? gp_acc : gp_dummy);
        }
#endif
        SEAM(pb + 6);
#if PM & 512
        if (IN(pb + 7)) {
            gm::StaticOrder S; S.init(MS, D, F.G, (int)blockIdx.x);
            gm::ASrc A{(const char*)ACT, nullptr, FF, nullptr}; gm::BSrc B{(const char*)(F.ws + WS_WD + (size_t)l * WD_BYTES), 5, (size_t)D * FF};
            gm::EpiDown E{(unsigned char*)YE, (const float*)(F.ws + WS_GATEV)};
            gm::gemm_phase<gm::EpiDown, true, true>(F.lds, A, B, S, E, GPH == 4 ? gp_acc : gp_dummy);
        }
#endif
        SEAM(pb + 7);
#if PM & 1024
        if (IN(pb + 8)) {
            if (l == 0) { const int cvstep = F.G * NWAVES, cvn = (CV_ITEMS + cvstep - 1) / cvstep, nun = ((MS / 256) * (2 * FF / 256)) / F.G;
                conv_weights(F, 1, (cvn <= nun) ? 0 : 1); combine_phase<false>(F, F.out, KIN(1) + D); }
            else combine_phase<true>(F, F.out, KIN(12));
        }
#endif
        if (l == 0) SEAM(pb + 8);
    }
#if GPROBE
    { const unsigned long long t0_ = __builtin_amdgcn_s_memrealtime(); while (__builtin_amdgcn_s_memrealtime() - t0_ < gp_acc * GPROBE_AMP) __builtin_amdgcn_s_sleep(8); }
#endif
#ifdef PROBE_PHASE
    { const unsigned long long now_ = __builtin_amdgcn_s_memrealtime(); if (PROBE_PHASE == 9) pr_acc += now_ - pr_last;
      const unsigned long long t0_ = __builtin_amdgcn_s_memrealtime(); while (__builtin_amdgcn_s_memrealtime() - t0_ < pr_acc * PROBE_AMP) __builtin_amdgcn_s_sleep(8); }
#endif
#undef IN
#undef SEAM
}

extern "C" void kernel_launch(void* const* d_in, const int* in_sizes, int n_in, void* d_out, int out_size, void* d_ws, size_t ws_size, hipStream_t stream) {
    static int grid = 0;
    if (grid == 0) {
        if (n_in != 13 || in_sizes[0] != M * D || out_size != M * D || ws_size < WS_END) {
            fprintf(stderr, "kernel_launch: unexpected problem (n_in %d, in0 %d, out %d, ws %zu < %zu); nothing launched\n", n_in, n_in > 0 ? in_sizes[0] : -1, out_size, ws_size, (size_t)WS_END); grid = -1; return; }
        int dev = 0, cus = 0, per_cu = 0;
        if (hipGetDevice(&dev) != hipSuccess || hipDeviceGetAttribute(&cus, hipDeviceAttributeMultiprocessorCount, dev) != hipSuccess) { grid = -1; return; }
        if (hipFuncSetAttribute((const void*)mk_fwd, hipFuncAttributeMaxDynamicSharedMemorySize, LDS_BYTES) != hipSuccess) { fprintf(stderr, "kernel_launch: hipFuncSetAttribute failed\n"); grid = -1; return; }
        if (hipOccupancyMaxActiveBlocksPerMultiprocessor(&per_cu, (const void*)mk_fwd, NTHREADS, LDS_BYTES) != hipSuccess || per_cu < 1) {
            fprintf(stderr, "kernel_launch: occupancy query reports %d workgroups per CU; nothing launched\n", per_cu); (void)hipGetLastError(); grid = -1; return; }
        grid = cus;
    }
    if (grid < 0) return;
    (void)hipMemsetAsync((char*)d_ws + WS_CTL, 0, CTL_BYTES, stream);
    Args a{};
    for (int i = 0; i < 13; ++i) a.in[i] = (const float*)d_in[i];
    a.out = (float*)d_out; a.ws = (unsigned char*)d_ws;
    if (MK_N_LAUNCHES == 1) {
        a.ph_lo = 0; a.ph_hi = NPH; a.li = 0;
        hipLaunchKernelGGL(mk_fwd, dim3(grid), dim3(NTHREADS), LDS_BYTES, stream, a);
    } else {
        for (int p = 0; p < NPH; ++p) { a.ph_lo = p; a.ph_hi = p + 1; a.li = p; hipLaunchKernelGGL(mk_fwd, dim3(grid), dim3(NTHREADS), LDS_BYTES, stream, a); }
    }
    const hipError_t le = hipPeekAtLastError();
    if (le != hipSuccess) fprintf(stderr, "kernel_launch: launch failed: %s\n", hipGetErrorName(le));
}
```

```cpp
#include <hip/hip_runtime.h>
#include <cstdio>
#include <cstdint>

#ifndef PM
#define PM 0xffff
#endif
#ifndef MK_N_LAUNCHES
#define MK_N_LAUNCHES 1
#endif

#define GAS __attribute__((address_space(1)))
#define LAS __attribute__((address_space(3)))
typedef unsigned short bf16_t;
typedef short bf16x8 __attribute__((ext_vector_type(8)));
typedef short s16x4 __attribute__((ext_vector_type(4)));
typedef float f32x4 __attribute__((ext_vector_type(4)));
typedef float f32x2 __attribute__((ext_vector_type(2)));
typedef unsigned u32x4 __attribute__((ext_vector_type(4)));
typedef unsigned u32x2 __attribute__((ext_vector_type(2)));
typedef int i32x4 __attribute__((ext_vector_type(4)));
typedef int v8i32 __attribute__((ext_vector_type(8)));
typedef GAS unsigned gu32;

constexpr int D = 1024, BATCH = 8, T = 8192, M = BATCH * T, NQKV = 3072, NE = 16, FF = 2816, CAP = 1024, MS = NE * BATCH * CAP;
constexpr int NWAVES = 8, NTHREADS = 512;
constexpr float EPS = 1e-6f;
constexpr float LOG2E = 1.4426950408889634f;
constexpr float QSCALE = 0.125f * LOG2E;
constexpr int NPH = 19;

constexpr size_t MiB = 1u << 20;
constexpr size_t WS_CTL = 0, CTL_BYTES = 1 * MiB;
constexpr size_t WS_ROPE = 2 * MiB;
constexpr size_t WS_AFF = 4 * MiB;
constexpr size_t WS_INV = 8 * MiB;
constexpr size_t WS_SEL = 12 * MiB;
constexpr size_t WS_GATEV = 12 * MiB + 512 * 1024;
constexpr size_t WS_RSTD = 13 * MiB;
constexpr size_t WS_RSTDQ = 13 * MiB + 256 * 1024;
constexpr size_t WS_RSS = 13 * MiB + 512 * 1024;
constexpr size_t WS_WIN = 16 * MiB;
constexpr size_t WS_WOUT = 22 * MiB;
constexpr size_t WS_WGU = 24 * MiB;
constexpr size_t WS_WD = 200 * MiB;
constexpr size_t WGU_BYTES = 88 * MiB, WD_BYTES = 44 * MiB;
constexpr size_t WS_H = 288 * MiB;
constexpr size_t WS_ACT = 416 * MiB;
constexpr size_t WS_QKV = 416 * MiB;
constexpr size_t WS_MIX = 800 * MiB;
constexpr size_t WS_YE = 1120 * MiB;
constexpr size_t WS_END = 1376 * MiB;
constexpr size_t WS_PARTA = 928 * MiB, WS_PARTB = 992 * MiB, WS_LSEP = 1056 * MiB;
constexpr size_t WS_SSQN = WS_LSEP + 8 * MiB;
constexpr size_t WS_RNS = WS_LSEP + 12 * MiB, WS_RAT = WS_LSEP + 13 * MiB;
constexpr int CW_BAR = 4096;

constexpr int RING_BYTES = 131072;
constexpr int MISC_OFF = RING_BYTES;
constexpr int GOFF_OFF = MISC_OFF + 64;
constexpr int LDS_BYTES = 147456;

#define LDS_WAIT() asm volatile("s_waitcnt lgkmcnt(0)" ::: "memory")
#define VM_WAIT() asm volatile("s_waitcnt vmcnt(0)" ::: "memory")
__device__ __forceinline__ unsigned cvt_pk_bf16(float lo, float hi) { unsigned r; asm volatile("v_cvt_pk_bf16_f32 %0, %1, %2" : "=v"(r) : "v"(lo), "v"(hi)); return r; }
constexpr float YSCALE = 8.0f;
constexpr float WSCALE = 32.0f, WINV = 1.0f / 32.0f;
__device__ __forceinline__ unsigned pk4_fp8(float a, float b, float c, float d) { int w = __builtin_amdgcn_cvt_pk_fp8_f32(a, b, 0, false); w = __builtin_amdgcn_cvt_pk_fp8_f32(c, d, w, true); return (unsigned)w; }
__device__ __forceinline__ float bf_lo(unsigned w) { return __uint_as_float(w << 16); }
__device__ __forceinline__ float bf_hi(unsigned w) { return __uint_as_float(w & 0xffff0000u); }
__device__ __forceinline__ int fresh_v(int v) { asm volatile("" : "+v"(v)); return v; }
__device__ __forceinline__ int fresh_s(int v) { asm volatile("" : "+s"(v)); return v; }
__device__ __forceinline__ float wave_sum(float v) {
#pragma unroll
    for (int o = 1; o < 64; o <<= 1) v += __shfl_xor(v, o);
    return v;
}

#define XB_TMO      128
#define XB_XCNT(j)  (256  + 64 * (j))
#define XB_XSUB(j)  (1280 + 64 * (j))
#define XB_XGEN(j)  (2304 + 64 * (j))
#define XB_TOP      3328
#define XB_TOPGEN   3392
#define XCD_BAR_WORDS 3456
#define XB_SPIN_CAP (1u << 18)
__device__ __forceinline__ unsigned xb_ld(unsigned* p)              { return __hip_atomic_load(p, __ATOMIC_RELAXED, __HIP_MEMORY_SCOPE_AGENT); }
__device__ __forceinline__ unsigned xb_add(unsigned* p, unsigned v) { return __hip_atomic_fetch_add(p, v, __ATOMIC_RELAXED, __HIP_MEMORY_SCOPE_AGENT); }
__device__ __forceinline__ unsigned xb_xcc_id() { return (unsigned)__builtin_amdgcn_s_getreg((3 << 11) | 20) & 0xFu; }
#define XB_SPIN(cond, bar) do { unsigned _sp = 0; while (cond) { __builtin_amdgcn_s_sleep(1); \
    if ((++_sp & 255u) == 0u) { if (xb_ld(&(bar)[XB_TMO])) break; if (_sp > XB_SPIN_CAP) { atomicAdd(&(bar)[XB_TMO], 1u); break; } } } } while (0)
struct XcdBarrier { unsigned* bar; unsigned x; volatile LAS unsigned* st; };
__device__ __forceinline__ XcdBarrier xcd_barrier_post(unsigned* bar, volatile LAS unsigned* st) {
    XcdBarrier b; b.bar = bar; b.x = xb_xcc_id(); b.st = st;
    if (threadIdx.x == 0) (void)xb_add(&bar[XB_XCNT(b.x)], 1u);
    return b;
}
__device__ __forceinline__ void xcd_barrier_complete(unsigned* bar, unsigned x, unsigned& nloc, unsigned& nx) {
    const unsigned G = gridDim.x * gridDim.y * gridDim.z;
    unsigned sum, cnt, mine, sp = 0u;
    for (;;) {
        sum = 0u; cnt = 0u; mine = 0u;
#pragma unroll
        for (unsigned j = 0; j < 16; ++j) { const unsigned c = xb_ld(&bar[XB_XCNT(j)]); sum += c; cnt += (c > 0u) ? 1u : 0u; mine = (j == x) ? c : mine; }
        if (sum == G) break;
        __builtin_amdgcn_s_sleep(1);
        if ((++sp & 255u) == 0u) { if (xb_ld(&bar[XB_TMO])) break; if (sp > XB_SPIN_CAP) { atomicAdd(&bar[XB_TMO], 1u); break; } }
    }
    nloc = mine > 0u ? mine : 1u; nx = cnt > 0u ? cnt : 1u;
}
__device__ __forceinline__ void xcd_barrier(const XcdBarrier& b) {
    asm volatile("s_waitcnt vmcnt(0)" ::: "memory");
    __syncthreads();
    if (threadIdx.x == 0) {
        unsigned* bar = b.bar;
        __builtin_amdgcn_s_waitcnt(0);
        unsigned nloc = b.st[0], nx = b.st[1];
        if (nloc == 0u) { xcd_barrier_complete(bar, b.x, nloc, nx); b.st[0] = nloc; b.st[1] = nx; }
        const unsigned old = xb_add(&bar[XB_XSUB(b.x)], 1u);
        const unsigned gen = old / nloc;
        if (old + 1u == (gen + 1u) * nloc) {
            __builtin_amdgcn_fence(__ATOMIC_RELEASE, "agent");
            asm volatile("s_waitcnt vmcnt(0)" ::: "memory");
            const unsigned og = xb_add(&bar[XB_TOP], 1u);
            const unsigned tg = og / nx;
            if (og + 1u == (tg + 1u) * nx) xb_add(&bar[XB_TOPGEN], 1u);
            else XB_SPIN(xb_ld(&bar[XB_TOPGEN]) == tg, bar);
            __builtin_amdgcn_fence(__ATOMIC_ACQUIRE, "agent");
            xb_add(&bar[XB_XGEN(b.x)], 1u);
            asm volatile("s_waitcnt vmcnt(0)" ::: "memory");
        } else {
            XB_SPIN(xb_ld(&bar[XB_XGEN(b.x)]) == gen, bar);
            __builtin_amdgcn_fence(__ATOMIC_ACQUIRE, "agent");
            asm volatile("s_waitcnt vmcnt(0)" ::: "memory");
        }
    }
    __syncthreads();
}

struct Args { const float* in[13]; float* out; unsigned char* ws; int ph_lo, ph_hi, li, pad; };
typedef __attribute__((address_space(4))) const Args CArgs;
__device__ __forceinline__ CArgs* kargs() { CArgs* p = (CArgs*)__builtin_amdgcn_kernarg_segment_ptr(); asm volatile("" : "+s"(p)); return p; }
#define KIN(k) (kargs()->in[k])

constexpr int CV_IGE = (D / 64) * (FF / 32), CV_IDE = (FF / 64) * (D / 32);
constexpr int CV_ITEMS = NE * (2 * CV_IGE + CV_IDE);
struct CvDesc { const float* W; unsigned char* WT; int N, K, rowb; };
__device__ __forceinline__ CvDesc cv_desc(unsigned char* ws, int l, int g) {
    CArgs* ka = kargs(); CvDesc d; int r = g < CV_ITEMS ? g : CV_ITEMS - 1;
    if (r < 2 * NE * CV_IGE) { const int aux = r >= NE * CV_IGE ? 1 : 0; r -= aux * NE * CV_IGE; const int e = r / CV_IGE, it = r - e * CV_IGE, kb = it / (FF / 32), nb = it - kb * (FF / 32), n0 = 32 * nb;
        d.W = (aux ? ka->in[10] : ka->in[9]) + (size_t)l * NE * D * FF + (size_t)e * D * FF + (size_t)(64 * kb) * FF + n0; d.N = FF; d.K = D;
        d.WT = ws + WS_WGU + (size_t)l * WGU_BYTES + (size_t)e * 2 * FF * D + 64 * kb; d.rowb = (n0 >> 7) * 256 + aux * 128 + (n0 & 127); }
    else { r -= 2 * NE * CV_IGE; const int e = r / CV_IDE, it = r - e * CV_IDE, kb = it >> 5, nb = it & 31;
        d.W = ka->in[11] + (size_t)l * NE * FF * D + (size_t)e * FF * D + (size_t)(64 * kb) * D + 32 * nb; d.N = D; d.K = FF;
        d.WT = ws + WS_WD + (size_t)l * WD_BYTES + (size_t)e * D * FF + 64 * kb; d.rowb = 32 * nb; }
    return d;
}
__device__ __forceinline__ void cv_load(f32x4 (&cv)[8], const CvDesc& d, int lane) {
    const float* p = d.W + (size_t)(4 * (lane >> 3)) * d.N + 4 * (lane & 7);
#pragma unroll
    for (int tt = 0; tt < 2; ++tt)
#pragma unroll
        for (int kk = 0; kk < 4; ++kk) cv[4 * tt + kk] = *(const f32x4*)(p + (size_t)(32 * tt + kk) * d.N);
}
__device__ __forceinline__ void cv_store(const f32x4 (&cv)[8], const CvDesc& d, int lane) {
    unsigned char* q = d.WT + (size_t)(d.rowb + 4 * (lane & 7)) * d.K + 4 * (lane >> 3);
#pragma unroll
    for (int tt = 0; tt < 2; ++tt)
#pragma unroll
        for (int j = 0; j < 4; ++j)
            *(unsigned*)(q + (size_t)j * d.K + 32 * tt) = pk4_fp8(cv[4 * tt][j] * WSCALE, cv[4 * tt + 1][j] * WSCALE, cv[4 * tt + 2][j] * WSCALE, cv[4 * tt + 3][j] * WSCALE);
}
template <bool B> struct BoolC { static constexpr bool value = B; };
namespace gm {
constexpr int BM = 256, BK = 64, HALF = 128, HTB = HALF * BK * 2, STAGE_BYTES = 8 * HTB, NXCD = 8, WGM = 8;
__host__ __device__ __forceinline__ int lds_byte(int r, int c) { const int st = (r >> 4) * 2 + (c >> 5), rr = r & 15, cc = c & 31, ob = rr * 64 + cc * 2; return st * 1024 + (ob ^ (((ob >> 9) & 1) << 5)); }
__host__ __device__ __forceinline__ void stage_rc(int b, int& R, int& C) { const int st = b / 1024, sb = b % 1024, swz = sb ^ (((sb >> 9) & 1) << 5); R = (st >> 1) * 16 + swz / 64; C = (st & 1) * 32 + (swz % 64) / 2; }
__host__ __device__ __forceinline__ int sig2(int x) { return ((x & 1) << 1) | (x >> 1); }
__host__ __device__ __forceinline__ int perm32(int rho) { const int n = rho >> 4, i = rho & 15; return 8 * sig2(i >> 2) + 4 * n + (i & 3); }
struct Unit { int pm, pn; };
struct StaticOrder {
    int nM, nN, nwg, G, c;
    __device__ void init(int Mr, int N, int G_, int c_) { nM = Mr / BM; nN = N / BM; nwg = nM * nN; G = G_; c = c_; }
    __device__ bool next(int i, Unit& u) const {
        const long L = (long)i * G + c; if (L >= nwg) return false;
        int wgid = (int)L; { const int q = nwg / NXCD, r = nwg % NXCD, xcd = wgid % NXCD, off = wgid / NXCD; wgid = (xcd < r ? xcd * (q + 1) : r * (q + 1) + (xcd - r) * q) + off; }
        const int nig = WGM * nN, gid = wgid / nig, fm = gid * WGM, gsz = (nM - fm) < WGM ? (nM - fm) : WGM;
        u.pm = fm + ((wgid % nig) % gsz); u.pn = (wgid % nig) / gsz; return true;
    }
};
struct ASrc { const char* base; const int* sel; int K; const float* rss; const float* rss2; };
struct BSrc { const char* base; int eshift; size_t estride; };

template <class Epi, bool GATHER, bool FP8>
#ifndef GPROBE
#define GPROBE 0
#endif
__device__ __forceinline__ void gemm_phase(LAS unsigned char* lds, const ASrc A, const BSrc B, const StaticOrder& S, const Epi& E, unsigned long long& gp_acc) {
    unsigned long long gp_t = 0ull; (void)gp_t; (void)gp_acc;
    const int tid = fresh_v(threadIdx.x), wid = __builtin_amdgcn_readfirstlane(tid >> 6), lane = tid & 63, wr = wid >> 2, wc = wid & 3, fr = lane & 15, fq = lane >> 4;
    const int K = A.K, KB = FP8 ? K : 2 * K, nt = KB / (BK * 2);
    unsigned voffA0, voffA1, voffB0, voffB1;
    { int R0, R1, C0, C1; stage_rc(tid * 16, R0, C0); stage_rc(tid * 16 + 8192, R1, C1);
      const int Rb0 = Epi::PERM2 ? ((R0 >> 5) * 64 + perm32(R0 & 31)) : Epi::PERM ? ((R0 & ~31) + perm32(R0 & 31)) : R0, Rb1 = Epi::PERM2 ? ((R1 >> 5) * 64 + perm32(R1 & 31)) : Epi::PERM ? ((R1 & ~31) + perm32(R1 & 31)) : R1;
      voffA0 = (unsigned)(R0 * KB + C0 * 2); voffA1 = (unsigned)(R1 * KB + C1 * 2); voffB0 = (unsigned)(Rb0 * KB + C0 * 2); voffB1 = (unsigned)(Rb1 * KB + C1 * 2); }
    const unsigned kstep = (unsigned)(BK * 2);
    const unsigned hstep = (unsigned)HALF * (unsigned)KB;
    const unsigned tstep = 2u * hstep;
    const unsigned hstepB = Epi::PERM2 ? 32u * (unsigned)KB : hstep;
    const unsigned ldsw = (unsigned)wid * 1024u;
    const int aoff = lds_byte(wr * 64 + fr, fq * 8), boff = lds_byte(wc * 32 + fr, fq * 8);
    const __amdgpu_buffer_rsrc_t rA = __builtin_amdgcn_make_buffer_rsrc((void*)A.base, 0, 0xffffffff, 0x00020000);
    const __amdgpu_buffer_rsrc_t rB = __builtin_amdgcn_make_buffer_rsrc((void*)B.base, 0, 0xffffffff, 0x00020000);
#define G_SA(b, h) (((b) * 2 + (h)) * HTB)
#define G_SB(b, h) ((4 + (b) * 2 + (h)) * HTB)
#define G_LDS2(bufoff, rs, so, o0, o1) do { \
        __builtin_amdgcn_raw_ptr_buffer_load_lds(rs, (LAS unsigned*)(lds + (bufoff) + ldsw), 16, (o0), (so), 0, 0); \
        __builtin_amdgcn_raw_ptr_buffer_load_lds(rs, (LAS unsigned*)(lds + (bufoff) + ldsw + 8192), 16, (o1), (so), 0, 0); } while (0)
#define G_STB(bufoff, so) G_LDS2(bufoff, rB, so, voffB0, voffB1)
#define G_STA(bufoff, DSO, GSO, g0, g1) do { if constexpr (GATHER) { G_LDS2(bufoff, rA, GSO, g0, g1); } else { G_LDS2(bufoff, rA, DSO, voffA0, voffA1); } } while (0)
#define G_RD8(p) __builtin_shufflevector(*(const LAS i32x4*)(p), *(const LAS i32x4*)((p) + 1024), 0, 1, 2, 3, 4, 5, 6, 7)
#define G_LDA(dst, b, h) do { if constexpr (FP8) { _Pragma("unroll") for (int m = 0; m < 4; ++m) dst##8[m] = G_RD8(lds + G_SA(b, h) + aoff + m * 2048); } \
        else { _Pragma("unroll") for (int m = 0; m < 4; ++m) _Pragma("unroll") for (int k = 0; k < 2; ++k) dst[m][k] = *(const LAS bf16x8*)(lds + G_SA(b, h) + aoff + m * 2048 + k * 1024); } } while (0)
#define G_LDB(dst, b, h) do { if constexpr (FP8) { _Pragma("unroll") for (int n = 0; n < 2; ++n) dst##8[n] = G_RD8(lds + G_SB(b, h) + boff + n * 2048); } \
        else { _Pragma("unroll") for (int n = 0; n < 2; ++n) _Pragma("unroll") for (int k = 0; k < 2; ++k) dst[n][k] = *(const LAS bf16x8*)(lds + G_SB(b, h) + boff + n * 2048 + k * 1024); } } while (0)
#define G_MMA(ai, bj, At, Bt) do { __builtin_amdgcn_s_setprio(1); _Pragma("unroll") for (int m = 0; m < 4; ++m) _Pragma("unroll") for (int n = 0; n < 2; ++n) { \
        if constexpr (FP8) acc[ai][bj][m][n] = __builtin_amdgcn_mfma_scale_f32_16x16x128_f8f6f4(Bt##8[n], At##8[m], acc[ai][bj][m][n], 0, 0, 0, 0, 0, 0); \
        else { _Pragma("unroll") for (int k = 0; k < 2; ++k) acc[ai][bj][m][n] = __builtin_amdgcn_mfma_f32_16x16x32_bf16(Bt[n][k], At[m][k], acc[ai][bj][m][n], 0, 0, 0); } } \
        __builtin_amdgcn_s_setprio(0); } while (0)
#define G_WAIT_V(n) asm volatile("s_waitcnt vmcnt(" #n ")" ::: "memory")
#define G_WAIT_L(n) asm volatile("s_waitcnt lgkmcnt(" #n ")" ::: "memory")
#define G_WAIT_V8F() do { if (fresh) { if (Epi::HOST && hprev) asm volatile("s_waitcnt vmcnt(%0)" :: "n"(8 + Epi::NST + 8) : "memory"); else asm volatile("s_waitcnt vmcnt(%0)" :: "n"(8 + Epi::NST) : "memory"); } \
        else asm volatile("s_waitcnt vmcnt(8)" ::: "memory"); } while (0)
#define G_BAR __builtin_amdgcn_s_barrier()
#define G_SCHED __builtin_amdgcn_sched_barrier(0)
#define G_ROWS(u, v00, v01, v10, v11) do { const int rb_ = (u).pm * BM; const unsigned kb_ = (unsigned)KB; int r0_, c0_, r1_, c1_; { const int tz_ = fresh_v(tid); stage_rc(tz_ * 16, r0_, c0_); stage_rc(tz_ * 16 + 8192, r1_, c1_); } \
        if (A.sel) { v00 = (unsigned)A.sel[rb_ + r0_] * kb_ + (unsigned)c0_ * 2u; v01 = (unsigned)A.sel[rb_ + r1_] * kb_ + (unsigned)c1_ * 2u; \
        v10 = (unsigned)A.sel[rb_ + HALF + r0_] * kb_ + (unsigned)c0_ * 2u; v11 = (unsigned)A.sel[rb_ + HALF + r1_] * kb_ + (unsigned)c1_ * 2u; } \
        else { v00 = (unsigned)(rb_ + r0_) * kb_ + (unsigned)c0_ * 2u; v01 = (unsigned)(rb_ + r1_) * kb_ + (unsigned)c1_ * 2u; \
        v10 = (unsigned)(rb_ + HALF + r0_) * kb_ + (unsigned)c0_ * 2u; v11 = (unsigned)(rb_ + HALF + r1_) * kb_ + (unsigned)c1_ * 2u; } \
        asm volatile("" : "+v"(v00), "+v"(v01), "+v"(v10), "+v"(v11)); } while (0)
#define G_BOFF(u) ((unsigned)((u).pm >> B.eshift) * (unsigned)B.estride + (unsigned)(u).pn * tstep)
    Unit cur, nxt; int ui = 0; bool fresh = false, hprev = false;
    if (!S.next(0, cur)) return;
    f32x4 acc[2][2][4][2];
#pragma unroll
    for (int a = 0; a < 2; ++a)
#pragma unroll
        for (int b = 0; b < 2; ++b)
#pragma unroll
            for (int m = 0; m < 4; ++m)
#pragma unroll
                for (int n = 0; n < 2; ++n) acc[a][b][m][n] = (f32x4){0.f, 0.f, 0.f, 0.f};
    bf16x8 At[4][2], B0[2][2], B1[2][2]; v8i32 At8[4], B08[2], B18[2];
    unsigned vC00 = 0, vC01 = 0, vC10 = 0, vC11 = 0;
    LAS u32x4* const gslot = (LAS u32x4*)(lds + GOFF_OFF) + tid;
    LAS float* const rstab = (LAS float*)(lds + GOFF_OFF + 8192);
    int rspar = 0;
    LAS float* const rstab2 = rstab + 2 * BM;
    if constexpr (Epi::NEED_RS) { if (tid < BM) { rstab[tid] = A.rss[cur.pm * BM + tid]; if constexpr (Epi::MIDT > 0) rstab2[tid] = A.rss2[cur.pm * BM + tid]; } }
    unsigned cA = (unsigned)cur.pm * tstep;
    unsigned cB = G_BOFF(cur);
    if constexpr (GATHER) { G_ROWS(cur, vC00, vC01, vC10, vC11); }
    G_STB(G_SB(0, 0), cB); G_STB(G_SB(0, 1), cB + hstepB); G_STA(G_SA(0, 0), cA, 0u, vC00, vC01); G_STA(G_SA(0, 1), cA + hstep, 0u, vC10, vC11);
    if (wr == 1) G_BAR;
    G_WAIT_V(2); G_BAR;
    G_STB(G_SB(1, 0), cB + kstep); G_STA(G_SA(1, 0), cA + kstep, kstep, vC00, vC01); G_STB(G_SB(1, 1), cB + hstepB + kstep);
    G_WAIT_V(6); G_BAR;
    for (;;) {
        const bool has_next = S.next(ui + 1, nxt);
        const unsigned nA = has_next ? (unsigned)nxt.pm * tstep : cA;
        const unsigned nB = has_next ? G_BOFF(nxt) : cB;
        if constexpr (GATHER) {
            unsigned n00 = vC00, n01 = vC01, n10 = vC10, n11 = vC11;
            if (has_next && nxt.pm != cur.pm) { G_ROWS(nxt, n00, n01, n10, n11);
                if constexpr (Epi::NEED_RS) { if (tid < BM) rstab[(rspar ^ 1) * BM + tid] = A.rss[nxt.pm * BM + tid]; } }
            *gslot = (u32x4){n00, n01, n10, n11};
        }
        float nrs_ = 0.f, nrs2_ = 0.f; bool nrsw_ = false;
        if constexpr (Epi::NEED_RS && !GATHER) { nrsw_ = has_next && nxt.pm != cur.pm && tid < BM; if (nrsw_) { nrs_ = A.rss[nxt.pm * BM + tid]; if constexpr (Epi::MIDT > 0) nrs2_ = A.rss2[nxt.pm * BM + tid]; } }
        if (GPROBE == 1 && ui > 0) gp_acc += __builtin_amdgcn_s_memrealtime() - gp_t;
#pragma unroll 1
        for (int t = 0; t < nt; t += 2) {
            if (GPROBE == 2 && ui > 0 && t == 0) gp_t = __builtin_amdgcn_s_memrealtime();
            if (GPROBE == 2 && ui > 0 && t == 2) gp_acc += __builtin_amdgcn_s_memrealtime() - gp_t;
            if (GPROBE == 3 && t == 2) gp_t = __builtin_amdgcn_s_memrealtime();
            if constexpr (Epi::MIDT > 0) { if (t == Epi::MIDT) {
#pragma unroll
                for (int a = 0; a < 2; ++a)
#pragma unroll
                    for (int m = 0; m < 4; ++m) { const float r_ = rstab2[rspar * BM + a * HALF + wr * 64 + m * 16 + fr];
#pragma unroll
                        for (int b = 0; b < 2; ++b)
#pragma unroll
                            for (int n = 0; n < 2; ++n) acc[a][b][m][n] = acc[a][b][m][n] * r_; } } }
            const bool last = (t == nt - 2);
            const unsigned a1 = cA + (unsigned)(t + 1) * kstep;
            const unsigned g1 = (unsigned)(t + 1) * kstep;
            const unsigned a2 = last ? nA : cA + (unsigned)(t + 2) * kstep; const unsigned b2 = last ? nB : cB + (unsigned)(t + 2) * kstep;
            const unsigned g2 = last ? 0u : (unsigned)(t + 2) * kstep;
            const unsigned a3 = a2 + kstep; const unsigned b3 = b2 + kstep; const unsigned g3 = g2 + kstep;
            G_LDB(B0, 0, 0); G_LDB(B1, 0, 1); G_SCHED; G_LDA(At, 0, 0); if (!fresh) G_STA(G_SA(1, 1), a1 + hstep, g1, vC10, vC11);
            if constexpr (GATHER) { if (last) { const u32x4 nv = *gslot; vC00 = nv.x; vC01 = nv.y; vC10 = nv.z; vC11 = nv.w; } }
            G_WAIT_V8F(); G_WAIT_L(0); G_BAR; G_MMA(0, 0, At, B0); G_MMA(0, 1, At, B1); G_BAR; G_SCHED;
            G_LDA(At, 0, 1); G_STB(G_SB(0, 0), b2); G_STB(G_SB(0, 1), b2 + hstepB); G_STA(G_SA(0, 0), a2, g2, vC00, vC01);
            G_WAIT_V8F(); G_WAIT_L(0); G_BAR; G_MMA(1, 0, At, B0); G_MMA(1, 1, At, B1); G_BAR; G_SCHED;
            G_LDB(B0, 1, 0); G_LDB(B1, 1, 1); G_SCHED; G_LDA(At, 1, 0); G_STA(G_SA(0, 1), a2 + hstep, g2, vC10, vC11);
            G_WAIT_V8F(); fresh = false; G_WAIT_L(0); G_BAR; G_MMA(0, 0, At, B0); G_MMA(0, 1, At, B1); G_BAR; G_SCHED;
            G_LDA(At, 1, 1); G_STB(G_SB(1, 0), b3); G_STB(G_SB(1, 1), b3 + hstepB); G_STA(G_SA(1, 0), a3, g3, vC00, vC01);
            G_WAIT_V(8); G_WAIT_L(0); G_BAR; G_MMA(1, 0, At, B0); G_MMA(1, 1, At, B1); G_BAR; G_SCHED;
        }
        if constexpr (Epi::NEED_RS && !GATHER) { if (nrsw_) { rstab[(rspar ^ 1) * BM + tid] = nrs_; if constexpr (Epi::MIDT > 0) rstab2[(rspar ^ 1) * BM + tid] = nrs2_; } }
        if (GPROBE == 3) gp_acc += __builtin_amdgcn_s_memrealtime() - gp_t;
        if (GPROBE == 1) gp_t = __builtin_amdgcn_s_memrealtime();
        G_STA(G_SA(1, 1), nA + kstep + hstep, kstep, vC10, vC11);
        if (wr == 0) G_BAR;
        f32x4 cvr[8]; bool hnow = false;
        int hl_ = 0, hj_ = 0;
        if constexpr (Epi::HOST) { hl_ = ui < E.hostn ? 1 : 0; hj_ = ui < E.hostn ? ui : ui - E.hostn + E.hostj0; }
        if constexpr (Epi::HOST) { hnow = ui < E.hostn + E.hostn0; if (hnow) { const CvDesc cd = cv_desc(E.ws, hl_, E.cvg0 + E.cvstep * hj_); cv_load(cvr, cd, lane); } }
        if constexpr (Epi::NEED_RS) E(acc, cur, wr, wc, fr, fq, rstab + rspar * BM); else E(acc, cur, wr, wc, fr, fq);
        if constexpr (Epi::HOST) { if (hnow) { const CvDesc cd = cv_desc(E.ws, hl_, E.cvg0 + E.cvstep * hj_); cv_store(cvr, cd, lane); } }
        if (!has_next) break;
        if constexpr (Epi::NEED_RS) { if (nxt.pm != cur.pm) rspar ^= 1; }
#pragma unroll
        for (int a = 0; a < 2; ++a)
#pragma unroll
            for (int b = 0; b < 2; ++b)
#pragma unroll
                for (int m = 0; m < 4; ++m)
#pragma unroll
                    for (int n = 0; n < 2; ++n) acc[a][b][m][n] = (f32x4){0.f, 0.f, 0.f, 0.f};
        cur = nxt; cA = nA; cB = nB; ++ui; fresh = true; hprev = hnow;
        if (wr == 1) G_BAR;
    }
    G_WAIT_V(0);
    G_BAR;
#undef G_SA
#undef G_SB
#undef G_LDS2
#undef G_STB
#undef G_STA
#undef G_LDA
#undef G_LDB
#undef G_MMA
#undef G_RD8
#undef G_WAIT_V
#undef G_WAIT_L
#undef G_WAIT_V8F
#undef G_BAR
#undef G_SCHED
#undef G_ROWS
#undef G_BOFF
}

struct EpiQKV {
    static constexpr bool NEED_RS = true; static constexpr bool PERM = true; static constexpr bool PERM2 = false; static constexpr int MIDT = 0; static constexpr bool HOST = false; static constexpr int NST = 16;
    bf16_t* O; const float* rope;
    __device__ __forceinline__ void operator()(const f32x4 (&acc)[2][2][4][2], const Unit& u, int wr, int wc, int fr, int fq, const LAS float* rst) const {
        const int row0 = u.pm * BM + wr * 64 + fr, col0 = u.pn * BM + wc * 32 + 8 * sig2(fq);
        const bool do_rope = u.pn < 4;
        const float sc = (u.pn < 2 || (u.pn >= 6 && u.pn < 8)) ? QSCALE : 1.0f;
        const int i0 = (wc & 1) * 16 + 4 * sig2(fq);
        f32x4 cs[2][4][2];
#pragma unroll
        for (int ai = 0; ai < 2; ++ai)
#pragma unroll
            for (int m = 0; m < 4; ++m) { cs[ai][m][0] = (f32x4){1.f, 0.f, 1.f, 0.f}; cs[ai][m][1] = cs[ai][m][0];
                if (do_rope) { const float* rp = rope + ((size_t)((row0 + ai * HALF + m * 16) & (T - 1)) * 32 + i0) * 2; cs[ai][m][0] = *(const f32x4*)rp; cs[ai][m][1] = *(const f32x4*)(rp + 4); } }
#pragma unroll
        for (int ai = 0; ai < 2; ++ai)
#pragma unroll
            for (int m = 0; m < 4; ++m) {
                const int row = row0 + ai * HALF + m * 16;
                const int bb = row >> 13, tt = row & (T - 1);
                const f32x4 cs0 = cs[ai][m][0], cs1 = cs[ai][m][1];
                const float scr_ = sc * rst[ai * HALF + wr * 64 + m * 16 + fr];
#pragma unroll
                for (int bj = 0; bj < 2; ++bj) {
                    f32x4 v0 = acc[ai][bj][m][0], v1 = acc[ai][bj][m][1];
                    if (do_rope) {
                        const f32x4 a = v0, b = v1;
                        v0[0] = a[0] * cs0[0] - a[1] * cs0[1]; v0[1] = a[1] * cs0[0] + a[0] * cs0[1];
                        v0[2] = a[2] * cs0[2] - a[3] * cs0[3]; v0[3] = a[3] * cs0[2] + a[2] * cs0[3];
                        v1[0] = b[0] * cs1[0] - b[1] * cs1[1]; v1[1] = b[1] * cs1[0] + b[0] * cs1[1];
                        v1[2] = b[2] * cs1[2] - b[3] * cs1[3]; v1[3] = b[3] * cs1[2] + b[2] * cs1[3];
                    }
                    v0 = v0 * scr_; v1 = v1 * scr_;
                    u32x4 w; w.x = cvt_pk_bf16(v0[0], v0[1]); w.y = cvt_pk_bf16(v0[2], v0[3]); w.z = cvt_pk_bf16(v1[0], v1[1]); w.w = cvt_pk_bf16(v1[2], v1[3]);
                    const int cc = col0 + bj * HALF;
                    *(u32x4*)(O + ((((size_t)((cc >> 9) * BATCH + bb) * 8 + ((cc >> 6) & 7)) * T + tt) << 6) + (cc & 63)) = w;
                }
            }
    }
};
struct EpiBf16Out {
    static constexpr bool NEED_RS = false; static constexpr bool PERM = true; static constexpr bool PERM2 = true; static constexpr int MIDT = 0; static constexpr bool HOST = false; static constexpr int NST = 16;
    bf16_t* O;
    __device__ __forceinline__ void operator()(const f32x4 (&acc)[2][2][4][2], const Unit& u, int wr, int wc, int fr, int fq) const {
        const bool hi = fr >= 8;
        const int row0 = u.pm * BM + wr * 64 + (fr & 7), col0 = u.pn * BM + wc * 64 + 8 * sig2(fq) + (hi ? 32 : 0);
#pragma unroll
        for (int ai = 0; ai < 2; ++ai)
#pragma unroll
            for (int m = 0; m < 4; ++m) { bf16_t* rowp = O + (size_t)(row0 + ai * HALF + m * 16) * D + col0;
                u32x4 wv[2];
#pragma unroll
                for (int bj = 0; bj < 2; ++bj) { const f32x4 v0 = acc[ai][bj][m][0], v1 = acc[ai][bj][m][1];
                    wv[bj].x = cvt_pk_bf16(v0[0], v0[1]); wv[bj].y = cvt_pk_bf16(v0[2], v0[3]); wv[bj].z = cvt_pk_bf16(v1[0], v1[1]); wv[bj].w = cvt_pk_bf16(v1[2], v1[3]); }
                u32x4 X, Y;
#pragma unroll
                for (int c = 0; c < 4; ++c) { const unsigned ra = (unsigned)__builtin_amdgcn_update_dpp(0, (int)wv[0][c], 0x128, 0xf, 0xf, false), rb = (unsigned)__builtin_amdgcn_update_dpp(0, (int)wv[1][c], 0x128, 0xf, 0xf, false);
                    X[c] = hi ? rb : wv[0][c]; Y[c] = hi ? wv[1][c] : ra; }
                *(u32x4*)rowp = X; *(u32x4*)(rowp + 8 * D) = Y; }
    }
};
template <bool RBF>
struct EpiX1 {
    static constexpr bool NEED_RS = true; static constexpr bool PERM = true; static constexpr bool PERM2 = true; static constexpr int MIDT = 8;
     static constexpr bool HOST = false; static constexpr int NST = 16;
    bf16_t* O; const void* resid;
    __device__ __forceinline__ void operator()(const f32x4 (&acc)[2][2][4][2], const Unit& u, int wr, int wc, int fr, int fq, const LAS float* rst) const {
        const bool hi = fr >= 8;
        const int row0 = u.pm * BM + wr * 64 + (fr & 7), col0 = u.pn * BM + wc * 64 + 8 * sig2(fq) + (hi ? 32 : 0);
        f32x4 xfA[4][2][2], xfB[4][2][2]; u32x4 xbA[4][2], xbB[4][2];
        u32x4 outA[4][2], outB[4][2];
#define X1_LOAD(ai_, xf_, xb_) do { _Pragma("unroll") for (int m = 0; m < 4; ++m) _Pragma("unroll") for (int y = 0; y < 2; ++y) { const size_t off_ = (size_t)(row0 + (ai_) * HALF + m * 16 + 8 * y) * D + col0; \
            if constexpr (RBF) xb_[m][y] = *(const u32x4*)((const bf16_t*)resid + off_); else { xf_[m][y][0] = *(const f32x4*)((const float*)resid + off_); xf_[m][y][1] = *(const f32x4*)((const float*)resid + off_ + 4); } } } while (0)
#define X1_PROC(ai_, xf_, xb_, out_) do { _Pragma("unroll") for (int m = 0; m < 4; ++m) { u32x4 wv[2]; const float rs_ = rst[(ai_) * HALF + wr * 64 + m * 16 + fr]; \
            _Pragma("unroll") for (int bj = 0; bj < 2; ++bj) { const f32x4 v0 = acc[ai_][bj][m][0] * rs_, v1 = acc[ai_][bj][m][1] * rs_; \
                wv[bj].x = cvt_pk_bf16(v0[0], v0[1]); wv[bj].y = cvt_pk_bf16(v0[2], v0[3]); wv[bj].z = cvt_pk_bf16(v1[0], v1[1]); wv[bj].w = cvt_pk_bf16(v1[2], v1[3]); } \
            u32x4 XY[2]; \
            _Pragma("unroll") for (int c = 0; c < 4; ++c) { const unsigned ra = (unsigned)__builtin_amdgcn_update_dpp(0, (int)wv[0][c], 0x128, 0xf, 0xf, false), rb = (unsigned)__builtin_amdgcn_update_dpp(0, (int)wv[1][c], 0x128, 0xf, 0xf, false); \
                XY[0][c] = hi ? rb : wv[0][c]; XY[1][c] = hi ? wv[1][c] : ra; } \
            _Pragma("unroll") for (int y = 0; y < 2; ++y) { f32x4 r0, r1; \
                if constexpr (RBF) { const u32x4 w = xb_[m][y]; r0 = (f32x4){bf_lo(w.x), bf_hi(w.x), bf_lo(w.y), bf_hi(w.y)}; r1 = (f32x4){bf_lo(w.z), bf_hi(w.z), bf_lo(w.w), bf_hi(w.w)}; } else { r0 = xf_[m][y][0]; r1 = xf_[m][y][1]; } \
                const u32x4 a = XY[y]; \
                out_[m][y].x = cvt_pk_bf16(r0[0] + bf_lo(a.x), r0[1] + bf_hi(a.x)); out_[m][y].y = cvt_pk_bf16(r0[2] + bf_lo(a.y), r0[3] + bf_hi(a.y)); \
                out_[m][y].z = cvt_pk_bf16(r1[0] + bf_lo(a.z), r1[1] + bf_hi(a.z)); out_[m][y].w = cvt_pk_bf16(r1[2] + bf_lo(a.w), r1[3] + bf_hi(a.w)); } } } while (0)
#define X1_STORE(ai_, out_) do { _Pragma("unroll") for (int m = 0; m < 4; ++m) { bf16_t* rowp = O + (size_t)(row0 + (ai_) * HALF + m * 16) * D + col0; *(u32x4*)rowp = out_[m][0]; *(u32x4*)(rowp + 8 * D) = out_[m][1]; } } while (0)
        X1_LOAD(0, xfA, xbA); __builtin_amdgcn_sched_barrier(0);
        X1_PROC(0, xfA, xbA, outA); __builtin_amdgcn_sched_barrier(0);
        X1_LOAD(1, xfB, xbB); __builtin_amdgcn_sched_barrier(0);
        X1_STORE(0, outA); __builtin_amdgcn_sched_barrier(0);
        X1_PROC(1, xfB, xbB, outB); __builtin_amdgcn_sched_barrier(0);
        X1_STORE(1, outB);
#undef X1_LOAD
#undef X1_PROC
#undef X1_STORE
    }
};
struct EpiResid {
    static constexpr bool NEED_RS = false; static constexpr bool PERM = false; static constexpr bool PERM2 = false; static constexpr int MIDT = 0; static constexpr bool HOST = false; static constexpr int NST = 0;
    const float* resid; float* out;
    __device__ __forceinline__ void operator()(const f32x4 (&acc)[2][2][4][2], const Unit& u, int wr, int wc, int fr, int fq) const {
        const int row0 = u.pm * BM + wr * 64 + fr, col0 = u.pn * BM + wc * 32 + 4 * fq;
#pragma unroll
        for (int ai = 0; ai < 2; ++ai)
#pragma unroll
            for (int m = 0; m < 4; ++m) { const size_t off = (size_t)(row0 + ai * HALF + m * 16) * D + col0;
#pragma unroll
                for (int bj = 0; bj < 2; ++bj)
#pragma unroll
                    for (int n = 0; n < 2; ++n) { const f32x4 r = *(const f32x4*)(resid + off + bj * HALF + n * 16); *(f32x4*)(out + off + bj * HALF + n * 16) = r + acc[ai][bj][m][n]; }
                if (m & 1) asm volatile("" ::: "memory"); }
    }
};
struct EpiSwiGLU {
    static constexpr bool NEED_RS = true; static constexpr bool PERM = true; static constexpr bool PERM2 = false; static constexpr int MIDT = 0; static constexpr bool HOST = true; static constexpr int NST = 4;
    unsigned char* O; unsigned char* ws; int hostn, hostn0, hostj0, cvg0, cvstep;
    __device__ __forceinline__ void operator()(const f32x4 (&acc)[2][2][4][2], const Unit& u, int wr, int wc, int fr, int fq, const LAS float* rst) const {
        const int hi = fq >> 1;
        const int row0 = u.pm * BM + wr * 64 + fr + 16 * hi, col0 = u.pn * HALF + wc * 32 + 8 * sig2(fq) - 8 * hi;
#pragma unroll
        for (int ai = 0; ai < 2; ++ai)
#pragma unroll
            for (int mp = 0; mp < 2; ++mp) {
                u32x2 w[2];
#pragma unroll
                for (int mm = 0; mm < 2; ++mm) { const int m = 2 * mp + mm;
                    const float rs = rst[ai * HALF + wr * 64 + m * 16 + fr], ce = rs * (-LOG2E * WINV), q = (WSCALE * WSCALE) * __builtin_amdgcn_rcpf(rs * rs);
                    float r[8];
                    const f32x2 ce2 = (f32x2){ce, ce}, q2 = (f32x2){q, q};
#pragma unroll
                    for (int n = 0; n < 2; ++n)
#pragma unroll
                        for (int jp = 0; jp < 2; ++jp) {
                            const f32x2 G2 = (f32x2){acc[ai][0][m][n][2 * jp], acc[ai][0][m][n][2 * jp + 1]}, U2 = (f32x2){acc[ai][1][m][n][2 * jp], acc[ai][1][m][n][2 * jp + 1]};
                            const f32x2 x2 = G2 * ce2;
                            const f32x2 e2 = (f32x2){__builtin_amdgcn_exp2f(x2[0]), __builtin_amdgcn_exp2f(x2[1])};
                            const f32x2 d2 = __builtin_elementwise_fma(e2, q2, q2);
                            const f32x2 r2 = (f32x2){__builtin_amdgcn_rcpf(d2[0]), __builtin_amdgcn_rcpf(d2[1])};
                            const f32x2 o2 = (G2 * U2) * r2;
                            r[n * 4 + 2 * jp] = o2[0]; r[n * 4 + 2 * jp + 1] = o2[1]; }
                    w[mm].x = pk4_fp8(r[0], r[1], r[2], r[3]); w[mm].y = pk4_fp8(r[4], r[5], r[6], r[7]); }
                const auto sx = __builtin_amdgcn_permlane32_swap(w[0].x, w[1].x, false, false), sy = __builtin_amdgcn_permlane32_swap(w[0].y, w[1].y, false, false);
                u32x4 v; v.x = sx[0]; v.y = sy[0]; v.z = sx[1]; v.w = sy[1];
                *(u32x4*)(O + (size_t)(row0 + ai * HALF + mp * 32) * FF + col0) = v;
            }
    }
};
struct EpiDown {
    static constexpr bool NEED_RS = false; static constexpr bool PERM = true; static constexpr bool PERM2 = false; static constexpr int MIDT = 0; static constexpr bool HOST = false; static constexpr int NST = 8;
    unsigned char* O; const float* gatev;
    __device__ __forceinline__ void operator()(const f32x4 (&acc)[2][2][4][2], const Unit& u, int wr, int wc, int fr, int fq) const {
        const int hi = fq >> 1;
        const int row0 = u.pm * BM + wr * 64 + fr + 16 * hi, col0 = u.pn * BM + wc * 32 + 8 * sig2(fq) - 8 * hi;
        const float gv = WINV * YSCALE;
#pragma unroll
        for (int ai = 0; ai < 2; ++ai)
#pragma unroll
            for (int mp = 0; mp < 2; ++mp) {
                unsigned char* rowp = O + (size_t)(row0 + ai * HALF + mp * 32) * D + col0;
#pragma unroll
                for (int bj = 0; bj < 2; ++bj) {
                    u32x2 w[2];
#pragma unroll
                    for (int mm = 0; mm < 2; ++mm) { const f32x4 v0 = acc[ai][bj][2 * mp + mm][0] * gv, v1 = acc[ai][bj][2 * mp + mm][1] * gv;
                        w[mm].x = pk4_fp8(v0[0], v0[1], v0[2], v0[3]); w[mm].y = pk4_fp8(v1[0], v1[1], v1[2], v1[3]); }
                    const auto sx = __builtin_amdgcn_permlane32_swap(w[0].x, w[1].x, false, false), sy = __builtin_amdgcn_permlane32_swap(w[0].y, w[1].y, false, false);
                    u32x4 v; v.x = sx[0]; v.y = sy[0]; v.z = sx[1]; v.w = sy[1];
                    *(u32x4*)(rowp + bj * HALF) = v; }
            }
    }
};
}

struct Frame {
    LAS unsigned char* lds;
    int tid, lane, wave, vcu, G;
    float* out; unsigned char* ws;
};
template <int MODE> __device__ __forceinline__ int dest_row(int n, int aux) {
    if (MODE == 1) return n < 1024 ? ((n & ~63) + 2 * (n & 31) + ((n >> 5) & 1)) : n;
    if (MODE == 2) return (n >> 7) * 256 + aux * 128 + (n & 127);
    return n;
}
template <int MODE> __device__ __forceinline__ void conv_item(const float* W, int K, int N, bf16_t* WT, int aux, LAS float* scr, int item, int lane, const float* kg) {
    const int nblk = N / 32, kb = item / nblk, nb = item - kb * nblk, k0 = 64 * kb, n0 = 32 * nb;
    f32x4 v[8];
#pragma unroll
    for (int it = 0; it < 8; ++it) { const int kk = 8 * it + (lane >> 3); v[it] = *(const f32x4*)(W + (size_t)(k0 + kk) * N + n0 + 4 * (lane & 7)); }
    if (kg) { float kv[8];
#pragma unroll
        for (int it = 0; it < 8; ++it) kv[it] = kg[k0 + 8 * it + (lane >> 3)];
        __builtin_amdgcn_sched_barrier(0);
#pragma unroll
        for (int it = 0; it < 8; ++it) v[it] = v[it] * kv[it]; }
#pragma unroll
    for (int it = 0; it < 8; ++it) { const int kk = 8 * it + (lane >> 3); LAS float* s = scr + kk * 33 + 4 * (lane & 7); s[0] = v[it][0]; s[1] = v[it][1]; s[2] = v[it][2]; s[3] = v[it][3]; }
    LDS_WAIT(); asm volatile("" ::: "memory");
    const int c = lane & 7;
#pragma unroll
    for (int j = 0; j < 4; ++j) { const int n = (lane >> 3) + 8 * j; const LAS float* s = scr + (8 * c) * 33 + n;
        u32x4 o; o.x = cvt_pk_bf16(s[0 * 33], s[1 * 33]); o.y = cvt_pk_bf16(s[2 * 33], s[3 * 33]); o.z = cvt_pk_bf16(s[4 * 33], s[5 * 33]); o.w = cvt_pk_bf16(s[6 * 33], s[7 * 33]);
        *(u32x4*)(WT + (size_t)dest_row<MODE>(n0 + n, aux) * K + k0 + 8 * c) = o; }
    LDS_WAIT(); asm volatile("" ::: "memory");
}
template <int MODE> __device__ __forceinline__ void conv_item8(const float* W, int K, int N, unsigned char* WT, int aux, LAS float* scr, int item, int lane) {
    const int nblk = N / 32, kb = item / nblk, nb = item - kb * nblk, k0 = 64 * kb, n0 = 32 * nb;
    f32x4 v[8];
#pragma unroll
    for (int it = 0; it < 8; ++it) { const int kk = 8 * it + (lane >> 3); v[it] = *(const f32x4*)(W + (size_t)(k0 + kk) * N + n0 + 4 * (lane & 7)); }
#pragma unroll
    for (int it = 0; it < 8; ++it) { const int kk = 8 * it + (lane >> 3); LAS float* s = scr + kk * 33 + 4 * (lane & 7); s[0] = v[it][0]; s[1] = v[it][1]; s[2] = v[it][2]; s[3] = v[it][3]; }
    LDS_WAIT(); asm volatile("" ::: "memory");
    const int c = lane & 3;
#pragma unroll
    for (int j = 0; j < 2; ++j) { const int n = (lane >> 2) + 16 * j; const LAS float* s = scr + (16 * c) * 33 + n;
        u32x4 o;
        o.x = pk4_fp8(s[0 * 33] * WSCALE, s[1 * 33] * WSCALE, s[2 * 33] * WSCALE, s[3 * 33] * WSCALE); o.y = pk4_fp8(s[4 * 33] * WSCALE, s[5 * 33] * WSCALE, s[6 * 33] * WSCALE, s[7 * 33] * WSCALE);
        o.z = pk4_fp8(s[8 * 33] * WSCALE, s[9 * 33] * WSCALE, s[10 * 33] * WSCALE, s[11 * 33] * WSCALE); o.w = pk4_fp8(s[12 * 33] * WSCALE, s[13 * 33] * WSCALE, s[14 * 33] * WSCALE, s[15 * 33] * WSCALE);
        *(u32x4*)(WT + (size_t)dest_row<MODE>(n0 + n, aux) * K + k0 + 16 * c) = o; }
    LDS_WAIT(); asm volatile("" ::: "memory");
}
__device__ __forceinline__ void conv_weights(Frame& F0, int l, int experts, int gw0 = -1, int ngw = 0) {
    Frame F = F0; F.tid = fresh_v(F0.tid); F.lane = F.tid & 63; F.wave = fresh_s(F0.wave);
    LAS float* scr = (LAS float*)(F.lds + F.wave * 16384);
    const int gw = gw0 >= 0 ? gw0 : F.vcu * NWAVES + F.wave, NGW = gw0 >= 0 ? ngw : F.G * NWAVES;
    constexpr int I_IN = (D / 64) * (NQKV / 32), I_OUT = (D / 64) * (D / 32), I_GE = (D / 64) * (FF / 32), I_DE = (FF / 64) * (D / 32);
    constexpr int NITEMS = I_IN + I_OUT + NE * (2 * I_GE + I_DE);
    CArgs* ka = kargs();
    const float* w_in = ka->in[2] + (size_t)l * D * NQKV; const float* w_out = ka->in[6] + (size_t)l * D * D;
    const float* w_gate = ka->in[9] + (size_t)l * NE * D * FF; const float* w_up = ka->in[10] + (size_t)l * NE * D * FF; const float* w_down = ka->in[11] + (size_t)l * NE * FF * D;
    bf16_t* WIN = (bf16_t*)(F.ws + WS_WIN); bf16_t* WOUT = (bf16_t*)(F.ws + WS_WOUT); unsigned char* WGU = F.ws + WS_WGU + (size_t)l * WGU_BYTES; unsigned char* WD = F.ws + WS_WD + (size_t)l * WD_BYTES;
    const int nit = experts == 1 ? NITEMS : experts == 2 ? I_IN + I_OUT + 2 * NE * I_GE : I_IN + I_OUT;
    for (int it = gw; it < nit; it += NGW) {
        int r = it;
        if (r < I_IN) { conv_item<1>(w_in, D, NQKV, WIN, 0, scr, r, F.lane, ka->in[1] + (size_t)l * D); continue; } r -= I_IN;
        if (r < I_OUT) { const int k0_ = 64 * (r / (D / 32)); conv_item<0>(w_out, D, D, WOUT, 0, scr, r, F.lane, k0_ < 512 ? ka->in[3] + (size_t)l * 512 : ka->in[4] + (size_t)l * 512 - 512); continue; } r -= I_OUT;
        if (r < NE * I_GE) { const int e = r / I_GE; conv_item8<2>(w_gate + (size_t)e * D * FF, D, FF, WGU + (size_t)e * 2 * FF * D, 0, scr, r - e * I_GE, F.lane); continue; } r -= NE * I_GE;
        if (r < NE * I_GE) { const int e = r / I_GE; conv_item8<2>(w_up + (size_t)e * D * FF, D, FF, WGU + (size_t)e * 2 * FF * D, 1, scr, r - e * I_GE, F.lane); continue; } r -= NE * I_GE;
        { const int e = r / I_DE; conv_item8<0>(w_down + (size_t)e * FF * D, FF, D, WD + (size_t)e * D * FF, 0, scr, r - e * I_DE, F.lane); }
    }
}
__device__ const double INVF[32] = {
    1.0, 0.7498942093324559, 0.5623413251903491, 0.4216965034285822, 0.31622776601683794, 0.23713737056616552, 0.1778279410038923, 0.1333521432163324,
    0.1, 0.07498942093324558, 0.05623413251903491, 0.042169650342858224, 0.03162277660168379, 0.023713737056616554, 0.01778279410038923, 0.01333521432163324,
    0.01, 0.007498942093324558, 0.005623413251903491, 0.004216965034285823, 0.0031622776601683794, 0.0023713737056616554, 0.0017782794100389228, 0.001333521432163324,
    0.001, 0.0007498942093324559, 0.0005623413251903491, 0.00042169650342858224, 0.00031622776601683794, 0.00023713737056616554, 0.00017782794100389227, 0.0001333521432163324};
__device__ __forceinline__ void rope_table(Frame& F0) {
    Frame F = F0; F.tid = fresh_v(F0.tid); F.lane = F.tid & 63; F.wave = fresh_s(F0.wave);
    float* tab = (float*)(F.ws + WS_ROPE);
    for (int idx = F.vcu * NTHREADS + F.tid; idx < T * 32; idx += F.G * NTHREADS) {
        const int t = idx >> 5, i = idx & 31;
        const double ang = (double)t * INVF[i];
        const double n = __builtin_rint(ang * 0.15915494309189535);
        double r = __builtin_fma(-n, 6.283185307179586, ang); r = __builtin_fma(-n, 2.4492935982947064e-16, r);
        const double x = r * 0.25, x2 = x * x;
        double s = -1.0 / 1307674368000.0; s = s * x2 + 1.0 / 6227020800.0; s = s * x2 - 1.0 / 39916800.0; s = s * x2 + 1.0 / 362880.0; s = s * x2 - 1.0 / 5040.0; s = s * x2 + 1.0 / 120.0; s = s * x2 - 1.0 / 6.0; s = s * x2 + 1.0; s = s * x;
        double c = 1.0 / 20922789888000.0; c = c * x2 - 1.0 / 87178291200.0; c = c * x2 + 1.0 / 479001600.0; c = c * x2 - 1.0 / 3628800.0; c = c * x2 + 1.0 / 40320.0; c = c * x2 - 1.0 / 720.0; c = c * x2 + 1.0 / 24.0; c = c * x2 - 0.5; c = c * x2 + 1.0;
        const double s2 = 2.0 * s * c, c2 = 1.0 - 2.0 * s * s; const double s4 = 2.0 * s2 * c2, c4 = 1.0 - 2.0 * s2 * s2;
        *(f32x2*)(tab + (size_t)idx * 2) = (f32x2){(float)c4, (float)s4};
    }
}
__device__ __forceinline__ void store_bf16_row(bf16_t* orow, const f32x4 (&v)[4], int lane) {
    u32x2* o8 = (u32x2*)orow + lane;
#pragma unroll
    for (int j = 0; j < 4; ++j) { u32x2 w; w.x = cvt_pk_bf16(v[j][0], v[j][1]); w.y = cvt_pk_bf16(v[j][2], v[j][3]); o8[64 * j] = w; }
}
__device__ __forceinline__ float row_rstd(const f32x4 (&v)[4]) {
    float s = 0.f;
#pragma unroll
    for (int j = 0; j < 4; ++j) s += (v[j][0] * v[j][0] + v[j][1] * v[j][1]) + (v[j][2] * v[j][2] + v[j][3] * v[j][3]);
    return 1.0f / sqrtf(wave_sum(s) * (1.0f / D) + EPS);
}
__device__ __forceinline__ void norm1_phase(Frame& F0, const float* x, const float* gain) {
    Frame F = F0; F.tid = fresh_v(F0.tid); F.lane = F.tid & 63; F.wave = fresh_s(F0.wave);
    bf16_t* H = (bf16_t*)(F.ws + WS_H);
    const int gw = F.vcu * NWAVES + F.wave, NGW = F.G * NWAVES;
    f32x4 g[4];
#pragma unroll
    for (int j = 0; j < 4; ++j) g[j] = *((const f32x4*)gain + 64 * j + F.lane);
#pragma unroll 1
    for (int m = gw; m < M; m += NGW) {
        const f32x4* xr = (const f32x4*)(x + (size_t)m * D) + F.lane; f32x4 v[4];
#pragma unroll
        for (int j = 0; j < 4; ++j) v[j] = xr[64 * j];
        const float rstd = row_rstd(v);
        store_bf16_row(H + (size_t)m * D, v, F.lane);
        if (F.lane == 0) ((float*)(F.ws + WS_RSTDQ))[m] = rstd;
    }
}
constexpr int N2_WHI = 0, N2_WLO = 32768, N2_GAIN = 65536;
template <bool XBF, bool NOA>
__device__ __forceinline__ void norm2_router_phase(Frame& F0, const void* xin, bf16_t* x1, const float* gain, const float* wr) {
    Frame F = F0; F.tid = fresh_v(F0.tid); F.lane = F.tid & 63; F.wave = fresh_s(F0.wave);
    unsigned char* H8 = F.ws + WS_H; float* AFF = (float*)(F.ws + WS_AFF); const bf16_t* Aat = (const bf16_t*)(F.ws + WS_PARTA); float* RSTD = (float*)(F.ws + WS_RSTD);
    { f32x4 wv[8];
#pragma unroll
      for (int k = 0; k < 8; ++k) wv[k] = *(const f32x4*)(wr + 4 * (F.tid + k * NTHREADS));
      float gv[8];
#pragma unroll
      for (int k = 0; k < 8; ++k) gv[k] = gain[(4 * (F.tid + k * NTHREADS)) >> 4];
#pragma unroll
      for (int k = 0; k < 8; ++k)
#pragma unroll
          for (int c = 0; c < 4; ++c) { const int idx = 4 * (F.tid + k * NTHREADS) + c, d = idx >> 4, e = idx & 15; const float w = wv[k][c] * gv[k];
              const unsigned hi = cvt_pk_bf16(w, 0.f) & 0xffffu; const float rem = w - __uint_as_float(hi << 16); const unsigned lo = cvt_pk_bf16(rem, 0.f) & 0xffffu;
              const int o = ((((d >> 5) * 4 + ((d >> 3) & 3)) * 16 + e) * 8 + (d & 7)) * 2;
              *(LAS bf16_t*)(F.lds + N2_WHI + o) = (bf16_t)hi; *(LAS bf16_t*)(F.lds + N2_WLO + o) = (bf16_t)lo; } }
    { const float g0_ = gain[F.tid], g1_ = gain[F.tid + NTHREADS]; ((LAS float*)(F.lds + N2_GAIN))[F.tid] = g0_; ((LAS float*)(F.lds + N2_GAIN))[F.tid + NTHREADS] = g1_; }
    __syncthreads();
    const int lane = F.lane, i = lane & 15, g = lane >> 4;
    const int gw = F.vcu * NWAVES + F.wave, NGW = F.G * NWAVES;
#pragma unroll 1
    for (int tile = gw; tile < M / 16; tile += NGW) {
        const int row = tile * 16 + i;
        const f32x4* xr = (const f32x4*)((const float*)xin + (size_t)row * D + 8 * g); const u32x4* xrb = (const u32x4*)((const bf16_t*)xin + (size_t)row * D + 8 * g);
        u32x4* xo = (u32x4*)(x1 + (size_t)row * D + 8 * g);
        const u32x4* ar = (const u32x4*)(Aat + (size_t)row * D + 8 * g); u32x2* ho = (u32x2*)(H8 + (size_t)row * D + 8 * g);
        f32x4 acc = (f32x4){0.f, 0.f, 0.f, 0.f}; float ssq = 0.f;
        static_assert(XBF && NOA, "only the (bf16 x1 in, nothing to add) form is instantiated");
        u32x4 xwall[32]; u32x2 h8prev = (u32x2){0u, 0u};
#pragma unroll
        for (int ks = 0; ks < 32; ++ks) xwall[ks] = xrb[4 * ks];
#pragma unroll
        for (int ks = 0; ks < 32; ++ks) {
                f32x4 va, vb;
                va = (f32x4){bf_lo(xwall[ks].x), bf_hi(xwall[ks].x), bf_lo(xwall[ks].y), bf_hi(xwall[ks].y)}; vb = (f32x4){bf_lo(xwall[ks].z), bf_hi(xwall[ks].z), bf_lo(xwall[ks].w), bf_hi(xwall[ks].w)};
                ssq += (va[0] * va[0] + va[1] * va[1]) + (va[2] * va[2] + va[3] * va[3]) + (vb[0] * vb[0] + vb[1] * vb[1]) + (vb[2] * vb[2] + vb[3] * vb[3]);
                const f32x4 ga = *(const LAS f32x4*)(F.lds + N2_GAIN + (32 * ks + 8 * g) * 4), gb = *(const LAS f32x4*)(F.lds + N2_GAIN + (32 * ks + 8 * g + 4) * 4);
                va = va * ga; vb = vb * gb;
                u32x2 h8; h8.x = pk4_fp8(va[0], va[1], va[2], va[3]); h8.y = pk4_fp8(vb[0], vb[1], vb[2], vb[3]);
                if ((ks & 1) == 0) h8prev = h8;
                else { const auto sx = __builtin_amdgcn_permlane16_swap(h8prev.x, h8.x, false, false), sy = __builtin_amdgcn_permlane16_swap(h8prev.y, h8.y, false, false);
                    u32x4 w16; w16.x = sx[0]; w16.y = sy[0]; w16.z = sx[1]; w16.w = sy[1];
                    *(u32x4*)(H8 + (size_t)row * D + 32 * (ks - 1 + (g & 1)) + 8 * (g & 2)) = w16; }
                const bf16x8 whi = *(const LAS bf16x8*)(F.lds + N2_WHI + (ks * 64 + lane) * 16), wlo = *(const LAS bf16x8*)(F.lds + N2_WLO + (ks * 64 + lane) * 16);
                const bf16x8 tx = __builtin_bit_cast(bf16x8, xwall[ks]);
                acc = __builtin_amdgcn_mfma_f32_16x16x32_bf16(whi, tx, acc, 0, 0, 0);
                acc = __builtin_amdgcn_mfma_f32_16x16x32_bf16(wlo, tx, acc, 0, 0, 0);
                if ((ks & 1) == 1) __builtin_amdgcn_sched_barrier(0);
        }
        ssq += __shfl_xor(ssq, 16); ssq += __shfl_xor(ssq, 32);
        const float rstd = 1.0f / sqrtf(ssq * (1.0f / D) + EPS);
        if (g == 0) RSTD[row] = rstd;
        f32x4 lg = acc * rstd;
        float mx = fmaxf(fmaxf(lg[0], lg[1]), fmaxf(lg[2], lg[3])); mx = fmaxf(mx, __shfl_xor(mx, 16)); mx = fmaxf(mx, __shfl_xor(mx, 32));
        f32x4 ex; ex[0] = __expf(lg[0] - mx); ex[1] = __expf(lg[1] - mx); ex[2] = __expf(lg[2] - mx); ex[3] = __expf(lg[3] - mx);
        float sum = (ex[0] + ex[1]) + (ex[2] + ex[3]); sum += __shfl_xor(sum, 16); sum += __shfl_xor(sum, 32);
        const float inv = 1.0f / sum;
        float* ap = AFF + ((size_t)(row >> 13) * NE + 4 * g) * T + (row & (T - 1));
#pragma unroll
        for (int r = 0; r < 4; ++r) ap[(size_t)r * T] = ex[r] * inv;
    }
    __syncthreads();
}
__device__ __forceinline__ void topk_phase(Frame& F0, bool conv_idle) {
    Frame F = F0; F.tid = fresh_v(F0.tid); F.lane = F.tid & 63; F.wave = fresh_s(F0.wave);
    if (conv_idle && F.vcu >= BATCH * NE) { conv_weights(F0, 1, 0, (F.vcu - BATCH * NE) * NWAVES + F.wave, (F.G - BATCH * NE) * NWAVES); return; }
    const float* AFF = (const float*)(F.ws + WS_AFF); int* INV = (int*)(F.ws + WS_INV); int* SEL = (int*)(F.ws + WS_SEL); float* GATEV = (float*)(F.ws + WS_GATEV);
    const float* RSTD = (const float*)(F.ws + WS_RSTD); float* RSS = (float*)(F.ws + WS_RSS);
    LAS unsigned* hist = (LAS unsigned*)F.lds;
    LAS unsigned* suf = hist + 256;
    LAS unsigned* ctl = hist + 768;
    LAS unsigned* wtot = hist + 800;
    for (int task = F.vcu; task < BATCH * NE; task += F.G) {
        const int b = task >> 4, e = task & 15;
        const unsigned* src = (const unsigned*)(AFF + (size_t)task * T) + F.tid * 16;
        unsigned v[16];
#pragma unroll
        for (int q = 0; q < 4; ++q) { const u32x4 w = *((const u32x4*)src + q); v[4 * q] = w.x; v[4 * q + 1] = w.y; v[4 * q + 2] = w.z; v[4 * q + 3] = w.w; }
        unsigned prefix = 0, remaining = CAP;
        if (F.tid < 256) hist[F.tid] = 0u;
        __syncthreads();
#pragma unroll 1
        for (int pass = 0; pass < 4; ++pass) {
            const int shift = 24 - 8 * pass;
#pragma unroll
            for (int j = 0; j < 16; ++j) { const bool match = (pass == 0) || ((v[j] >> (shift + 8)) == prefix); if (match) atomicAdd((unsigned*)&hist[(v[j] >> shift) & 255u], 1u); }
            __syncthreads();
            unsigned hv = 0u, sfx = 0u;
            if (F.tid < 256) { hv = hist[F.tid]; hist[F.tid] = 0u; }
            { int pv = (int)hv;
              pv += __builtin_amdgcn_update_dpp(0, pv, 0x111, 0xf, 0xf, false); pv += __builtin_amdgcn_update_dpp(0, pv, 0x112, 0xf, 0xf, false);
              pv += __builtin_amdgcn_update_dpp(0, pv, 0x114, 0xf, 0xf, false); pv += __builtin_amdgcn_update_dpp(0, pv, 0x118, 0xf, 0xf, false);
              pv += __builtin_amdgcn_update_dpp(0, pv, 0x142, 0xa, 0xf, false); pv += __builtin_amdgcn_update_dpp(0, pv, 0x143, 0xc, 0xf, false);
              const unsigned tot = (unsigned)__builtin_amdgcn_readlane(pv, 63);
              sfx = tot - (unsigned)pv + hv; }
            if (F.tid < 256 && F.lane == 0) wtot[F.wave] = sfx;
            __syncthreads();
            if (F.tid < 256) { unsigned above = 0u;
#pragma unroll
                for (int w = 1; w < 4; ++w) above += (w > F.wave) ? wtot[w] : 0u;
                const unsigned sd = sfx + above, sn = sd - hv;
                if (sd >= remaining && sn < remaining) { ctl[0] = (unsigned)F.tid; ctl[1] = remaining - sn; } }
            __syncthreads();
            prefix = (prefix << 8) | ctl[0]; remaining = ctl[1];
        }
        const unsigned thr = prefix, need_eq = remaining, n_gt = CAP - remaining;
        unsigned cnt = 0u;
#pragma unroll
        for (int j = 0; j < 16; ++j) cnt += (v[j] > thr ? 1u : 0u) + (v[j] == thr ? 0x10000u : 0u);
        unsigned inc = cnt;
#pragma unroll
        for (int o = 1; o < 64; o <<= 1) { const unsigned t = __shfl_up(inc, o); if (F.lane >= o) inc += t; }
        if (F.lane == 63) wtot[F.wave] = inc;
        __syncthreads();
        unsigned base = 0u;
#pragma unroll
        for (int w = 0; w < NWAVES; ++w) base += (w < F.wave) ? wtot[w] : 0u;
        unsigned run = base + inc - cnt;
        unsigned rg = run & 0xffffu, re = run >> 16;
        const int tbase = F.tid * 16;
        f32x4 rs4[4];
#pragma unroll
        for (int q = 0; q < 4; ++q) rs4[q] = *((const f32x4*)(RSTD + (size_t)b * T + tbase) + q);
#pragma unroll
        for (int j = 0; j < 16; ++j) {
            const int t = tbase + j; int slot = -1;
            if (v[j] > thr) { slot = (int)rg; ++rg; }
            else if (v[j] == thr) { if (re < need_eq) slot = (int)(n_gt + re); ++re; }
            const int gt = b * T + t;
            INV[(size_t)gt * NE + e] = slot >= 0 ? b * CAP + slot : -1;
            if (slot >= 0) { const int sr = e * (BATCH * CAP) + b * CAP + slot; SEL[sr] = gt; GATEV[sr] = __uint_as_float(v[j]); RSS[sr] = rs4[j >> 2][j & 3]; }
        }
        __syncthreads();
    }
}
template <bool FINAL>
__device__ __forceinline__ void combine_phase(Frame& F0, float* x  , const float* gain) {
    Frame F = F0; F.tid = fresh_v(F0.tid); F.lane = F.tid & 63; F.wave = fresh_s(F0.wave);
    const int* INV = (const int*)(F.ws + WS_INV); const unsigned char* YE = F.ws + WS_YE; bf16_t* H = (bf16_t*)(F.ws + WS_H); const float* GATEV = (const float*)(F.ws + WS_GATEV);
    const int gw = F.vcu * NWAVES + F.wave, NGW = F.G * NWAVES;
    f32x4 g[4];
#pragma unroll
    for (int j = 0; j < 4; ++j) g[j] = *((const f32x4*)gain + 64 * j + F.lane);
#define CB_POP(T) const int e1##T = any##T ? __builtin_ctzll(mask##T) : 0; if (any##T) mask##T &= mask##T - 1; const bool two##T = mask##T != 0ull; const int e2##T = two##T ? __builtin_ctzll(mask##T) : e1##T; if (two##T) mask##T &= mask##T - 1; \
        const int s1##T = any##T ? __builtin_amdgcn_readlane(inv##T, e1##T) : 0, s2##T = any##T ? __builtin_amdgcn_readlane(inv##T, e2##T) : 0;
#define CB_ISSUE(T) const float g1##T = __hip_atomic_load(GATEV + (size_t)e1##T * (BATCH * CAP) + s1##T, __ATOMIC_RELAXED, __HIP_MEMORY_SCOPE_AGENT) * (1.0f / YSCALE), \
                        g2r##T = __hip_atomic_load(GATEV + (size_t)e2##T * (BATCH * CAP) + s2##T, __ATOMIC_RELAXED, __HIP_MEMORY_SCOPE_AGENT) * (1.0f / YSCALE); \
        const int* yr1##T = (const int*)(YE + ((size_t)e1##T * (BATCH * CAP) + s1##T) * D) + F.lane; const int* yr2##T = (const int*)(YE + ((size_t)e2##T * (BATCH * CAP) + s2##T) * D) + F.lane; \
        int w1##T[4], w2##T[4]; _Pragma("unroll") for (int j = 0; j < 4; ++j) { w1##T[j] = yr1##T[64 * j]; w2##T[j] = yr2##T[64 * j]; }
#define CB_FMA(V, W, Gv) _Pragma("unroll") for (int j = 0; j < 4; ++j) { const f32x2 a_ = __builtin_amdgcn_cvt_pk_f32_fp8(W[j], false), c_ = __builtin_amdgcn_cvt_pk_f32_fp8(W[j], true); \
            V[j][0] += (Gv) * a_.x; V[j][1] += (Gv) * a_.y; V[j][2] += (Gv) * c_.x; V[j][3] += (Gv) * c_.y; }
#define CB_CONSUME(T) { const float ga_ = any##T ? g1##T : 0.f, gb_ = two##T ? g2r##T : 0.f; CB_FMA(v##T, w1##T, ga_) CB_FMA(v##T, w2##T, gb_) }
#define CB_REST(T) while (mask##T) { const bool any##T = true; (void)any##T; CB_POP(T) CB_ISSUE(T) CB_CONSUME(T) }
#define CB_FINISH(T, m_) { _Pragma("unroll") for (int j = 0; j < 4; ++j) { v##T[j][0] += bf_lo(xw##T[j].x); v##T[j][1] += bf_hi(xw##T[j].x); v##T[j][2] += bf_lo(xw##T[j].y); v##T[j][3] += bf_hi(xw##T[j].y); } \
        const float rstd_ = row_rstd(v##T); \
        if (FINAL) { f32x4* xr_ = (f32x4*)(x + (size_t)(m_) * D) + F.lane; _Pragma("unroll") for (int j = 0; j < 4; ++j) xr_[64 * j] = v##T[j] * rstd_ * g[j]; } \
        else { store_bf16_row((bf16_t*)x + (size_t)(m_) * D, v##T, F.lane);     \
               if (F.lane == 0) ((float*)(F.ws + WS_RSTDQ))[m_] = rstd_; } }
    int invA_n = INV[(size_t)gw * NE + (F.lane & 15)], invB_n = INV[(size_t)(gw + NGW < M ? gw + NGW : gw) * NE + (F.lane & 15)];
#pragma unroll 1
    for (int m = gw; m < M; m += 2 * NGW) {
        const int mB = m + NGW; const bool hasB = mB < M; const int mBc = hasB ? mB : m;
        const int invA = invA_n, invB = invB_n;
        { const int ma_ = (m + 2 * NGW < M) ? m + 2 * NGW : m, mb_ = (mB + 2 * NGW < M) ? mB + 2 * NGW : m;
          invA_n = INV[(size_t)ma_ * NE + (F.lane & 15)]; invB_n = INV[(size_t)mb_ * NE + (F.lane & 15)]; }
        u32x2 xwA[4], xwB[4];
        { const u32x2* xa_ = (const u32x2*)((const bf16_t*)(F.ws + WS_PARTA) + (size_t)m * D) + F.lane; const u32x2* xb_ = (const u32x2*)((const bf16_t*)(F.ws + WS_PARTA) + (size_t)mBc * D) + F.lane;
#pragma unroll
          for (int j = 0; j < 4; ++j) { xwA[j] = xa_[64 * j]; xwB[j] = xb_[64 * j]; } }
        f32x4 vA[4], vB[4];
#pragma unroll
        for (int j = 0; j < 4; ++j) { vA[j] = (f32x4){0.f, 0.f, 0.f, 0.f}; vB[j] = (f32x4){0.f, 0.f, 0.f, 0.f}; }
        unsigned long long maskA = __ballot(invA >= 0) & 0xffffull, maskB = hasB ? (__ballot(invB >= 0) & 0xffffull) : 0ull;
        const bool anyA = maskA != 0ull, anyB = maskB != 0ull;
        CB_POP(A) CB_POP(B)
        CB_ISSUE(A) CB_ISSUE(B)
        CB_CONSUME(A) CB_REST(A)
        CB_CONSUME(B) CB_REST(B)
        CB_FINISH(A, m)
        if (hasB) CB_FINISH(B, mB)
    }
#undef CB_POP
#undef CB_ISSUE
#undef CB_FMA
#undef CB_CONSUME
#undef CB_REST
#undef CB_FINISH
}

constexpr int ATT_VROW = 160;
constexpr int ATT_VBYTES = 32 * ATT_VROW;
constexpr int ATT_SSQ_OFF = NWAVES * ATT_VBYTES;
constexpr int ATT_BIAS_OFF = ATT_SSQ_OFF + 2 * 8 * 256 * 4;
constexpr int ATT_BIAS_PADF = 32, ATT_BIAS_TAILF = 64;
typedef short v4i16_t __attribute__((ext_vector_type(4)));
__device__ __forceinline__ s16x4 vtr(const LAS unsigned char* p) { return __builtin_bit_cast(s16x4, __builtin_amdgcn_ds_read_tr16_b64_v4i16((LAS v4i16_t*)p)); }

template <bool NA>
__device__ __forceinline__ void attn_task(const bf16_t* __restrict__ qkv, bf16_t* __restrict__ mix, LAS unsigned char* lds, int lane, int wave,
                                          int b, int h, int mblk, int r, int grow, int cb) {
    const int i = lane & 15, g = lane >> 4;
    constexpr size_t TENS = (size_t)BATCH * 8 * T * 64;
    const bf16_t* qbase = qkv + (size_t)(NA ? 3 : 0) * TENS + ((size_t)(b * 8 + h) * T << 6) + 8 * g;
    const bf16_t* kbase = qbase + TENS;
    const int tl = NA ? ((grow & 3) * 64 + 16 * cb + i) : (16 * i + r);
    const int tq = 256 * mblk + tl;
    const bf16x8 Q0 = *(const bf16x8*)(qbase + ((size_t)tq << 6)), Q1 = *(const bf16x8*)(qbase + ((size_t)tq << 6) + 32);
    const int qrow = grow, qcol = 16 * cb + i;
    const int rs = min(max(qrow - 4, 0), 120), cs = min(max(qcol - 8, 0), 48), kc0 = min(max(16 * cb - 8, 0), 32);
    const LAS float* biasp = (const LAS float*)(lds + ATT_BIAS_OFF) + ATT_BIAS_PADF + ((h * 15 + (rs - qrow + 7)) * 31 + (kc0 - qcol + 15 + 4 * g));
    constexpr int NSTEP = NA ? 9 : 24;
    LAS unsigned char* vst = lds + wave * ATT_VBYTES + i * ATT_VROW + 16 * g;
    const LAS unsigned char* vrd = lds + wave * ATT_VBYTES + (4 * g + (i >> 2)) * ATT_VROW + (i & 3) * 8;
    bf16x8 K0[2][2], V0[2][2], K1[2][2], V1[2][2], K2[2][2], V2[2][2];
#define ATT_SEG(sidx, sl, sh, rp, Lm1, basepos) \
    if ((sidx) < 5) { sl = (sidx); sh = 4; rp = r; Lm1 = 511; basepos = 16 * mblk - 64; } \
    else if ((sidx) < 11) { sl = (sidx) - 5; sh = 2; rp = r & 3; Lm1 = 2047; basepos = 64 * mblk - 64; } \
    else { sl = (sidx) - 11; sh = 0; rp = 0; Lm1 = 8191; basepos = 256 * mblk - 64; }
#define ATT_LOAD(KB, VB, sidx) do { int sl_, sh_, rp_, Lm1_, bp_; if (!NA) { ATT_SEG(sidx, sl_, sh_, rp_, Lm1_, bp_) } \
        _Pragma("unroll") for (int T_ = 0; T_ < 2; ++T_) { int tok_; \
            if (NA) tok_ = min(rs + (sidx), 127) * 64 + kc0 + 16 * T_ + i; \
            else { const int pos_ = bp_ + 32 * sl_ + 16 * T_ + i; tok_ = (min(max(pos_, 0), Lm1_) << sh_) + rp_; } \
            const bf16_t* p_ = kbase + ((size_t)tok_ << 6); \
            KB[T_][0] = *(const bf16x8*)p_; KB[T_][1] = *(const bf16x8*)(p_ + 32); VB[T_][0] = *(const bf16x8*)(p_ + TENS); VB[T_][1] = *(const bf16x8*)(p_ + TENS + 32); } } while (0)
    f32x4 O[4];
#pragma unroll
    for (int n = 0; n < 4; ++n) O[n] = (f32x4){0.f, 0.f, 0.f, 0.f};
    float mrun = -1e30f, lrun = 0.f;
#define ATT_STEP(KB, VB, s) do { \
        _Pragma("unroll") for (int T_ = 0; T_ < 2; ++T_) { *(LAS bf16x8*)(vst + T_ * 16 * ATT_VROW) = VB[T_][0]; *(LAS bf16x8*)(vst + T_ * 16 * ATT_VROW + 64) = VB[T_][1]; } \
        f32x4 sc[2]; \
        _Pragma("unroll") for (int T_ = 0; T_ < 2; ++T_) { sc[T_] = __builtin_amdgcn_mfma_f32_16x16x32_bf16(KB[T_][0], Q0, (f32x4){0.f, 0.f, 0.f, 0.f}, 0, 0, 0); \
            sc[T_] = __builtin_amdgcn_mfma_f32_16x16x32_bf16(KB[T_][1], Q1, sc[T_], 0, 0, 0); } \
        ATT_LOAD(KB, VB, min((s) + 3, NSTEP - 1)); \
        int lo, span, x0; \
        if (NA) { lo = ((s) < 8) ? cs - kc0 - 4 * g : (1 << 20); span = 15; x0 = 0; } \
        else { int sl_, sh_, rp_, Lm1_, bp_; ATT_SEG(s, sl_, sh_, rp_, Lm1_, bp_) (void)rp_; \
            const int pq = tq >> sh_; \
            lo = max(pq - 64, 0) - bp_ - 4 * g; span = (min(pq + 64, Lm1_) - bp_ - 4 * g) - lo; x0 = 32 * sl_; } \
        float mloc = -INFINITY; \
        _Pragma("unroll") for (int T_ = 0; T_ < 2; ++T_) \
            _Pragma("unroll") for (int q = 0; q < 4; ++q) { const bool valid = (unsigned)(x0 + 16 * T_ + q - lo) <= (unsigned)span; \
                float v = sc[T_][q]; if (NA) v += biasp[(s) * 31 + 16 * T_ + q]; \
                v = valid ? v : -INFINITY; sc[T_][q] = v; mloc = fmaxf(mloc, v); } \
        mloc = fmaxf(mloc, __shfl_xor(mloc, 16)); mloc = fmaxf(mloc, __shfl_xor(mloc, 32)); \
        const float mnew = fmaxf(mrun, mloc), alpha = __builtin_amdgcn_exp2f(mrun - mnew); mrun = mnew; \
        float psum = 0.f; \
        _Pragma("unroll") for (int T_ = 0; T_ < 2; ++T_) \
            _Pragma("unroll") for (int q = 0; q < 4; ++q) { const float p = __builtin_amdgcn_exp2f(sc[T_][q] - mnew); sc[T_][q] = p; psum += p; } \
        lrun = lrun * alpha + psum; \
        _Pragma("unroll") for (int n = 0; n < 4; ++n) O[n] = O[n] * alpha; \
        u32x4 pw; pw.x = cvt_pk_bf16(sc[0][0], sc[0][1]); pw.y = cvt_pk_bf16(sc[0][2], sc[0][3]); pw.z = cvt_pk_bf16(sc[1][0], sc[1][1]); pw.w = cvt_pk_bf16(sc[1][2], sc[1][3]); \
        const bf16x8 Pf = __builtin_bit_cast(bf16x8, pw); \
        _Pragma("unroll") for (int n = 0; n < 4; ++n) { const s16x4 a = vtr(vrd + n * 32), c = vtr(vrd + 16 * ATT_VROW + n * 32); \
            const bf16x8 Vf = (bf16x8){a[0], a[1], a[2], a[3], c[0], c[1], c[2], c[3]}; \
            O[n] = __builtin_amdgcn_mfma_f32_16x16x32_bf16(Vf, Pf, O[n], 0, 0, 0); } \
    } while (0)
    ATT_LOAD(K0, V0, 0); ATT_LOAD(K1, V1, 1); ATT_LOAD(K2, V2, 2);
#pragma unroll 1
    for (int s = 0; s < NSTEP; s += 3) {
        ATT_STEP(K0, V0, s);
        ATT_STEP(K1, V1, s + 1);
        ATT_STEP(K2, V2, s + 2);
    }
#undef ATT_STEP
#undef ATT_LOAD
#undef ATT_SEG
    float lt = lrun; lt += __shfl_xor(lt, 16); lt += __shfl_xor(lt, 32);
    const float inv = 1.0f / lt;
    float ssq = 0.f;
    bf16_t* op = mix + ((size_t)b * T + tq) * D + (NA ? 512 : 0) + h * 64 + 4 * g;
#pragma unroll
    for (int n = 0; n < 4; ++n) { const f32x4 o = O[n] * inv; ssq += (o[0] * o[0] + o[1] * o[1]) + (o[2] * o[2] + o[3] * o[3]);
        u32x2 w; w.x = cvt_pk_bf16(o[0], o[1]); w.y = cvt_pk_bf16(o[2], o[3]); *(u32x2*)(op + 16 * n) = w; }
    (void)ssq; (void)tl;
}

constexpr int NA_BIAS_OFF = MISC_OFF + 64;
constexpr int DU_NK = 256, DU_KB = DU_NK * 128, DU_BUF = 2 * DU_KB;
struct DUnit { int sh, res, Lm1, P0, type; };
__device__ __forceinline__ DUnit du_decode(int q, int u) {
    DUnit d;
    if (u < 16) { d.type = 0; d.sh = 4; d.res = 4 * q + (u >> 2); d.Lm1 = 511; d.P0 = 128 * (u & 3); }
    else if (u < 32) { d.type = 1; d.sh = 2; d.res = q; d.Lm1 = 2047; d.P0 = 128 * (u - 16); }
    else { d.type = 2; d.sh = 0; d.res = 0; d.Lm1 = 8191; d.P0 = 128 * (16 * q + (u - 32)); }
    return d;
}
__device__ __forceinline__ void attn_units_phase(Frame& F0, int l) {
    Frame F = F0; F.tid = fresh_v(F0.tid); F.lane = F.tid & 63; F.wave = fresh_s(F0.wave);
    constexpr size_t TENS = (size_t)BATCH * 8 * T * 64;
    const bf16_t* qkv = (const bf16_t*)(F.ws + WS_QKV); bf16_t* mix = (bf16_t*)(F.ws + WS_MIX);
    bf16_t* partA = (bf16_t*)(F.ws + WS_PARTA); bf16_t* partB = (bf16_t*)(F.ws + WS_PARTB); float* lsep = (float*)(F.ws + WS_LSEP);
    const int lane = F.lane, w = F.wave, i = lane & 15, g = lane >> 4;
    for (int c = F.vcu; c < 256; c += F.G) {
        const int bh = c >> 2, q = c & 3, b = bh >> 3, h = bh & 7;
        const bf16_t* qb = qkv + ((size_t)(b * 8 + h) * T << 6);
        const bf16_t* kb = qb + TENS;
        const __amdgpu_buffer_rsrc_t rKV = __builtin_amdgcn_make_buffer_rsrc((void*)kb, 0, 0xffffffff, 0x00020000);
        const int fK = (i >> 1) & 7;
        const int kof0 = i * 128 + ((g ^ fK) << 4), kof1 = i * 128 + (((4 + g) ^ fK) << 4);
        const int fV = ((2 * g + (i >> 3)) & 3) << 1;
        int vof[4];
#pragma unroll
        for (int n = 0; n < 4; ++n) vof[n] = (4 * g + (i >> 2)) * 128 + (((2 * n + ((i & 3) >> 1)) ^ fV) << 4) + (i & 1) * 8;
#define DU_ISSUE_HALF(d_, half_, slot_) do { \
        _Pragma("unroll") for (int k_ = 0; k_ < 2; ++k_) { const int rr_ = 16 * w + 8 * k_ + (lane >> 3), row_ = 128 * (half_) + rr_; \
            const int pos_ = min(max((d_).P0 - 64 + row_, 0), (d_).Lm1); const size_t tok_ = (size_t)((pos_ << (d_).sh) + (d_).res); \
            const int cK_ = (lane & 7) ^ ((row_ >> 1) & 7), cV_ = (lane & 7) ^ (((row_ >> 1) & 3) << 1); \
            __builtin_amdgcn_raw_ptr_buffer_load_lds(rKV, (LAS unsigned*)(F.lds + (slot_) * 16384 + (16 * w + 8 * k_) * 128), 16, (unsigned)(tok_ << 7) + (unsigned)(cK_ * 16), 0, 0, 0); \
            __builtin_amdgcn_raw_ptr_buffer_load_lds(rKV, (LAS unsigned*)(F.lds + 65536 + (slot_) * 16384 + (16 * w + 8 * k_) * 128), 16, (unsigned)(tok_ << 7) + (unsigned)(cV_ * 16), (unsigned)(TENS * 2), 0, 0); } } while (0)
#define DU_CHAIN_START(u_) ((u_) < 16 ? (((u_) & 3) == 0) : ((u_) == 16 || (u_) == 32))
#define DU_QLOAD(u_, Qa, Qb) do { const DUnit d_ = du_decode(q, (u_)); const size_t tq_ = (size_t)(((d_.P0 + 16 * w + i) << d_.sh) + d_.res); \
        Qa = *(const bf16x8*)(qb + (tq_ << 6) + 8 * g); Qb = *(const bf16x8*)(qb + (tq_ << 6) + 8 * g + 32); } while (0)
        bf16x8 Qn0, Qn1;
        __syncthreads();
        { const DUnit d0_ = du_decode(q, 0); DU_ISSUE_HALF(d0_, 0, 0); DU_ISSUE_HALF(d0_, 1, 1); } DU_QLOAD(0, Qn0, Qn1);
        int slotA = 0;
        __builtin_amdgcn_s_waitcnt(0x0F70);
#pragma unroll 1
        for (int u = 0; u < 48; ++u) {
            const bf16x8 Q0 = Qn0, Q1 = Qn1;
            asm volatile("s_waitcnt vmcnt(5)" ::: "memory");
            asm volatile("" ::: "memory"); __builtin_amdgcn_s_barrier(); asm volatile("" ::: "memory");
            const int slotB = (slotA + 1) & 3; int slotN = slotB;
            { const int un_ = u + 1 < 48 ? u + 1 : 47; const DUnit dn_ = du_decode(q, un_);
                if (DU_CHAIN_START(u + 1)) { DU_ISSUE_HALF(dn_, 0, (slotA + 2) & 3); DU_ISSUE_HALF(dn_, 1, (slotA + 3) & 3); slotN = (slotA + 2) & 3; }
                else DU_ISSUE_HALF(dn_, 1, (slotA + 2) & 3);
                DU_QLOAD(un_, Qn0, Qn1); }
            const DUnit d = du_decode(q, u);
            const int kbA = slotA * 16384, kbB = slotB * 16384 - 16384;
            const int lo = max(i, 64 - d.P0 - 16 * w) - 4 * g, span = min(i + 128, d.Lm1 + 64 - d.P0 - 16 * w) - 4 * g - lo;
            f32x4 sc[9];
#pragma unroll
            for (int t_ = 0; t_ < 9; ++t_) { const int rb = 16 * w + 16 * t_;
                const LAS unsigned char* Kb = F.lds + ((w + t_ >= 8) ? kbB : kbA);
                const bf16x8 k0 = *(const LAS bf16x8*)(Kb + rb * 128 + kof0), k1 = *(const LAS bf16x8*)(Kb + rb * 128 + kof1);
                sc[t_] = __builtin_amdgcn_mfma_f32_16x16x32_bf16(k0, Q0, (f32x4){0.f, 0.f, 0.f, 0.f}, 0, 0, 0);
                sc[t_] = __builtin_amdgcn_mfma_f32_16x16x32_bf16(k1, Q1, sc[t_], 0, 0, 0); }
            float mrow = -INFINITY;
#pragma unroll
            for (int t_ = 0; t_ < 9; ++t_)
#pragma unroll
                for (int r_ = 0; r_ < 4; ++r_) { const bool valid = (unsigned)(16 * t_ + r_ - lo) <= (unsigned)span;
                    const float v = valid ? sc[t_][r_] : -INFINITY; sc[t_][r_] = v; mrow = fmaxf(mrow, v); }
            mrow = fmaxf(mrow, __shfl_xor(mrow, 16)); mrow = fmaxf(mrow, __shfl_xor(mrow, 32));
            float lt = 0.f;
#pragma unroll
            for (int t_ = 0; t_ < 9; ++t_)
#pragma unroll
                for (int r_ = 0; r_ < 4; ++r_) { const float p = __builtin_amdgcn_exp2f(sc[t_][r_] - mrow); sc[t_][r_] = p; lt += p; }
            f32x4 O[4];
#pragma unroll
            for (int n = 0; n < 4; ++n) O[n] = (f32x4){0.f, 0.f, 0.f, 0.f};
            unsigned vadA[4], vadB[4];
#pragma unroll
            for (int n = 0; n < 4; ++n) { vadA[n] = (unsigned)(__SIZE_TYPE__)(F.lds + 65536 + kbA + (16 * w) * 128 + vof[n]); vadB[n] = (unsigned)(__SIZE_TYPE__)(F.lds + 65536 + kbB + (16 * w) * 128 + vof[n]); }
            s16x4 va[2][4], vc[2][4];
#define DU_VTR(dst, ad, off) asm volatile("ds_read_b64_tr_b16 %0, %1 offset:%2" : "=v"(dst) : "v"(ad), "n"(off))
#define DU_VISSUE(s_) do { const bool hiA_ = (16 * w + 32 * (s_) >= 128), hiC_ = (16 * w + 32 * (s_) + ((s_) < 4 ? 16 : 0) >= 128); \
        _Pragma("unroll") for (int n = 0; n < 4; ++n) { DU_VTR(va[(s_) & 1][n], hiA_ ? vadB[n] : vadA[n], (s_) * 4096); DU_VTR(vc[(s_) & 1][n], hiC_ ? vadB[n] : vadA[n], ((s_) < 4 ? (s_) * 4096 + 2048 : (s_) * 4096)); } } while (0)
            __builtin_amdgcn_sched_barrier(0);
            DU_VISSUE(0);
#pragma unroll
            for (int s = 0; s < 5; ++s) {
                u32x4 pw; pw.x = cvt_pk_bf16(sc[2 * s][0], sc[2 * s][1]); pw.y = cvt_pk_bf16(sc[2 * s][2], sc[2 * s][3]);
                if (s < 4) { pw.z = cvt_pk_bf16(sc[2 * s + 1][0], sc[2 * s + 1][1]); pw.w = cvt_pk_bf16(sc[2 * s + 1][2], sc[2 * s + 1][3]); } else { pw.z = 0u; pw.w = 0u; }
                const bf16x8 Pf = __builtin_bit_cast(bf16x8, pw);
                if (s < 4) { DU_VISSUE(s + 1);
                    asm volatile("s_waitcnt lgkmcnt(8)" : "+v"(va[s & 1][0]), "+v"(va[s & 1][1]), "+v"(va[s & 1][2]), "+v"(va[s & 1][3]), "+v"(vc[s & 1][0]), "+v"(vc[s & 1][1]), "+v"(vc[s & 1][2]), "+v"(vc[s & 1][3])); }
                else asm volatile("s_waitcnt lgkmcnt(0)" : "+v"(va[s & 1][0]), "+v"(va[s & 1][1]), "+v"(va[s & 1][2]), "+v"(va[s & 1][3]), "+v"(vc[s & 1][0]), "+v"(vc[s & 1][1]), "+v"(vc[s & 1][2]), "+v"(vc[s & 1][3]));
#pragma unroll
                for (int n = 0; n < 4; ++n) { const s16x4 a = va[s & 1][n], cc = vc[s & 1][n];
                    const bf16x8 Vf = (bf16x8){a[0], a[1], a[2], a[3], cc[0], cc[1], cc[2], cc[3]};
                    O[n] = __builtin_amdgcn_mfma_f32_16x16x32_bf16(Vf, Pf, O[n], 0, 0, 0); }
                __builtin_amdgcn_sched_barrier(0);
            }
#undef DU_VTR
#undef DU_VISSUE
            lt += __shfl_xor(lt, 16); lt += __shfl_xor(lt, 32);
            const float inv = 1.0f / lt; const float mrun = mrow;
            const size_t tokq = (size_t)b * T + (size_t)(((d.P0 + 16 * w + i) << d.sh) + d.res);
            bf16_t* op = (d.type == 0 ? partA + tokq * 512 : d.type == 1 ? partB + tokq * 512 : mix + tokq * D) + h * 64 + 4 * g;
#pragma unroll
            for (int n = 0; n < 4; ++n) { const f32x4 o = O[n] * inv; u32x2 ww; ww.x = cvt_pk_bf16(o[0], o[1]); ww.y = cvt_pk_bf16(o[2], o[3]); *(u32x2*)(op + 16 * n) = ww; }
            if (g == 0) lsep[((size_t)d.type * M + tokq) * 8 + h] = mrun + __builtin_amdgcn_logf(lt);
            slotA = slotN;
        }
#undef DU_ISSUE_HALF
#undef DU_CHAIN_START
#undef DU_QLOAD
    }
    __syncthreads();
    { CArgs* ka = kargs(); const float* rpb = ka->in[5] + (size_t)l * 8 * 15 * 31; LAS float* bias = (LAS float*)(F.lds + NA_BIAS_OFF);
      constexpr int NB_ = (ATT_BIAS_PADF + 8 * 15 * 31 + ATT_BIAS_TAILF + NTHREADS - 1) / NTHREADS;
      float bv_[NB_];
#pragma unroll
      for (int k = 0; k < NB_; ++k) { const int j = F.tid + k * NTHREADS - ATT_BIAS_PADF; const float t_ = rpb[j < 0 ? 0 : (j < 8 * 15 * 31 ? j : 8 * 15 * 31 - 1)]; bv_[k] = (j >= 0 && j < 8 * 15 * 31) ? t_ : 0.f; }
      __builtin_amdgcn_sched_barrier(0);
#pragma unroll
      for (int k = 0; k < NB_; ++k) { const int idx = F.tid + k * NTHREADS; if (idx < ATT_BIAS_PADF + 8 * 15 * 31 + ATT_BIAS_TAILF) bias[idx] = bv_[k] * LOG2E; } }
    for (int c = F.vcu; c < 256; c += F.G) {
        const int b = c >> 5, h = (c >> 2) & 7, cb = c & 3, kc0 = min(max(16 * cb - 8, 0), 32);
        const bf16_t* qb = qkv + 3 * TENS + ((size_t)(b * 8 + h) * T << 6);
        const bf16_t* kb = qb + TENS;
        const int fK = (i >> 1) & 7, kof0 = i * 128 + ((g ^ fK) << 4), kof1 = i * 128 + (((4 + g) ^ fK) << 4);
        const int fV = ((2 * g + (i >> 3)) & 3) << 1;
        int vof[4];
#pragma unroll
        for (int n = 0; n < 4; ++n) vof[n] = (4 * g + (i >> 2)) * 128 + (((2 * n + ((i & 3) >> 1)) ^ fV) << 4) + (i & 1) * 8;
        const int pkk = (F.tid >> 3) & 31, pc = F.tid & 7, pr = F.tid >> 8;
        u32x4 st[8];
#define NA_FETCH(row0_, nrow_) do { _Pragma("unroll") for (int k_ = 0; k_ < 8; ++k_) { const int ro_ = 2 * (k_ & 3) + pr; const int kr_ = min((row0_) + ro_, 127); \
            st[k_] = *(const u32x4*)(kb + (size_t)(k_ >> 2) * TENS + ((size_t)(kr_ * 64 + kc0 + pkk) << 6) + pc * 8); } } while (0)
#define NA_STORE(row0_, nrow_) do { _Pragma("unroll") for (int k_ = 0; k_ < 8; ++k_) { const int ro_ = 2 * (k_ & 3) + pr; if (ro_ < (nrow_)) { const int R_ = (((row0_) + ro_) & 15) * 32 + pkk; \
            const int f_ = (k_ >> 2) ? (((R_ >> 1) & 3) << 1) : ((R_ >> 1) & 7); \
            *(LAS u32x4*)(F.lds + (k_ >> 2) * 65536 + R_ * 128 + ((pc ^ f_) << 4)) = st[k_]; } } } while (0)
        __syncthreads();
        NA_FETCH(0, 8); NA_STORE(0, 8); NA_FETCH(8, 3); NA_STORE(8, 3);
        bf16x8 Qn0, Qn1;
        { const size_t tq0 = (size_t)(w * 64 + 16 * cb + i); Qn0 = *(const bf16x8*)(qb + (tq0 << 6) + 8 * g); Qn1 = *(const bf16x8*)(qb + (tq0 << 6) + 8 * g + 32); }
        __builtin_amdgcn_s_waitcnt(0x0F70);
        __syncthreads();
#pragma unroll 1
        for (int j = 0; j < 16; ++j) {
            const int hi_cur = min(8 * j + 10, 127), hi_nxt = min(8 * j + 18, 127), nnew = (j < 15) ? hi_nxt - hi_cur : 0;
            if (nnew > 0) NA_FETCH(hi_cur + 1, nnew);
            const int qrow = 8 * j + w, qcol = 16 * cb + i, rs = min(max(qrow - 4, 0), 120), cs = min(max(qcol - 8, 0), 48);
            const size_t tq = (size_t)(qrow * 64 + qcol);
            const bf16x8 Q0 = Qn0, Q1 = Qn1;
            { const int qn = min(8 * (j + 1) + w, 127); const size_t tqn = (size_t)(qn * 64 + qcol); Qn0 = *(const bf16x8*)(qb + (tqn << 6) + 8 * g); Qn1 = *(const bf16x8*)(qb + (tqn << 6) + 8 * g + 32); }
            const LAS float* biasp = (const LAS float*)(F.lds + NA_BIAS_OFF) + ATT_BIAS_PADF + ((h * 15 + (rs - qrow + 7)) * 31 + (kc0 - qcol + 15 + 4 * g));
            const int lo = cs - kc0 - 4 * g;
            f32x4 sc[16];
#pragma unroll
            for (int s = 0; s < 8; ++s) { const int R0 = ((rs + s) & 15) * 32;
#pragma unroll
                for (int T_ = 0; T_ < 2; ++T_) { const bf16x8 k0 = *(const LAS bf16x8*)(F.lds + (R0 + 16 * T_) * 128 + kof0), k1 = *(const LAS bf16x8*)(F.lds + (R0 + 16 * T_) * 128 + kof1);
                    sc[2 * s + T_] = __builtin_amdgcn_mfma_f32_16x16x32_bf16(k0, Q0, (f32x4){0.f, 0.f, 0.f, 0.f}, 0, 0, 0);
                    sc[2 * s + T_] = __builtin_amdgcn_mfma_f32_16x16x32_bf16(k1, Q1, sc[2 * s + T_], 0, 0, 0); } }
            bool first[4]; int boff[4];
#pragma unroll
            for (int r_ = 0; r_ < 4; ++r_) { first[r_] = r_ >= lo; boff[r_] = first[r_] ? r_ : 16 + r_; }
            float w[8][4]; float mrow = -INFINITY;
#pragma unroll
            for (int s = 0; s < 8; ++s)
#pragma unroll
                for (int r_ = 0; r_ < 4; ++r_) { const float v = (first[r_] ? sc[2 * s][r_] : sc[2 * s + 1][r_]) + biasp[s * 31 + boff[r_]]; w[s][r_] = v; mrow = fmaxf(mrow, v); }
            mrow = fmaxf(mrow, __shfl_xor(mrow, 16)); mrow = fmaxf(mrow, __shfl_xor(mrow, 32));
            float lt = 0.f;
#pragma unroll
            for (int s = 0; s < 8; ++s)
#pragma unroll
                for (int r_ = 0; r_ < 4; ++r_) { const float p = __builtin_amdgcn_exp2f(w[s][r_] - mrow); lt += p; sc[2 * s][r_] = first[r_] ? p : 0.f; sc[2 * s + 1][r_] = first[r_] ? 0.f : p; }
            f32x4 O[4];
#pragma unroll
            for (int n = 0; n < 4; ++n) O[n] = (f32x4){0.f, 0.f, 0.f, 0.f};
#pragma unroll
            for (int s = 0; s < 8; ++s) { const int R0 = ((rs + s) & 15) * 32;
                u32x4 pw; pw.x = cvt_pk_bf16(sc[2 * s][0], sc[2 * s][1]); pw.y = cvt_pk_bf16(sc[2 * s][2], sc[2 * s][3]); pw.z = cvt_pk_bf16(sc[2 * s + 1][0], sc[2 * s + 1][1]); pw.w = cvt_pk_bf16(sc[2 * s + 1][2], sc[2 * s + 1][3]);
                const bf16x8 Pf = __builtin_bit_cast(bf16x8, pw);
#pragma unroll
                for (int n = 0; n < 4; ++n) { const s16x4 a = vtr(F.lds + 65536 + R0 * 128 + vof[n]), cc = vtr(F.lds + 65536 + (R0 + 16) * 128 + vof[n]);
                    const bf16x8 Vf = (bf16x8){a[0], a[1], a[2], a[3], cc[0], cc[1], cc[2], cc[3]};
                    O[n] = __builtin_amdgcn_mfma_f32_16x16x32_bf16(Vf, Pf, O[n], 0, 0, 0); }
            }
            lt += __shfl_xor(lt, 16); lt += __shfl_xor(lt, 32);
            const float inv = 1.0f / lt;
            bf16_t* op = mix + ((size_t)b * T + tq) * D + 512 + h * 64 + 4 * g;
            float sq = 0.f;
#pragma unroll
            for (int n = 0; n < 4; ++n) { const f32x4 o = O[n] * inv; sq += (o[0] * o[0] + o[1] * o[1]) + (o[2] * o[2] + o[3] * o[3]); u32x2 ww; ww.x = cvt_pk_bf16(o[0], o[1]); ww.y = cvt_pk_bf16(o[2], o[3]); *(u32x2*)(op + 16 * n) = ww; }
            sq += __shfl_xor(sq, 16); sq += __shfl_xor(sq, 32);
            if (g == 0) ((float*)(F.ws + WS_SSQN))[((size_t)b * T + tq) * 8 + h] = sq;
            __builtin_amdgcn_s_waitcnt(0x0F75);
            __syncthreads();
            if (nnew > 0) NA_STORE(hi_cur + 1, nnew);
            __syncthreads();
        }
#undef NA_FETCH
#undef NA_STORE
    }
}
__device__ __forceinline__ void attn_merge_phase(Frame& F0, int l) {
    Frame F = F0; F.tid = fresh_v(F0.tid); F.lane = F.tid & 63; F.wave = fresh_s(F0.wave); (void)l;
    bf16_t* mix = (bf16_t*)(F.ws + WS_MIX); const bf16_t* partA = (const bf16_t*)(F.ws + WS_PARTA); const bf16_t* partB = (const bf16_t*)(F.ws + WS_PARTB); const float* lsep = (const float*)(F.ws + WS_LSEP);
    const float* ssqn = (const float*)(F.ws + WS_SSQN); float* rns = (float*)(F.ws + WS_RNS); float* rat = (float*)(F.ws + WS_RAT);
    const int lane = F.lane, hh = lane >> 3;
    const int gw = F.vcu * NWAVES + F.wave, NGW = F.G * NWAVES;
#define MG_LOAD(T, m_) u32x4* p##T = (u32x4*)(mix + (size_t)(m_) * D + 8 * lane); \
        const u32x4 c##T = p##T[0], a##T = *(const u32x4*)(partA + (size_t)(m_) * 512 + 8 * lane), b##T = *(const u32x4*)(partB + (size_t)(m_) * 512 + 8 * lane); \
        const float la##T = lsep[((size_t)0 * M + (m_)) * 8 + hh], lb##T = lsep[((size_t)1 * M + (m_)) * 8 + hh], lc##T = lsep[((size_t)2 * M + (m_)) * 8 + hh]; \
        const float snr##T = ssqn[(size_t)(m_) * 8 + (lane & 7)];
#define MG_DONE(T, m_) { float sn = lane < 8 ? snr##T : 0.f; \
        const float mx = fmaxf(fmaxf(la##T, lb##T), lc##T); \
        float wa = __builtin_amdgcn_exp2f(la##T - mx), wb = __builtin_amdgcn_exp2f(lb##T - mx), wc = __builtin_amdgcn_exp2f(lc##T - mx); \
        const float wi = 1.0f / (wa + wb + wc); wa *= wi; wb *= wi; wc *= wi; \
        const unsigned cw[4] = {c##T.x, c##T.y, c##T.z, c##T.w}, aw[4] = {a##T.x, a##T.y, a##T.z, a##T.w}, bw[4] = {b##T.x, b##T.y, b##T.z, b##T.w}; \
        float o[8]; float ssq = 0.f; \
        _Pragma("unroll") for (int k = 0; k < 4; ++k) { o[2 * k] = wa * bf_lo(aw[k]) + wb * bf_lo(bw[k]) + wc * bf_lo(cw[k]); o[2 * k + 1] = wa * bf_hi(aw[k]) + wb * bf_hi(bw[k]) + wc * bf_hi(cw[k]); \
            ssq += o[2 * k] * o[2 * k] + o[2 * k + 1] * o[2 * k + 1]; } \
        ssq = wave_sum(ssq); \
        sn += __shfl_xor(sn, 1); sn += __shfl_xor(sn, 2); sn += __shfl_xor(sn, 4); \
        p##T[0] = (u32x4){cvt_pk_bf16(o[0], o[1]), cvt_pk_bf16(o[2], o[3]), cvt_pk_bf16(o[4], o[5]), cvt_pk_bf16(o[6], o[7])}; \
        if (lane == 0) { const float rd = 1.0f / sqrtf(ssq * (1.0f / 512.0f) + EPS), rn = 1.0f / sqrtf(sn * (1.0f / 512.0f) + EPS); rns[m_] = rn; rat[m_] = rd * sqrtf(sn * (1.0f / 512.0f) + EPS); } }
#pragma unroll 1
    for (int m = gw; m < M; m += 2 * NGW) {
        const int mB = m + NGW; const bool hasB = mB < M; const int mBc = hasB ? mB : m;
        MG_LOAD(A, m) MG_LOAD(B, mBc)
        MG_DONE(A, m)
        if (hasB) MG_DONE(B, mB)
    }
#undef MG_LOAD
#undef MG_DONE
}


__global__ void __launch_bounds__(NTHREADS, 2) mk_fwd(Args args) {
    extern __shared__ __attribute__((aligned(16))) unsigned char lds_raw[];
    Frame F;
    F.lds = (LAS unsigned char*)lds_raw;
    F.tid = threadIdx.x; F.lane = F.tid & 63; F.wave = __builtin_amdgcn_readfirstlane(F.tid >> 6);
    F.G = gridDim.x; { const int bx = blockIdx.x; F.vcu = (F.G % 8 == 0) ? (bx % 8) * (F.G / 8) + bx / 8 : bx; }
    F.out = args.out; F.ws = args.ws;
    volatile LAS unsigned* MISC = (volatile LAS unsigned*)(F.lds + MISC_OFF);
    if (F.tid < 16) MISC[F.tid] = 0u;
    __syncthreads();
    XcdBarrier bar; bar.bar = (unsigned*)(F.ws + WS_CTL) + CW_BAR; bar.x = 0; bar.st = nullptr;
    if (MK_N_LAUNCHES == 1) bar = xcd_barrier_post((unsigned*)(F.ws + WS_CTL) + CW_BAR, MISC + 8);
    const int lo = args.ph_lo, hi = args.ph_hi;
    const bool hostdn = (F.G == 256);
#define IN(k) (lo <= (k) && (k) < hi)
#ifdef PROBE_PHASE
    unsigned long long pr_last = __builtin_amdgcn_s_memrealtime(), pr_acc = 0ull;
#define SEAM(k) do { if (IN(k) && IN((k) + 1)) xcd_barrier(bar); { const unsigned long long now_ = __builtin_amdgcn_s_memrealtime(); const int ty_ = (k) == 0 ? 0 : 1 + ((k) - 1) % 9; if (ty_ == PROBE_PHASE) pr_acc += now_ - pr_last; pr_last = now_; } } while (0)
#else
#define SEAM(k) do { if (IN(k) && IN((k) + 1)) xcd_barrier(bar); } while (0)
#endif
#ifndef GPH
#define GPH 0
#endif
#ifndef GPROBE_AMP
#define GPROBE_AMP 1
#endif
    unsigned long long gp_acc = 0ull, gp_dummy = 0ull; (void)gp_dummy;
    bf16_t* H = (bf16_t*)(F.ws + WS_H); bf16_t* QKV = (bf16_t*)(F.ws + WS_QKV); bf16_t* MIX = (bf16_t*)(F.ws + WS_MIX);
    bf16_t* ACT = (bf16_t*)(F.ws + WS_ACT); bf16_t* YE = (bf16_t*)(F.ws + WS_YE);

    if (IN(0)) {
#if PM & 1
        conv_weights(F, 0, hostdn ? 2 : 1);
#endif
#if PM & 2
        rope_table(F);
#endif
#if PM & 4
        norm1_phase(F, KIN(0), KIN(1));
#endif
    }
    SEAM(0);
#pragma unroll 1
    for (int l = 0; l < 2; ++l) {
        const int pb = 1 + 9 * l;
#if PM & 8
        if (IN(pb + 0)) {
            gm::StaticOrder S; S.init(M, NQKV, F.G, (int)blockIdx.x);
            gm::ASrc A{l == 0 ? (const char*)H : (const char*)F.out, nullptr, D, (const float*)(F.ws + WS_RSTDQ)}; gm::BSrc B{(const char*)(F.ws + WS_WIN), 31, 0};
            gm::EpiQKV E{QKV, (const float*)(F.ws + WS_ROPE)};
            gm::gemm_phase<gm::EpiQKV, false, false>(F.lds, A, B, S, E, GPH == 1 ? gp_acc : gp_dummy);
        }
#endif
        SEAM(pb + 0);
#if PM & 16
        if (IN(pb + 1)) attn_units_phase(F, l);
#endif
        SEAM(pb + 1);
#if PM & 16
        if (IN(pb + 2)) attn_merge_phase(F, l);
#endif
        SEAM(pb + 2);
#if PM & 32
        if (IN(pb + 3)) {
            gm::StaticOrder S; S.init(M, D, F.G, (int)blockIdx.x);
            gm::ASrc A{(const char*)MIX, nullptr, D, (const float*)(F.ws + WS_RNS), (const float*)(F.ws + WS_RAT)}; gm::BSrc B{(const char*)(F.ws + WS_WOUT), 31, 0};
            { gm::EpiX1<true> E{(bf16_t*)(F.ws + WS_PARTA), l == 0 ? (const void*)H : (const void*)F.out}; gm::gemm_phase<gm::EpiX1<true>, false, false>(F.lds, A, B, S, E, GPH == 2 ? gp_acc : gp_dummy); }
        }
#endif
        SEAM(pb + 3);
#if PM & 64
        if (IN(pb + 4)) { norm2_router_phase<true, true>(F, (const void*)(F.ws + WS_PARTA), MIX, KIN(7) + (size_t)l * D, KIN(8) + (size_t)l * D * NE); }
#endif
        SEAM(pb + 4);
#if PM & 128
        if (IN(pb + 5)) topk_phase(F, l == 0 && hostdn);
#endif
        SEAM(pb + 5);
#if PM & 256
        if (IN(pb + 6)) {
            gm::StaticOrder S; S.init(MS, 2 * FF, F.G, (int)blockIdx.x);
            gm::ASrc A{(const char*)H, (const int*)(F.ws + WS_SEL), D, (const float*)(F.ws + WS_RSS)}; gm::BSrc B{(const char*)(F.ws + WS_WGU + (size_t)l * WGU_BYTES), 5, (size_t)2 * FF * D};
            const int cvstep = F.G * NWAVES, cvn = (CV_ITEMS + cvstep - 1) / cvstep, nun = ((MS / 256) * (2 * FF / 256)) / F.G;
            const bool h1 = (l == 0 && cvn <= nun);
            gm::EpiSwiGLU E{(unsigned char*)ACT, F.ws, h1 ? cvn : 0, (l == 0 && hostdn) ? 11 : 0, 22, F.vcu * NWAVES + F.wave, cvstep};
            gm::gemm_phase<gm::EpiSwiGLU, true, true>(F.lds, A, B, S, E, GPH == 3 ? gp_acc : gp_dummy);
        }
#endif
        SEAM(pb + 6);
#if PM & 512
        if (IN(pb + 7)) {
            gm::StaticOrder S; S.init(MS, D, F.G, (int)blockIdx.x);
            gm::ASrc A{(const char*)ACT, nullptr, FF, nullptr}; gm::BSrc B{(const char*)(F.ws + WS_WD + (size_t)l * WD_BYTES), 5, (size_t)D * FF};
            gm::EpiDown E{(unsigned char*)YE, (const float*)(F.ws + WS_GATEV)};
            gm::gemm_phase<gm::EpiDown, true, true>(F.lds, A, B, S, E, GPH == 4 ? gp_acc : gp_dummy);
        }
#endif
        SEAM(pb + 7);
#if PM & 1024
        if (IN(pb + 8)) {
            if (l == 0) { const int cvstep = F.G * NWAVES, cvn = (CV_ITEMS + cvstep - 1) / cvstep, nun = ((MS / 256) * (2 * FF / 256)) / F.G;
                if (!hostdn) conv_weights(F, 1, (cvn <= nun) ? 0 : 1); combine_phase<false>(F, F.out, KIN(1) + D); }
            else combine_phase<true>(F, F.out, KIN(12));
        }
#endif
        if (l == 0) SEAM(pb + 8);
    }
#if GPROBE
    { const unsigned long long t0_ = __builtin_amdgcn_s_memrealtime(); while (__builtin_amdgcn_s_memrealtime() - t0_ < gp_acc * GPROBE_AMP) __builtin_amdgcn_s_sleep(8); }
#endif
#ifdef PROBE_PHASE
    { const unsigned long long now_ = __builtin_amdgcn_s_memrealtime(); if (PROBE_PHASE == 9) pr_acc += now_ - pr_last;
      const unsigned long long t0_ = __builtin_amdgcn_s_memrealtime(); while (__builtin_amdgcn_s_memrealtime() - t0_ < pr_acc * PROBE_AMP) __builtin_amdgcn_s_sleep(8); }
#endif
#undef IN
#undef SEAM
}

extern "C" void kernel_launch(void* const* d_in, const int* in_sizes, int n_in, void* d_out, int out_size, void* d_ws, size_t ws_size, hipStream_t stream) {
    static int grid = 0;
    if (grid == 0) {
        if (n_in != 13 || in_sizes[0] != M * D || out_size != M * D || ws_size < WS_END) {
            fprintf(stderr, "kernel_launch: unexpected problem (n_in %d, in0 %d, out %d, ws %zu < %zu); nothing launched\n", n_in, n_in > 0 ? in_sizes[0] : -1, out_size, ws_size, (size_t)WS_END); grid = -1; return; }
        int dev = 0, cus = 0, per_cu = 0;
        if (hipGetDevice(&dev) != hipSuccess || hipDeviceGetAttribute(&cus, hipDeviceAttributeMultiprocessorCount, dev) != hipSuccess) { grid = -1; return; }
        if (hipFuncSetAttribute((const void*)mk_fwd, hipFuncAttributeMaxDynamicSharedMemorySize, LDS_BYTES) != hipSuccess) { fprintf(stderr, "kernel_launch: hipFuncSetAttribute failed\n"); grid = -1; return; }
        if (hipOccupancyMaxActiveBlocksPerMultiprocessor(&per_cu, (const void*)mk_fwd, NTHREADS, LDS_BYTES) != hipSuccess || per_cu < 1) {
            fprintf(stderr, "kernel_launch: occupancy query reports %d workgroups per CU; nothing launched\n", per_cu); (void)hipGetLastError(); grid = -1; return; }
        grid = cus;
    }
    if (grid < 0) return;
    (void)hipMemsetAsync((char*)d_ws + WS_CTL, 0, CTL_BYTES, stream);
    Args a{};
    for (int i = 0; i < 13; ++i) a.in[i] = (const float*)d_in[i];
    a.out = (float*)d_out; a.ws = (unsigned char*)d_ws;
    if (MK_N_LAUNCHES == 1) {
        a.ph_lo = 0; a.ph_hi = NPH; a.li = 0;
        hipLaunchKernelGGL(mk_fwd, dim3(grid), dim3(NTHREADS), LDS_BYTES, stream, a);
    } else {
        for (int p = 0; p < NPH; ++p) { a.ph_lo = p; a.ph_hi = p + 1; a.li = p; hipLaunchKernelGGL(mk_fwd, dim3(grid), dim3(NTHREADS), LDS_BYTES, stream, a); }
    }
    const hipError_t le = hipPeekAtLastError();
    if (le != hipSuccess) fprintf(stderr, "kernel_launch: launch failed: %s\n", hipGetErrorName(le));
}
```
